# Optimizing an MI355X kernel written in HIP

```python
import math
import jax, jax.numpy as jnp
from jax import lax
import numpy as np

D_MODEL = 1024
BATCH = 1
SEQ = 16384
DEPTH = 1
DEC_BATCH = 4
DEC_SEQ = 4096
PAST_LEN = 128

MIX_WIDTH = D_MODEL
ATTN_WIDTH = D_MODEL // 2
SSM_WIDTH = MIX_WIDTH - ATTN_WIDTH
HEAD_DIM = 64
N_HEADS = ATTN_WIDTH // HEAD_DIM
DILATION_BRANCHES = ((128, 1), (512, 4), (2048, 16))
Q_BLOCK = 128
ROPE_THETA = 10000.0
SSM_GROUP = 16
N_SSM_GROUPS = SSM_WIDTH // SSM_GROUP
SSM_STATE = 64
FFN_HIDDEN = -(-8 * D_MODEL // (3 * 256)) * 256
PROJ_WIDTH = 3 * ATTN_WIDTH + SSM_WIDTH
N_MOD = 6
EPS = 1e-6

kernel_name = "hymba_dilated_s5_adaln_encoder"


def _rmsnorm(x, g):
    x32 = x.astype(jnp.float32)
    y = x32 * lax.rsqrt(jnp.mean(x32 * x32, axis=-1, keepdims=True) + EPS)
    return (y * g.astype(jnp.float32)).astype(x.dtype)


def _rope_tables(seq_len):
    inv = 1.0 / (ROPE_THETA ** (jnp.arange(0, HEAD_DIM, 2, dtype=jnp.float32) / HEAD_DIM))
    ang = jnp.arange(seq_len, dtype=jnp.float32)[:, None] * inv[None, :]
    return jnp.cos(ang), jnp.sin(ang)


def _rope(x, cos, sin):
    x32 = x.astype(jnp.float32)
    x1, x2 = jnp.split(x32, 2, axis=-1)
    c = cos[None, :, None, :]
    s = sin[None, :, None, :]
    return jnp.concatenate([x1 * c - x2 * s, x2 * c + x1 * s], axis=-1).astype(x.dtype)


def _dilated_attention(q, k, v):
    b, s_len, h, dh = q.shape
    n_blk = s_len // Q_BLOCK
    scale = HEAD_DIM ** -0.5
    branches = []
    for window, dil in DILATION_BRANCHES:
        half = (window // (2 * dil)) * dil
        pads = ((0, 0), (half, half), (0, 0), (0, 0))
        branches.append((jnp.pad(k, pads), jnp.pad(v, pads), half, dil))

    def block(i):
        start = i * Q_BLOCK
        qb = lax.dynamic_slice_in_dim(q, start, Q_BLOCK, axis=1)
        qpos = start + jnp.arange(Q_BLOCK)
        outs, lses = [], []
        for kp, vp, half, dil in branches:
            offs = jnp.arange(-half, half + 1, dil)
            pos = qpos[:, None] + offs[None, :]
            valid = (pos >= 0) & (pos < s_len)
            kg = jnp.take(kp, pos + half, axis=1)
            vg = jnp.take(vp, pos + half, axis=1)
            sc = jnp.einsum('bqhd,bqnhd->bhqn', qb, kg,
                            preferred_element_type=jnp.float32) * scale
            sc = jnp.where(valid[None, None], sc, -jnp.inf)
            m = jnp.max(sc, axis=-1, keepdims=True)
            p = jnp.exp(sc - m)
            den = jnp.sum(p, axis=-1, keepdims=True)
            o = jnp.einsum('bhqn,bqnhd->bqhd', p / den, vg.astype(jnp.float32))
            outs.append(o)
            lses.append(jnp.transpose((m + jnp.log(den))[..., 0], (0, 2, 1)))
        wts = jax.nn.softmax(jnp.stack(lses, axis=0), axis=0)
        out = jnp.sum(wts[..., None] * jnp.stack(outs, axis=0), axis=0)
        return out.astype(q.dtype)

    out = lax.map(block, jnp.arange(n_blk))
    return jnp.moveaxis(out, 0, 1).reshape(b, s_len, h * dh)


def _complex_linear_combine(e1, e2):
    a1r, a1i, b1r, b1i = e1
    a2r, a2i, b2r, b2i = e2
    return (a2r * a1r - a2i * a1i,
            a2r * a1i + a2i * a1r,
            a2r * b1r - a2i * b1i + b2r,
            a2r * b1i + a2i * b1r + b2i)


def _s5_direction(ug, lam_re, lam_im, log_dt, b_re, b_im, c_re, c_im, reverse):
    dt = jnp.exp(log_dt)[:, None]
    mag = jnp.exp(lam_re * dt)
    ang = lam_im * dt
    a_re = mag * jnp.cos(ang)
    a_im = mag * jnp.sin(ang)
    nr = a_re - 1.0
    den = lam_re * lam_re + lam_im * lam_im
    z_re = ((nr * lam_re + a_im * lam_im) / den)[..., None]
    z_im = ((a_im * lam_re - nr * lam_im) / den)[..., None]
    bb_re = z_re * b_re - z_im * b_im
    bb_im = z_re * b_im + z_im * b_re
    bu_re = jnp.einsum('bsgc,gpc->bsgp', ug, bb_re)
    bu_im = jnp.einsum('bsgc,gpc->bsgp', ug, bb_im)
    shape = bu_re.shape
    elems = (jnp.broadcast_to(a_re, shape), jnp.broadcast_to(a_im, shape), bu_re, bu_im)
    _, _, h_re, h_im = lax.associative_scan(_complex_linear_combine, elems,
                                            reverse=reverse, axis=1)
    return (jnp.einsum('bsgp,gcp->bsgc', h_re, c_re)
            - jnp.einsum('bsgp,gcp->bsgc', h_im, c_im))


def _s5_bidirectional(u, lam_re, lam_im, log_dt, b_re, b_im, c_re, c_im, d_skip, w_glu, b_glu):
    b, s_len, _ = u.shape
    ug = u.reshape(b, s_len, N_SSM_GROUPS, SSM_GROUP)
    y_f = _s5_direction(ug, lam_re[0], lam_im[0], log_dt[0], b_re[0], b_im[0],
                        c_re[0], c_im[0], reverse=False)
    y_b = _s5_direction(ug, lam_re[1], lam_im[1], log_dt[1], b_re[1], b_im[1],
                        c_re[1], c_im[1], reverse=True)
    y = (y_f + y_b).reshape(b, s_len, SSM_WIDTH) + d_skip * u
    g = jax.nn.gelu(y)
    return g * jax.nn.sigmoid(g @ w_glu + b_glu)


def _encode(x, c, w_ada, b_ada, norm1_g, w_in, lam_re, lam_im, log_dt, b_re, b_im,
            c_re, c_im, d_skip, w_glu, b_glu, attn_norm_g, ssm_norm_g, w_o,
            norm2_g, w1, w3, w2, final_g):
    b, s_len, _ = x.shape
    cos, sin = _rope_tables(s_len)
    for l in range(DEPTH):
        mod = (jax.nn.silu(c) @ w_ada[l] + b_ada[l])[:, None, :]
        sh1, sc1, g1, sh2, sc2, g2 = jnp.split(mod, N_MOD, axis=-1)
        h = _rmsnorm(x, norm1_g[l]) * (1.0 + sc1) + sh1
        proj = h @ w_in[l]
        q, k, v, u = jnp.split(proj, [ATTN_WIDTH, 2 * ATTN_WIDTH, 3 * ATTN_WIDTH], axis=-1)
        q = _rope(q.reshape(b, s_len, N_HEADS, HEAD_DIM), cos, sin)
        k = _rope(k.reshape(b, s_len, N_HEADS, HEAD_DIM), cos, sin)
        v = v.reshape(b, s_len, N_HEADS, HEAD_DIM)
        attn = _dilated_attention(q, k, v)
        ssm = _s5_bidirectional(u, lam_re[l], lam_im[l], log_dt[l], b_re[l], b_im[l],
                                c_re[l], c_im[l], d_skip[l], w_glu[l], b_glu[l])
        mixed = jnp.concatenate([_rmsnorm(attn, attn_norm_g[l]),
                                 _rmsnorm(ssm, ssm_norm_g[l])], axis=-1) @ w_o[l]
        x = x + g1 * mixed
        h = _rmsnorm(x, norm2_g[l]) * (1.0 + sc2) + sh2
        ffn = (jax.nn.silu(h @ w1[l]) * (h @ w3[l])) @ w2[l]
        x = x + g2 * ffn
    return _rmsnorm(x, final_g)


def setup_inputs(seed: int = 0) -> dict:
    key = jax.random.key(seed)
    ks = jax.random.split(key, 32)
    f32 = jnp.float32
    L, D, G, P, C = DEPTH, D_MODEL, N_SSM_GROUPS, SSM_STATE, SSM_GROUP

    def nrm(k, shape, scale):
        return jax.random.normal(k, shape, f32) * scale

    lam_im0 = jnp.broadcast_to(jnp.pi * jnp.arange(P, dtype=f32), (L, 2, G, P))
    return {
        "x_prompt": nrm(ks[0], (BATCH, SEQ, D), 1.0),
        "x_sample": nrm(ks[1], (DEC_BATCH, DEC_SEQ, D), 1.0),
        "c_prompt": nrm(ks[2], (BATCH, D), 1.0),
        "c_sample": nrm(ks[3], (DEC_BATCH, D), 1.0),
        "w_ada": nrm(ks[4], (L, D, N_MOD * D), 0.5 * D ** -0.5),
        "b_ada": nrm(ks[5], (L, N_MOD * D), 0.01),
        "norm1_g": 1.0 + nrm(ks[6], (L, D), 0.02),
        "w_in": nrm(ks[7], (L, D, PROJ_WIDTH), D ** -0.5),
        "lam_re": -0.5 + nrm(ks[8], (L, 2, G, P), 0.01),
        "lam_im": lam_im0 + nrm(ks[9], (L, 2, G, P), 0.01),
        "log_dt": jax.random.uniform(ks[10], (L, 2, G), f32, math.log(0.001), math.log(0.1)),
        "b_re": nrm(ks[11], (L, 2, G, P, C), (2 * C) ** -0.5),
        "b_im": nrm(ks[12], (L, 2, G, P, C), (2 * C) ** -0.5),
        "c_re": nrm(ks[13], (L, 2, G, C, P), (2 * P) ** -0.5),
        "c_im": nrm(ks[14], (L, 2, G, C, P), (2 * P) ** -0.5),
        "d_skip": nrm(ks[15], (L, SSM_WIDTH), 1.0),
        "w_glu": nrm(ks[16], (L, SSM_WIDTH, SSM_WIDTH), SSM_WIDTH ** -0.5),
        "b_glu": nrm(ks[17], (L, SSM_WIDTH), 0.01),
        "attn_norm_g": 1.0 + nrm(ks[18], (L, ATTN_WIDTH), 0.02),
        "ssm_norm_g": 1.0 + nrm(ks[19], (L, SSM_WIDTH), 0.02),
        "w_o": nrm(ks[20], (L, MIX_WIDTH, D), MIX_WIDTH ** -0.5),
        "norm2_g": 1.0 + nrm(ks[21], (L, D), 0.02),
        "w1": nrm(ks[22], (L, D, FFN_HIDDEN), D ** -0.5),
        "w3": nrm(ks[23], (L, D, FFN_HIDDEN), D ** -0.5),
        "w2": nrm(ks[24], (L, FFN_HIDDEN, D), FFN_HIDDEN ** -0.5),
        "final_g": 1.0 + nrm(ks[25], (D,), 0.02),
    }


def reference(x_prompt, x_sample, c_prompt, c_sample, w_ada, b_ada, norm1_g, w_in,
              lam_re, lam_im, log_dt, b_re, b_im, c_re, c_im, d_skip, w_glu, b_glu,
              attn_norm_g, ssm_norm_g, w_o, norm2_g, w1, w3, w2, final_g):
    y_prompt = _encode(x_prompt, c_prompt, w_ada, b_ada, norm1_g, w_in, lam_re, lam_im,
                       log_dt, b_re, b_im, c_re, c_im, d_skip, w_glu, b_glu,
                       attn_norm_g, ssm_norm_g, w_o, norm2_g, w1, w3, w2, final_g)
    y_sample = _encode(x_sample, c_sample, w_ada, b_ada, norm1_g, w_in, lam_re, lam_im,
                       log_dt, b_re, b_im, c_re, c_im, d_skip, w_glu, b_glu,
                       attn_norm_g, ssm_norm_g, w_o, norm2_g, w1, w3, w2, final_g)
    return (y_prompt, y_sample)
```

```cpp
#include <hip/hip_runtime.h>
#include <cstdio>
#include <cstdint>
#include <cmath>
namespace pg8 {
#define PG8_LAS __attribute__((address_space(3)))
typedef unsigned short bf16_t;
typedef short bf16x8 __attribute__((ext_vector_type(8)));
typedef float f32x4 __attribute__((ext_vector_type(4)));
typedef unsigned u32x4 __attribute__((ext_vector_type(4)));
constexpr int BM = 256, BK = 64, HALF = 128, HTB = HALF * BK * 2  , STAGE_BYTES = 8 * HTB, NXCD = 8, WGM = 8;

__host__ __device__ __forceinline__ int lds_byte(int r, int c) { const int st = (r >> 4) * 2 + (c >> 5), rr = r & 15, cc = c & 31, ob = rr * 64 + cc * 2; return st * 1024 + (ob ^ (((ob >> 9) & 1) << 5)); }
__host__ __device__ __forceinline__ void stage_rc(int b, int& R, int& C) { const int st = b / 1024, sb = b % 1024, swz = sb ^ (((sb >> 9) & 1) << 5); R = (st >> 1) * 16 + swz / 64; C = (st & 1) * 32 + (swz % 64) / 2; }
__host__ __device__ __forceinline__ int perm32(int rho) { const int n = rho >> 4, i = rho & 15; return 8 * (i >> 2) + 4 * n + (i & 3); }

struct Unit { int pm, pn; };
struct Gemm { const bf16_t* A; const bf16_t* Bt; int M, N, K, lda, ldb; };

struct StaticOrder {
    int nM, nN, nwg, G, c;
    __host__ __device__ void init(int M, int N, int G_, int c_) { nM = M / BM; nN = N / BM; nwg = nM * nN; G = G_; c = c_; }
    __host__ __device__ bool next(int i, Unit& u) const {
        const long L = (long)i * G + c; if (L >= nwg) return false;
        int wgid = (int)L; { const int q = nwg / NXCD, r = nwg % NXCD, xcd = wgid % NXCD, off = wgid / NXCD; wgid = (xcd < r ? xcd * (q + 1) : r * (q + 1) + (xcd - r) * q) + off; }
        const int nig = WGM * nN, gid = wgid / nig, fm = gid * WGM, gsz = (nM - fm) < WGM ? (nM - fm) : WGM;
        u.pm = fm + ((wgid % nig) % gsz); u.pn = (wgid % nig) / gsz; return true;
    }
    __device__ __forceinline__ void a_ready(const Unit&) const {}
    __device__ __forceinline__ void done(const Unit&) const {}
};

__device__ __forceinline__ unsigned cvt_pk_bf16(float lo, float hi) { unsigned r; asm volatile("v_cvt_pk_bf16_f32 %0, %1, %2" : "=v"(r) : "v"(lo), "v"(hi)); return r; }
template <class Epi, class Sched, bool ALIGN_EPI = false, bool SP2 = false>
__device__ __forceinline__ void gemm_phase(PG8_LAS unsigned char* lds, const Gemm g, const Sched& S, const Epi& E) {
    const int tid = threadIdx.x, wid = __builtin_amdgcn_readfirstlane(tid >> 6), lane = tid & 63, wr = wid >> 2, wc = wid & 3, fr = lane & 15, fq = lane >> 4;
    const int K = g.K, nt = K / BK;
    unsigned voffA[2], voffB[2];
#pragma unroll
    for (int i = 0; i < 2; ++i) { int R, C; stage_rc(tid * 16 + i * 8192, R, C); const int Rb = Epi::PERM ? ((R & ~31) + perm32(R & 31)) : R;
        voffA[i] = (unsigned)(R * g.lda + C) * 2u; voffB[i] = (unsigned)(Rb * g.ldb + C) * 2u; }
    const size_t kstep = (size_t)(BK * 2);
    const size_t hstepA = (size_t)HALF * g.lda * 2, hstepB = (size_t)HALF * g.ldb * 2;
    const size_t tstepA = 2 * hstepA, tstepB = 2 * hstepB;
    const unsigned ldsw = (unsigned)wid * 1024u;
    const int aoff = lds_byte(wr * 64 + fr, fq * 8), boff = lds_byte(wc * 32 + fr, fq * 8);
#define PG8_SA(b, h) (((b) * 2 + (h)) * HTB)
#define PG8_SB(b, h) ((4 + (b) * 2 + (h)) * HTB)
#define PG8_STAGE(bufoff, gbase, voff) do { _Pragma("unroll") for (int _i = 0; _i < 2; ++_i) \
        __builtin_amdgcn_global_load_lds((const unsigned*)((const char*)(gbase) + (voff)[_i]), (PG8_LAS unsigned*)(lds + (bufoff) + ldsw + _i * 8192), 16, 0, 0); } while (0)
#define PG8_LDA(dst, b, h) do { _Pragma("unroll") for (int m = 0; m < 4; ++m) _Pragma("unroll") for (int k = 0; k < 2; ++k) dst[m][k] = *(const PG8_LAS bf16x8*)(lds + PG8_SA(b, h) + aoff + m * 2048 + k * 1024); } while (0)
#define PG8_LDB(dst, b, h) do { _Pragma("unroll") for (int n = 0; n < 2; ++n) _Pragma("unroll") for (int k = 0; k < 2; ++k) dst[n][k] = *(const PG8_LAS bf16x8*)(lds + PG8_SB(b, h) + boff + n * 2048 + k * 1024); } while (0)
#define PG8_MMA(ai, bj, At, Bt) do { __builtin_amdgcn_s_setprio(1); _Pragma("unroll") for (int m = 0; m < 4; ++m) _Pragma("unroll") for (int n = 0; n < 2; ++n) _Pragma("unroll") for (int k = 0; k < 2; ++k) \
        acc[ai][bj][m][n] = __builtin_amdgcn_mfma_f32_16x16x32_bf16(Bt[n][k], At[m][k], acc[ai][bj][m][n], 0, 0, 0); __builtin_amdgcn_s_setprio(0); } while (0)
#define PG8_WAIT_V(n) asm volatile("s_waitcnt vmcnt(" #n ")" ::: "memory")
#define PG8_WAIT_L(n) asm volatile("s_waitcnt lgkmcnt(" #n ")" ::: "memory")
#define PG8_BAR __builtin_amdgcn_s_barrier()
#define PG8_SCHED __builtin_amdgcn_sched_barrier(0)
    Unit cur, nxt; int ui = 0;
    if (!S.next(0, cur)) return;
    f32x4 acc[2][2][4][2];
#pragma unroll
    for (int a = 0; a < 2; ++a)
#pragma unroll
        for (int b = 0; b < 2; ++b)
#pragma unroll
            for (int m = 0; m < 4; ++m)
#pragma unroll
                for (int n = 0; n < 2; ++n) acc[a][b][m][n] = (f32x4){0.f, 0.f, 0.f, 0.f};
    bf16x8 At[4][2], B0[2][2], B1[2][2];
    const char* cA = (const char*)g.A + (size_t)cur.pm * tstepA; const char* cB = (const char*)g.Bt + (size_t)cur.pn * tstepB;
    S.a_ready(cur);
    if constexpr (SP2) {
        PG8_STAGE(PG8_SB(0, 0), cB, voffB); PG8_STAGE(PG8_SB(0, 1), cB + hstepB, voffB); PG8_STAGE(PG8_SA(0, 0), cA, voffA); PG8_STAGE(PG8_SA(0, 1), cA + hstepA, voffA);
        if (wr == 1) PG8_BAR;
        PG8_WAIT_V(2); PG8_BAR;
        PG8_STAGE(PG8_SB(1, 0), cB + kstep, voffB); PG8_STAGE(PG8_SA(1, 0), cA + kstep, voffA); PG8_STAGE(PG8_SB(1, 1), cB + hstepB + kstep, voffB);
        PG8_WAIT_V(6); PG8_BAR;
    } else {
        PG8_STAGE(PG8_SB(0, 0), cB, voffB); PG8_STAGE(PG8_SA(0, 0), cA, voffA); PG8_STAGE(PG8_SB(0, 1), cB + hstepB, voffB); PG8_STAGE(PG8_SA(0, 1), cA + hstepA, voffA);
        if (wr == 1) PG8_BAR;
        PG8_WAIT_V(4); PG8_BAR;
        PG8_STAGE(PG8_SB(1, 0), cB + kstep, voffB); PG8_STAGE(PG8_SA(1, 0), cA + kstep, voffA); PG8_STAGE(PG8_SB(1, 1), cB + hstepB + kstep, voffB);
        PG8_WAIT_V(6); PG8_BAR;
    }
    for (;;) {
        const bool has_next = S.next(ui + 1, nxt);
        const char* nA = has_next ? (const char*)g.A + (size_t)nxt.pm * tstepA : cA; const char* nB = has_next ? (const char*)g.Bt + (size_t)nxt.pn * tstepB : cB;
        for (int t = 0; t < nt; t += 2) {
            const bool last = (t == nt - 2);
            const char* a1 = cA + (size_t)(t + 1) * kstep;
            const char* a2 = last ? nA : cA + (size_t)(t + 2) * kstep; const char* b2 = last ? nB : cB + (size_t)(t + 2) * kstep;
            const char* a3 = a2 + kstep; const char* b3 = b2 + kstep;
            if (last && has_next) S.a_ready(nxt);
            if constexpr (SP2) {
            PG8_LDB(B0, 0, 0); PG8_LDB(B1, 0, 1); PG8_SCHED; PG8_LDA(At, 0, 0); PG8_STAGE(PG8_SA(1, 1), a1 + hstepA, voffA);
            PG8_WAIT_V(8); PG8_WAIT_L(0); PG8_BAR; PG8_MMA(0, 0, At, B0); PG8_MMA(0, 1, At, B1); PG8_BAR; PG8_SCHED;
            PG8_LDA(At, 0, 1); PG8_STAGE(PG8_SB(0, 0), b2, voffB); PG8_STAGE(PG8_SB(0, 1), b2 + hstepB, voffB); PG8_STAGE(PG8_SA(0, 0), a2, voffA);
            PG8_WAIT_V(8); PG8_WAIT_L(0); PG8_BAR; PG8_MMA(1, 0, At, B0); PG8_MMA(1, 1, At, B1); PG8_BAR; PG8_SCHED;
            PG8_LDB(B0, 1, 0); PG8_LDB(B1, 1, 1); PG8_SCHED; PG8_LDA(At, 1, 0); PG8_STAGE(PG8_SA(0, 1), a2 + hstepA, voffA);
            PG8_WAIT_V(8); PG8_WAIT_L(0); PG8_BAR; PG8_MMA(0, 0, At, B0); PG8_MMA(0, 1, At, B1); PG8_BAR; PG8_SCHED;
            PG8_LDA(At, 1, 1); PG8_STAGE(PG8_SB(1, 0), b3, voffB); PG8_STAGE(PG8_SB(1, 1), b3 + hstepB, voffB); PG8_STAGE(PG8_SA(1, 0), a3, voffA);
            PG8_WAIT_V(8); PG8_WAIT_L(0); PG8_BAR; PG8_MMA(1, 0, At, B0); PG8_MMA(1, 1, At, B1); PG8_BAR; PG8_SCHED;
            } else {
            PG8_LDB(B0, 0, 0); PG8_SCHED; PG8_LDA(At, 0, 0); PG8_STAGE(PG8_SA(1, 1), a1 + hstepA, voffA);
            PG8_WAIT_L(8); PG8_BAR; PG8_WAIT_L(0); PG8_MMA(0, 0, At, B0); PG8_BAR; PG8_SCHED;
            PG8_LDB(B1, 0, 1); PG8_STAGE(PG8_SB(0, 0), b2, voffB);
            PG8_BAR; PG8_WAIT_L(0); PG8_MMA(0, 1, At, B1); PG8_BAR;
            PG8_LDA(At, 0, 1); PG8_STAGE(PG8_SA(0, 0), a2, voffA);
            PG8_BAR; PG8_WAIT_L(0); PG8_MMA(1, 0, At, B0); PG8_BAR; PG8_SCHED;
            PG8_STAGE(PG8_SB(0, 1), b2 + hstepB, voffB);
            PG8_WAIT_V(6); PG8_BAR; PG8_MMA(1, 1, At, B1); PG8_BAR;
            PG8_LDB(B0, 1, 0); PG8_SCHED; PG8_LDA(At, 1, 0); PG8_STAGE(PG8_SA(0, 1), a2 + hstepA, voffA);
            PG8_WAIT_L(8); PG8_BAR; PG8_WAIT_L(0); PG8_MMA(0, 0, At, B0); PG8_BAR; PG8_SCHED;
            PG8_LDB(B1, 1, 1); PG8_STAGE(PG8_SB(1, 0), b3, voffB);
            PG8_BAR; PG8_WAIT_L(0); PG8_MMA(0, 1, At, B1); PG8_BAR;
            PG8_LDA(At, 1, 1); PG8_STAGE(PG8_SA(1, 0), a3, voffA);
            PG8_BAR; PG8_WAIT_L(0); PG8_MMA(1, 0, At, B0); PG8_BAR; PG8_SCHED;
            PG8_STAGE(PG8_SB(1, 1), b3 + hstepB, voffB);
            PG8_WAIT_V(6); PG8_BAR; PG8_MMA(1, 1, At, B1); PG8_BAR;
            }
        }
        if constexpr (ALIGN_EPI) { if (wr == 0) PG8_BAR; }
        if constexpr (!Epi::AFTER_DRAIN) { E(acc, cur, wr, wc, fr, fq); S.done(cur); }
        if (!has_next) break;
#pragma unroll
        for (int a = 0; a < 2; ++a)
#pragma unroll
            for (int b = 0; b < 2; ++b)
#pragma unroll
                for (int m = 0; m < 4; ++m)
#pragma unroll
                    for (int n = 0; n < 2; ++n) acc[a][b][m][n] = (f32x4){0.f, 0.f, 0.f, 0.f};
        cur = nxt; cA = nA; cB = nB; ++ui;
        if constexpr (ALIGN_EPI) { if (wr == 1) PG8_BAR; }
    }
    PG8_WAIT_V(0);
    if constexpr (!ALIGN_EPI) { if (wr == 0) PG8_BAR; }
    PG8_BAR;
    if constexpr (Epi::AFTER_DRAIN) { E.fused(acc, cur, wr, wc, fr, fq, lds, wid, lane); S.done(cur); }
#undef PG8_SA
#undef PG8_SB
#undef PG8_STAGE
#undef PG8_LDA
#undef PG8_LDB
#undef PG8_MMA
#undef PG8_WAIT_V
#undef PG8_WAIT_L
#undef PG8_BAR
#undef PG8_SCHED
}
}
#define GAS __attribute__((address_space(1)))
#define LAS __attribute__((address_space(3)))
typedef unsigned short bf16;
typedef unsigned v4u __attribute__((ext_vector_type(4)));
typedef float f32x4 __attribute__((ext_vector_type(4)));
typedef short bf16x8 __attribute__((ext_vector_type(8)));
typedef GAS unsigned gu32;
typedef GAS unsigned long long gu64;
#define RLX_AGENT __ATOMIC_RELAXED, __HIP_MEMORY_SCOPE_AGENT
#define LDS_WAIT() asm volatile("s_waitcnt lgkmcnt(0)" ::: "memory")
#define VM_WAIT() asm volatile("s_waitcnt vmcnt(0)" ::: "memory")
__device__ __forceinline__ unsigned long long rt() { return __builtin_amdgcn_s_memrealtime(); }
__device__ __forceinline__ unsigned f2bf(float f) { unsigned u = __builtin_bit_cast(unsigned, f); return (u + 0x7fffu + ((u >> 16) & 1u)) >> 16; }
__device__ __forceinline__ unsigned pk2(float lo, float hi) { return f2bf(lo) | (f2bf(hi) << 16); }

#define XB_TMO      128
#define XB_XCNT(j)  (256  + 64 * (j))
#define XB_XSUB(j)  (1280 + 64 * (j))
#define XB_XGEN(j)  (2304 + 64 * (j))
#define XB_TOP      3328
#define XB_TOPGEN   3392
#define XCD_BAR_WORDS 3456
#define XB_SPIN_CAP (1u << 18)

__device__ __forceinline__ unsigned xb_ld(unsigned* p)              { return __hip_atomic_load(p, __ATOMIC_RELAXED, __HIP_MEMORY_SCOPE_AGENT); }
__device__ __forceinline__ unsigned xb_add(unsigned* p, unsigned v) { return __hip_atomic_fetch_add(p, v, __ATOMIC_RELAXED, __HIP_MEMORY_SCOPE_AGENT); }
__device__ __forceinline__ unsigned xb_xcc_id() { return (unsigned)__builtin_amdgcn_s_getreg((3 << 11) | 20) & 0xFu; }
#define XB_SPIN(cond, bar) do { unsigned _sp = 0; while (cond) { __builtin_amdgcn_s_sleep(1); \
    if ((++_sp & 255u) == 0u) { if (xb_ld(&(bar)[XB_TMO])) break; if (_sp > XB_SPIN_CAP) { atomicAdd(&(bar)[XB_TMO], 1u); break; } } } } while (0)

struct XcdBarrier {
    unsigned* bar; unsigned x;
    volatile LAS unsigned* st;
};

__device__ __forceinline__ XcdBarrier xcd_barrier_post(unsigned* bar, volatile LAS unsigned* st) {
    XcdBarrier b; b.bar = bar; b.x = xb_xcc_id(); b.st = st;
    if (threadIdx.x == 0) (void)xb_add(&bar[XB_XCNT(b.x)], 1u);
    return b;
}
__device__ __forceinline__ void xcd_barrier_complete(unsigned* bar, unsigned x, unsigned& nloc, unsigned& nx) {
    const unsigned G = gridDim.x * gridDim.y * gridDim.z;
    unsigned sum, cnt, mine, sp = 0u;
    for (;;) {
        sum = 0u; cnt = 0u; mine = 0u;
#pragma unroll
        for (unsigned j = 0; j < 16; ++j) { const unsigned c = xb_ld(&bar[XB_XCNT(j)]); sum += c; cnt += (c > 0u) ? 1u : 0u; mine = (j == x) ? c : mine; }
        if (sum == G) break;
        __builtin_amdgcn_s_sleep(1);
        if ((++sp & 255u) == 0u) { if (xb_ld(&bar[XB_TMO])) break; if (sp > XB_SPIN_CAP) { atomicAdd(&bar[XB_TMO], 1u); break; } }
    }
    nloc = mine > 0u ? mine : 1u; nx = cnt > 0u ? cnt : 1u;
}

__device__ __forceinline__ void xcd_barrier(const XcdBarrier& b) {
    asm volatile("s_waitcnt vmcnt(0)" ::: "memory");
    __syncthreads();
    if (threadIdx.x == 0) {
        unsigned* bar = b.bar;
        __builtin_amdgcn_s_waitcnt(0);
        unsigned nloc = b.st[0], nx = b.st[1];
        if (nloc == 0u) { xcd_barrier_complete(bar, b.x, nloc, nx); b.st[0] = nloc; b.st[1] = nx; }
        const unsigned old = xb_add(&bar[XB_XSUB(b.x)], 1u);
        const unsigned gen = old / nloc;
        if (old + 1u == (gen + 1u) * nloc) {
            __builtin_amdgcn_fence(__ATOMIC_RELEASE, "agent");
            asm volatile("s_waitcnt vmcnt(0)" ::: "memory");
            const unsigned og = xb_add(&bar[XB_TOP], 1u);
            const unsigned tg = og / nx;
            if (og + 1u == (tg + 1u) * nx) xb_add(&bar[XB_TOPGEN], 1u);
            else XB_SPIN(xb_ld(&bar[XB_TOPGEN]) == tg, bar);
            __builtin_amdgcn_fence(__ATOMIC_ACQUIRE, "agent");
            xb_add(&bar[XB_XGEN(b.x)], 1u);
            asm volatile("s_waitcnt vmcnt(0)" ::: "memory");
        } else {
            XB_SPIN(xb_ld(&bar[XB_XGEN(b.x)]) == gen, bar);
            __builtin_amdgcn_fence(__ATOMIC_ACQUIRE, "agent");
            asm volatile("s_waitcnt vmcnt(0)" ::: "memory");
        }
    }
    __syncthreads();
}

constexpr int NWAVES = 8;
#ifndef MK_N_LAUNCHES
#define MK_N_LAUNCHES 14
#endif
constexpr int N_PHASES = 14;
constexpr int D = 1024, M = 32768, MP = 16384, SS = 4096;
constexpr int NG = 32, TCH = 64, FF = 2816, NPROJ = 2048, NMOD = 6144, UP = 1280;
constexpr float EPS = 1e-6f;
constexpr float LOG2E = 1.4426950408889634f, LN2F = 0.6931471805599453f;
constexpr float QSCALE = 0.125f * LOG2E;
constexpr double INV_2PI = 0.15915494309189533577;

constexpr size_t MiB = 1u << 20;
constexpr size_t WS_CTL = 0, CTL_ZERO_BYTES = 65536;
constexpr size_t WS_MODF = 65536;
constexpr size_t WS_LDRE = 196608, WS_ZRE = 212992, WS_ZIM = 229376, WS_ATRE = 245760, WS_ATIM = 262144, WS_THETA = 278528;
constexpr size_t WS_W13 = 1 * MiB;
constexpr size_t WS_PTAB = 12 * MiB, WS_SBUF = 28 * MiB, WS_WIN = 44 * MiB, WS_ROPE = 48 * MiB, WS_MODP = 52 * MiB, WS_WGLU = 53 * MiB, WS_WO = 54 * MiB, WS_KLAG = 56 * MiB;
constexpr size_t WS_SSMRAW = 12 * MiB, WS_H2 = 12 * MiB, WS_W2 = 12 * MiB;
constexpr size_t WS_U = 76 * MiB, WS_Q = 116 * MiB, WS_K = 148 * MiB, WS_V = 180 * MiB, WS_TOEP = 116 * MiB, WS_G = 196 * MiB, WS_MIXA = 76 * MiB, WS_ACT = 76 * MiB, WS_END = 252 * MiB;
constexpr size_t DO_H1 = 0, DO_OB = 0, DO_LSE = 96 * MiB;
constexpr int CW_BAR = 4096;

constexpr int RING_OFF = 0, RING_BYTES = 131072;
constexpr int LDSCTL_OFF = RING_BYTES, MISC_OFF = LDSCTL_OFF + 320;
constexpr int LDS_BYTES = 147456;

typedef short v4i16_t __attribute__((ext_vector_type(4)));
typedef unsigned v2u __attribute__((ext_vector_type(2)));

struct Args { const float* in[26]; float* out; unsigned char* ws; int ph_lo, ph_hi; };

__device__ __forceinline__ float wave_sum(float v) {
#pragma unroll
    for (int o = 1; o < 64; o <<= 1) v += __shfl_xor(v, o);
    return v;
}
__device__ __forceinline__ float fexp2(float x) { return __builtin_amdgcn_exp2f(x); }
__device__ __forceinline__ float frcp(float x) { return __builtin_amdgcn_rcpf(x); }
__device__ __forceinline__ float sigm(float x) { return frcp(1.f + fexp2(-x * LOG2E)); }
__device__ __forceinline__ float gelu_tanh(float x) { const float u = 1.5957691216057308f * (x + 0.044715f * x * x * x); return x * sigm(u); }
__device__ __forceinline__ void sincos_rev(double revs, float& s, float& c) { const double fr = revs - __builtin_rint(revs); const float f = (float)fr; s = __builtin_amdgcn_sinf(f); c = __builtin_amdgcn_cosf(f); }
__device__ __forceinline__ float bf2f(unsigned short h) { return __builtin_bit_cast(float, (unsigned)h << 16); }
__device__ __forceinline__ float bflo(unsigned w) { return __builtin_bit_cast(float, w << 16); }
__device__ __forceinline__ float bfhi(unsigned w) { return __builtin_bit_cast(float, w & 0xffff0000u); }
__device__ __forceinline__ int batch_of(int row) { return row < MP ? 0 : 1 + ((row - MP) >> 12); }
__device__ __forceinline__ const float* xrow_ptr(const Args& a, int row) { return row < MP ? a.in[0] + (size_t)row * D : a.in[1] + (size_t)(row - MP) * D; }

struct SchedState {
    int c;
    __device__ bool next(int i, pg8::Unit& u) const { if (i > 0 || c >= 64) return false; u.pm = c; u.pn = c >> 1; return true; }
    __device__ __forceinline__ void a_ready(const pg8::Unit&) const {}
    __device__ __forceinline__ void done(const pg8::Unit&) const {}
};
struct SchedSsmOut {
    int c;
    __device__ bool next(int i, pg8::Unit& u) const { if (i > 0 || c >= 256) return false; const int g = c >> 3; u.pm = 2 * g + ((c >> 2) & 1); u.pn = 4 * g + (c & 3); return true; }
    __device__ __forceinline__ void a_ready(const pg8::Unit&) const {}
    __device__ __forceinline__ void done(const pg8::Unit&) const {}
};

using pg8::f32x4; using pg8::u32x4; using pg8::cvt_pk_bf16;
#define EPI_ROWS(u, ai, m) ((u).pm * 256 + (ai) * 128 + wr * 64 + (m) * 16 + fr)
__device__ __forceinline__ u32x4 pack8(const f32x4& a, const f32x4& b) { u32x4 w; w.x = cvt_pk_bf16(a[0], a[1]); w.y = cvt_pk_bf16(a[2], a[3]); w.z = cvt_pk_bf16(b[0], b[1]); w.w = cvt_pk_bf16(b[2], b[3]); return w; }

struct EpiQKV {
    static constexpr bool PERM = true, AFTER_DRAIN = false;
    bf16 *Q, *K, *V, *U; const float *cosT, *sinT;
    __device__ __forceinline__ void operator()(const f32x4 (&acc)[2][2][4][2], const pg8::Unit& u, int wr, int wc, int fr, int fq) const {
        const int kind = u.pn >> 1, ph = u.pn & 1;
        if (kind < 2) {
            bf16* dst0 = kind == 0 ? Q : K; const float sc = kind == 0 ? QSCALE : 1.f;
            const int i0 = 16 * (wc & 1) + 4 * fq;
#pragma unroll
            for (int ai = 0; ai < 2; ++ai)
#pragma unroll
                for (int m = 0; m < 4; ++m) {
                    const int row = EPI_ROWS(u, ai, m); const int pos = row < MP ? row : ((row - MP) & (SS - 1));
                    const f32x4 cs = *(const f32x4*)(cosT + pos * 32 + i0), sn = *(const f32x4*)(sinT + pos * 32 + i0);
#pragma unroll
                    for (int bj = 0; bj < 2; ++bj) {
                        const int head = ph * 4 + bj * 2 + (wc >> 1);
                        const f32x4 x1 = acc[ai][bj][m][0], x2 = acc[ai][bj][m][1];
                        const f32x4 o1 = (x1 * cs - x2 * sn) * sc, o2 = (x2 * cs + x1 * sn) * sc;
                        bf16* d = dst0 + (size_t)row * 512 + head * 64 + i0;
                        v2u w1; w1.x = cvt_pk_bf16(o1[0], o1[1]); w1.y = cvt_pk_bf16(o1[2], o1[3]);
                        v2u w2; w2.x = cvt_pk_bf16(o2[0], o2[1]); w2.y = cvt_pk_bf16(o2[2], o2[3]);
                        *(v2u*)d = w1; *(v2u*)(d + 32) = w2;
                    }
                }
        } else {
#pragma unroll
            for (int ai = 0; ai < 2; ++ai)
#pragma unroll
                for (int m = 0; m < 4; ++m) {
                    const int row = EPI_ROWS(u, ai, m);
#pragma unroll
                    for (int bj = 0; bj < 2; ++bj) {
                        const int col = ph * 256 + bj * 128 + wc * 32 + 8 * fq;
                        const u32x4 w = pack8(acc[ai][bj][m][0], acc[ai][bj][m][1]);
                        if (kind == 2) *(u32x4*)(V + (size_t)row * 512 + col) = w;
                        else { const int g = col >> 4, c = col & 15; *(u32x4*)(U + ((size_t)(g * 512 + (row >> 6)) * UP + (row & 63) * 16 + c)) = w; }
                    }
                }
        }
    }
};
struct EpiState {
    static constexpr bool PERM = true, AFTER_DRAIN = false;
    float* S;
    __device__ __forceinline__ void operator()(const f32x4 (&acc)[2][2][4][2], const pg8::Unit& u, int wr, int wc, int fr, int fq) const {
        const int g = u.pn, mt = u.pm & 1;
#pragma unroll
        for (int ai = 0; ai < 2; ++ai)
#pragma unroll
            for (int m = 0; m < 4; ++m) {
                const int chunk = mt * 256 + ai * 128 + wr * 64 + m * 16 + fr;
#pragma unroll
                for (int bj = 0; bj < 2; ++bj) { float* p = S + ((size_t)(g * 512 + chunk) * 256 + bj * 128 + wc * 32 + 8 * fq); *(f32x4*)p = acc[ai][bj][m][0]; *(f32x4*)(p + 4) = acc[ai][bj][m][1]; }
            }
    }
};
struct EpiSsmOut {
    static constexpr bool PERM = true, AFTER_DRAIN = false;
    bf16* G;
    __device__ __forceinline__ void operator()(const f32x4 (&acc)[2][2][4][2], const pg8::Unit& u, int wr, int wc, int fr, int fq) const {
        const int g = u.pn >> 2, nt = u.pn & 3, mt = u.pm & 1;
#pragma unroll
        for (int ai = 0; ai < 2; ++ai)
#pragma unroll
            for (int m = 0; m < 4; ++m) {
                const int chunk = mt * 256 + ai * 128 + wr * 64 + m * 16 + fr;
#pragma unroll
                for (int bj = 0; bj < 2; ++bj) {
                    const int ncol = nt * 256 + bj * 128 + wc * 32 + 8 * fq, t = ncol >> 4, c0 = ncol & 15;
                    f32x4 a = acc[ai][bj][m][0], b = acc[ai][bj][m][1];
#pragma unroll
                    for (int e = 0; e < 4; ++e) { a[e] = gelu_tanh(a[e]); b[e] = gelu_tanh(b[e]); }
                    *(u32x4*)(G + (size_t)(chunk * 64 + t) * 512 + g * 16 + c0) = pack8(a, b);
                }
            }
    }
};
struct EpiGlu {
    static constexpr bool PERM = true, AFTER_DRAIN = false;
    const bf16* G; const float* bglu; bf16* O;
    __device__ __forceinline__ void operator()(const f32x4 (&acc)[2][2][4][2], const pg8::Unit& u, int wr, int wc, int fr, int fq) const {
#pragma unroll
        for (int bj = 0; bj < 2; ++bj) {
            const int col = u.pn * 256 + bj * 128 + wc * 32 + 8 * fq;
            const f32x4 b0 = *(const f32x4*)(bglu + col), b1 = *(const f32x4*)(bglu + col + 4);
#pragma unroll
            for (int ai = 0; ai < 2; ++ai)
#pragma unroll
                for (int m = 0; m < 4; ++m) {
                    const int row = EPI_ROWS(u, ai, m);
                    const u32x4 gv = *(const u32x4*)(G + (size_t)row * 512 + col);
                    const f32x4 z0 = acc[ai][bj][m][0] + b0, z1 = acc[ai][bj][m][1] + b1;
                    f32x4 o0, o1;
                    o0[0] = bflo(gv.x) * sigm(z0[0]); o0[1] = bfhi(gv.x) * sigm(z0[1]); o0[2] = bflo(gv.y) * sigm(z0[2]); o0[3] = bfhi(gv.y) * sigm(z0[3]);
                    o1[0] = bflo(gv.z) * sigm(z1[0]); o1[1] = bfhi(gv.z) * sigm(z1[1]); o1[2] = bflo(gv.w) * sigm(z1[2]); o1[3] = bfhi(gv.w) * sigm(z1[3]);
                    *(u32x4*)(O + (size_t)row * 512 + col) = pack8(o0, o1);
                }
        }
    }
};
struct EpiResid {
    static constexpr bool PERM = true, AFTER_DRAIN = false;
    const float* xp; const float* xs; float* out; const float* gate;
    int inplace;
    __device__ __forceinline__ void operator()(const f32x4 (&acc)[2][2][4][2], const pg8::Unit& u, int wr, int wc, int fr, int fq) const {
#pragma unroll
        for (int ai = 0; ai < 2; ++ai)
#pragma unroll
            for (int m = 0; m < 4; ++m) {
                const int row = EPI_ROWS(u, ai, m); const int b = batch_of(row);
                const float* base = inplace ? out + (size_t)row * D : (row < MP ? xp + (size_t)row * D : xs + (size_t)(row - MP) * D);
#pragma unroll
                for (int bj = 0; bj < 2; ++bj) {
                    const int col = u.pn * 256 + bj * 128 + wc * 32 + 8 * fq;
                    const f32x4 g0 = *(const f32x4*)(gate + b * NMOD + col), g1 = *(const f32x4*)(gate + b * NMOD + col + 4);
                    const f32x4 x0 = *(const f32x4*)(base + col), x1 = *(const f32x4*)(base + col + 4);
                    *(f32x4*)(out + (size_t)row * D + col) = x0 + g0 * acc[ai][bj][m][0];
                    *(f32x4*)(out + (size_t)row * D + col + 4) = x1 + g1 * acc[ai][bj][m][1];
                }
            }
    }
};
struct EpiUp {
    static constexpr bool PERM = true, AFTER_DRAIN = false;
    bf16* O;
    __device__ __forceinline__ void operator()(const f32x4 (&acc)[2][2][4][2], const pg8::Unit& u, int wr, int wc, int fr, int fq) const {
        const int j0 = u.pn * 128 + wc * 32 + 8 * fq;
#pragma unroll
        for (int ai = 0; ai < 2; ++ai)
#pragma unroll
            for (int m = 0; m < 4; ++m) {
                const int row = EPI_ROWS(u, ai, m);
                f32x4 o0, o1;
#pragma unroll
                for (int e = 0; e < 4; ++e) { const float a0 = acc[ai][0][m][0][e], a1 = acc[ai][0][m][1][e]; o0[e] = a0 * sigm(a0) * acc[ai][1][m][0][e]; o1[e] = a1 * sigm(a1) * acc[ai][1][m][1][e]; }
                *(u32x4*)(O + (size_t)row * FF + j0) = pack8(o0, o1);
            }
    }
};

template <class Map>
__device__ __forceinline__ void transpose_item(const float* W, int K, int N, bf16* WT, LAS float* scr, int item, int lane, Map map) {
    const int nblk = N / 32, kb = item / nblk, nb = item % nblk, k0 = 64 * kb, n0 = 32 * nb;
#pragma unroll 8
    for (int i = 0; i < 32; ++i) { const int kk = 2 * i + (lane >> 5); scr[kk * 33 + (lane & 31)] = W[(size_t)(k0 + kk) * N + n0 + (lane & 31)]; }
    LDS_WAIT(); asm volatile("" ::: "memory");
    const int c = lane & 7;
#pragma unroll
    for (int j = 0; j < 4; ++j) { const int n = (lane >> 3) + 8 * j; const LAS float* s = scr + (8 * c) * 33 + n;
        v4u o; o.x = pk2(s[0 * 33], s[1 * 33]); o.y = pk2(s[2 * 33], s[3 * 33]); o.z = pk2(s[4 * 33], s[5 * 33]); o.w = pk2(s[6 * 33], s[7 * 33]);
        *(GAS v4u*)(WT + (size_t)map(n0 + n) * K + k0 + 8 * c) = o; }
    LDS_WAIT(); asm volatile("" ::: "memory");
}
struct MapId { __device__ __forceinline__ int operator()(int n) const { return n; } };
struct MapWin { __device__ __forceinline__ int operator()(int n) const { if (n >= 1024) return n; const int d = n & 63; return (n & ~63) + ((d >> 2) & 7) * 8 + (d >> 5) * 4 + (d & 3); } };
struct MapW13 { int off; __device__ __forceinline__ int operator()(int j) const { return 256 * (j >> 7) + off + (j & 127); } };

__device__ __forceinline__ void norm_row_lds(const float* xrow, bf16* orow, const LAS float* Gm, const LAS float* Sh, int lane) {
    const GAS f32x4* xr = (const GAS f32x4*)xrow + lane;
    f32x4 v[4]; float s = 0.f;
#pragma unroll
    for (int j = 0; j < 4; ++j) { v[j] = xr[64 * j]; s += (v[j].x * v[j].x + v[j].y * v[j].y) + (v[j].z * v[j].z + v[j].w * v[j].w); }
    const float rstd = __builtin_amdgcn_rsqf(wave_sum(s) * (1.f / D) + EPS);
    GAS v2u* o8 = (GAS v2u*)orow + lane;
#pragma unroll
    for (int j = 0; j < 4; ++j) { const f32x4 gm = *(const LAS f32x4*)(Gm + 256 * j + 4 * lane), sh = *(const LAS f32x4*)(Sh + 256 * j + 4 * lane);
        const f32x4 h = v[j] * rstd * gm + sh; v2u w; w.x = pk2(h.x, h.y); w.y = pk2(h.z, h.w); o8[64 * j] = w; }
}

__device__ __forceinline__ void cpow_tab(const float* ldre, const double* theta, int bi, int e, float& pre, float& pim) {
    const float mag = fexp2((float)e * ldre[bi] * LOG2E); float s, c; sincos_rev((double)e * theta[bi], s, c); pre = mag * c; pim = mag * s;
}

namespace att {
constexpr int KOFF = 0, VOFF = 32768, VROWS = 272;
__device__ __forceinline__ void attn_item(LAS unsigned char* lds, const bf16* Q, const bf16* K, const bf16* V, bf16* Ob, float* Lse, int item, int wave, int lane) {
    const int br = item >> 11, rem = item & 2047, h = rem >> 8, tb = rem & 255;
    const int ldil = 2 * br, dil = 1 << ldil;
    int seq_base, S, slot;
    if (tb < 128) { seq_base = 0; S = MP; slot = tb; } else { const int si = (tb - 128) >> 5; seq_base = MP + SS * si; S = SS; slot = (tb - 128) & 31; }
    const int r = slot & (dil - 1), kblk = slot >> ldil, nidx = S >> ldil;
    const int kbase = 128 * kblk - 64;
    __syncthreads();
    {
        const int rsub = lane >> 3, c16 = lane & 7;
#pragma unroll
        for (int i = 0; i < 4; ++i) {
            const int p = wave + 8 * i, row = 8 * p + rsub; int kidx = kbase + row; kidx = kidx < 0 ? 0 : (kidx >= nidx ? nidx - 1 : kidx);
            const size_t tok = (size_t)seq_base + r + ((size_t)kidx << ldil);
            const bf16* src = K + tok * 512 + h * 64 + ((c16 ^ (row & 7)) << 3);
            __builtin_amdgcn_global_load_lds((const unsigned*)src, (LAS unsigned*)(lds + KOFF + p * 1024), 16, 0, 0);
        }
#pragma unroll
        for (int i = 0; i < 5; ++i) {
            const int p = wave + 8 * i;
            if (p < 34) {
                const int row = 8 * p + rsub; int kidx = kbase + row; kidx = kidx < 0 ? 0 : (kidx >= nidx ? nidx - 1 : kidx);
                const size_t tok = (size_t)seq_base + r + ((size_t)kidx << ldil);
                const bf16* src = V + tok * 512 + h * 64 + ((c16 ^ (((row >> 1) & 3) << 1)) << 3);
                __builtin_amdgcn_global_load_lds((const unsigned*)src, (LAS unsigned*)(lds + VOFF + p * 1024), 16, 0, 0);
            }
        }
    }
    const int qi = lane & 15, g4 = lane >> 4;
    const int qidx = 128 * kblk + 16 * wave + qi;
    const size_t qtok = (size_t)seq_base + r + ((size_t)qidx << ldil);
    bf16x8 qf[2];
    qf[0] = *(const bf16x8*)(Q + qtok * 512 + h * 64 + 8 * g4);
    qf[1] = *(const bf16x8*)(Q + qtok * 512 + h * 64 + 32 + 8 * g4);
    asm volatile("s_waitcnt vmcnt(0)" ::: "memory");
    __syncthreads();
    f32x4 sc[9];
#pragma unroll
    for (int kt = 0; kt < 9; ++kt) {
        const int j = 16 * (wave + kt) + qi;
        const bf16x8 k0 = *(const LAS bf16x8*)(lds + KOFF + j * 128 + (((g4) ^ (j & 7)) << 4));
        const bf16x8 k1 = *(const LAS bf16x8*)(lds + KOFF + j * 128 + (((4 + g4) ^ (j & 7)) << 4));
        f32x4 z = {0.f, 0.f, 0.f, 0.f};
        z = __builtin_amdgcn_mfma_f32_16x16x32_bf16(k0, qf[0], z, 0, 0, 0);
        sc[kt] = __builtin_amdgcn_mfma_f32_16x16x32_bf16(k1, qf[1], z, 0, 0, 0);
    }
    float mx = -INFINITY;
#pragma unroll
    for (int kt = 0; kt < 9; ++kt)
#pragma unroll
        for (int e = 0; e < 4; ++e) {
            const int jj = 4 * g4 + e, kidx = kbase + 16 * (wave + kt) + jj;
            bool ok = (unsigned)kidx < (unsigned)nidx;
            if (kt == 0) ok = ok && (jj >= qi);
            if (kt == 8) ok = ok && (jj <= qi);
            const float v = ok ? sc[kt][e] : -INFINITY; sc[kt][e] = v; mx = fmaxf(mx, v);
        }
    mx = fmaxf(mx, __shfl_xor(mx, 16)); mx = fmaxf(mx, __shfl_xor(mx, 32));
    float ls = 0.f;
#pragma unroll
    for (int kt = 0; kt < 9; ++kt)
#pragma unroll
        for (int e = 0; e < 4; ++e) { const float p = fexp2(sc[kt][e] - mx); sc[kt][e] = p; ls += p; }
    ls += __shfl_xor(ls, 16); ls += __shfl_xor(ls, 32);
    f32x4 o[4];
#pragma unroll
    for (int dt = 0; dt < 4; ++dt) o[dt] = (f32x4){0.f, 0.f, 0.f, 0.f};
    const int il = lane & 15, q_ = il >> 2, p_ = il & 3;
#pragma unroll
    for (int ks = 0; ks < 5; ++ks) {
        const f32x4 pa = sc[2 * ks], pb = (ks < 4) ? sc[2 * ks + 1] : (f32x4){0.f, 0.f, 0.f, 0.f};
        const u32x4 pw = pack8(pa, pb); const bf16x8 pf = __builtin_bit_cast(bf16x8, pw);
        const int row0 = 16 * (wave + 2 * ks) + 4 * g4 + q_, row1 = row0 + 16;
#pragma unroll
        for (int dt = 0; dt < 4; ++dt) {
            const v4i16_t lo = __builtin_amdgcn_ds_read_tr16_b64_v4i16((LAS v4i16_t*)(lds + VOFF + row0 * 128 + ((dt ^ ((row0 >> 1) & 3)) << 5) + p_ * 8));
            const v4i16_t hi = __builtin_amdgcn_ds_read_tr16_b64_v4i16((LAS v4i16_t*)(lds + VOFF + row1 * 128 + ((dt ^ ((row1 >> 1) & 3)) << 5) + p_ * 8));
            const bf16x8 vf = (bf16x8){lo[0], lo[1], lo[2], lo[3], hi[0], hi[1], hi[2], hi[3]};
            o[dt] = __builtin_amdgcn_mfma_f32_16x16x32_bf16(vf, pf, o[dt], 0, 0, 0);
        }
    }
    const float inv = frcp(ls);
    bf16* od = Ob + ((size_t)br * M + qtok) * 512 + h * 64 + 4 * g4;
#pragma unroll
    for (int dt = 0; dt < 4; ++dt) { v2u w; w.x = cvt_pk_bf16(o[dt][0] * inv, o[dt][1] * inv); w.y = cvt_pk_bf16(o[dt][2] * inv, o[dt][3] * inv); *(v2u*)(od + 16 * dt) = w; }
    if (g4 == 0) Lse[((size_t)br * M + qtok) * 8 + h] = (mx + __builtin_amdgcn_logf(ls)) * LN2F;
}
}

__global__ void __launch_bounds__(NWAVES * 64, 2) mk_fwd(Args args) {
    extern __shared__ __attribute__((aligned(16))) unsigned char lds_raw[];
    LAS unsigned char* lds = (LAS unsigned char*)lds_raw;
    volatile LAS unsigned* MISC = (volatile LAS unsigned*)(lds + MISC_OFF);
    const int tid = threadIdx.x, lane = tid & 63, wave = __builtin_amdgcn_readfirstlane(tid >> 6);
    const int G = gridDim.x, bx = blockIdx.x;
    const int vcu = (G % 8 == 0) ? (bx % 8) * (G / 8) + bx / 8 : bx;
    const int gw = vcu * NWAVES + wave, NGW = G * NWAVES;
    const int gtid = gw * 64 + lane, NT = NGW * 64;
    unsigned char* ws = args.ws;
    gu32* ctl = (gu32*)(ws + WS_CTL);
    for (int u = tid; u < (LDS_BYTES - LDSCTL_OFF) / 4; u += NWAVES * 64) ((LAS unsigned*)(lds + LDSCTL_OFF))[u] = 0u;
    __syncthreads();
    XcdBarrier bar; bar.bar = (unsigned*)(ctl + CW_BAR); bar.x = 0; bar.st = nullptr;
    if (MK_N_LAUNCHES == 1) bar = xcd_barrier_post((unsigned*)(ctl + CW_BAR), MISC + 8);
    const int lo = args.ph_lo, hi = args.ph_hi;
#define IN(k) (lo <= (k) && (k) < hi)
#define SEAM(k) do { if (IN(k) && IN((k) + 1)) xcd_barrier(bar); } while (0)

    float* modf = (float*)(ws + WS_MODF); float* modp = (float*)(ws + WS_MODP);
    float* t_ldre = (float*)(ws + WS_LDRE); float* t_zre = (float*)(ws + WS_ZRE); float* t_zim = (float*)(ws + WS_ZIM); float* t_atre = (float*)(ws + WS_ATRE); float* t_atim = (float*)(ws + WS_ATIM); double* t_theta = (double*)(ws + WS_THETA);
    bf16* W13T = (bf16*)(ws + WS_W13); bf16* WinT = (bf16*)(ws + WS_WIN); bf16* WgluT = (bf16*)(ws + WS_WGLU); bf16* WoT = (bf16*)(ws + WS_WO); bf16* W2T = (bf16*)(ws + WS_W2);
    bf16* Ptab = (bf16*)(ws + WS_PTAB); float* Sbuf = (float*)(ws + WS_SBUF); bf16* Klag = (bf16*)(ws + WS_KLAG); bf16* Toep = (bf16*)(ws + WS_TOEP);
    float* cosT = (float*)(ws + WS_ROPE); float* sinT = cosT + 16384 * 32;
    bf16* Ub = (bf16*)(ws + WS_U); bf16* Qb = (bf16*)(ws + WS_Q); bf16* Kb = (bf16*)(ws + WS_K); bf16* Vb = (bf16*)(ws + WS_V);
    bf16* Gb = (bf16*)(ws + WS_G); bf16* SsmRaw = (bf16*)(ws + WS_SSMRAW); bf16* MixA = (bf16*)(ws + WS_MIXA); bf16* H2 = (bf16*)(ws + WS_H2); bf16* Act = (bf16*)(ws + WS_ACT);
    bf16* H1 = (bf16*)((unsigned char*)args.out + DO_H1); bf16* Ob = (bf16*)((unsigned char*)args.out + DO_OB); float* Lse = (float*)((unsigned char*)args.out + DO_LSE);
    LAS float* scr = (LAS float*)(lds + RING_OFF + wave * 16384);

    if (IN(0)) {
        constexpr int I_IN = 16 * 64, I_GLU = 8 * 16, I_O = 16 * 32, I_1 = 16 * 88;
        constexpr int NITEMS = I_IN + I_GLU + I_O + 2 * I_1;
        for (int it = gw; it < NITEMS; it += NGW) {
            int r = it;
            if (r < I_IN) { transpose_item(args.in[7], D, NPROJ, WinT, scr, r, lane, MapWin{}); continue; } r -= I_IN;
            if (r < I_GLU) { transpose_item(args.in[16], 512, 512, WgluT, scr, r, lane, MapId{}); continue; } r -= I_GLU;
            if (r < I_O) { transpose_item(args.in[20], D, D, WoT, scr, r, lane, MapId{}); continue; } r -= I_O;
            if (r < I_1) { transpose_item(args.in[22], D, FF, W13T, scr, r, lane, MapW13{0}); continue; } r -= I_1;
            transpose_item(args.in[23], D, FF, W13T, scr, r, lane, MapW13{128});
        }
        for (int task = gw; task < 96 * 8; task += NGW) {
            const int cb = task % 96, ks = task / 96, n = 64 * cb + lane;
            const float* W = args.in[4] + (size_t)(128 * ks) * NMOD + n; const float* cp = args.in[2] + 128 * ks; const float* cs = args.in[3] + 128 * ks;
            float a0 = 0.f, a1 = 0.f, a2 = 0.f, a3 = 0.f, a4 = 0.f;
#pragma unroll 4
            for (int k = 0; k < 128; ++k) { const float w = W[(size_t)k * NMOD];
                const float c0 = cp[k], c1 = cs[k], c2 = cs[1024 + k], c3 = cs[2048 + k], c4 = cs[3072 + k];
                a0 += c0 * sigm(c0) * w; a1 += c1 * sigm(c1) * w; a2 += c2 * sigm(c2) * w; a3 += c3 * sigm(c3) * w; a4 += c4 * sigm(c4) * w; }
            float* pp = modp + (size_t)(ks * 5) * NMOD + n;
            pp[0] = a0; pp[NMOD] = a1; pp[2 * NMOD] = a2; pp[3 * NMOD] = a3; pp[4 * NMOD] = a4;
        }
        for (int idx = gtid; idx < 16384 * 32; idx += NT) { const int pos = idx >> 5, i = idx & 31;
            const float inv = fexp2(-(float)i * 0.41524101186092033f); const float ang = (float)pos * inv; float s, c; sincos_rev((double)ang * INV_2PI, s, c); cosT[idx] = c; sinT[idx] = s; }
        for (int idx = gtid; idx < 4096; idx += NT) {
            const float dt = fexp2(args.in[10][idx >> 6] * LOG2E), lr = args.in[8][idx], li = args.in[9][idx];
            const float ldre = lr * dt; const double th = (double)li * (double)dt * INV_2PI;
            float s, c; sincos_rev(th, s, c); const float mag = fexp2(ldre * LOG2E), are = mag * c, aim = mag * s;
            const float nr = are - 1.f, den = lr * lr + li * li;
            t_ldre[idx] = ldre; t_theta[idx] = th; t_zre[idx] = (nr * lr + aim * li) / den; t_zim[idx] = (aim * lr - nr * li) / den;
            float sT, cT; sincos_rev(64.0 * th, sT, cT); const float mT = fexp2(64.f * ldre * LOG2E); t_atre[idx] = mT * cT; t_atim[idx] = mT * sT;
        }
    }
    SEAM(0);

    if (IN(1)) {
        for (int e = gtid; e < 5 * NMOD; e += NT) { const int b = e / NMOD, n = e % NMOD; float v = args.in[5][n];
#pragma unroll
            for (int ks = 0; ks < 8; ++ks) v += modp[(size_t)(ks * 5 + b) * NMOD + n];
            modf[e] = v; }
        LAS float* Gm = (LAS float*)(lds + RING_OFF + 65536); LAS float* Sh = Gm + 1024;
        for (int rb = vcu; rb < M / 128; rb += G) {
            const int row0 = rb * 128, b = batch_of(row0);
            __syncthreads();
            for (int k = tid; k < 1024; k += NWAVES * 64) { float sc = args.in[5][1024 + k], sh = args.in[5][k];
#pragma unroll
                for (int ks = 0; ks < 8; ++ks) { sc += modp[(size_t)(ks * 5 + b) * NMOD + 1024 + k]; sh += modp[(size_t)(ks * 5 + b) * NMOD + k]; }
                Gm[k] = args.in[6][k] * (1.f + sc); Sh[k] = sh; }
            __syncthreads();
            for (int i = 0; i < 16; ++i) { const int row = row0 + wave * 16 + i; norm_row_lds(xrow_ptr(args, row), H1 + (size_t)row * D, Gm, Sh, lane); }
        }
        for (int e = gtid; e < 32 * 127 * 16; e += NT) {
            const int c = e & 15, q = e >> 4, ti = q % 127, g = q / 127, tau = ti - 63, at = tau < 0 ? -tau : tau;
            float acc[16];
#pragma unroll
            for (int j = 0; j < 16; ++j) acc[j] = 0.f;
            for (int dir = 0; dir < 2; ++dir) {
                if ((dir == 0 && tau < 0) || (dir == 1 && tau > 0)) continue;
                const int gb = (dir * 32 + g) * 64;
                for (int n = 0; n < 64; ++n) {
                    const int bi = gb + n; float pre, pim; cpow_tab(t_ldre, t_theta, bi, at, pre, pim);
                    const float cr = args.in[13][(size_t)((dir * 32 + g) * 16 + c) * 64 + n], ci = args.in[14][(size_t)((dir * 32 + g) * 16 + c) * 64 + n];
                    const float wre = cr * pre - ci * pim, wim = cr * pim + ci * pre;
                    const float zr = t_zre[bi], zi = t_zim[bi], wzr = wre * zr - wim * zi, wzi = wre * zi + wim * zr;
                    const f32x4* br = (const f32x4*)(args.in[11] + (size_t)bi * 16); const f32x4* bm = (const f32x4*)(args.in[12] + (size_t)bi * 16);
#pragma unroll
                    for (int j4 = 0; j4 < 4; ++j4) { const f32x4 b1 = br[j4], b2 = bm[j4];
#pragma unroll
                        for (int e2 = 0; e2 < 4; ++e2) acc[4 * j4 + e2] += wzr * b1[e2] - wzi * b2[e2]; }
                }
            }
            if (tau == 0) { const float dsk = args.in[15][16 * g + c];
#pragma unroll
                for (int j = 0; j < 16; ++j) acc[j] += (j == c) ? dsk : 0.f; }
            v4u o0, o1; o0.x = pk2(acc[0], acc[1]); o0.y = pk2(acc[2], acc[3]); o0.z = pk2(acc[4], acc[5]); o0.w = pk2(acc[6], acc[7]);
            o1.x = pk2(acc[8], acc[9]); o1.y = pk2(acc[10], acc[11]); o1.z = pk2(acc[12], acc[13]); o1.w = pk2(acc[14], acc[15]);
            v4u* dst = (v4u*)(Klag + (size_t)e * 16); dst[0] = o0; dst[1] = o1;
        }
        for (int e = gtid; e < 32 * 2 * 64 * 64; e += NT) {
            const int s = e & 63, n = (e >> 6) & 63, dir = (e >> 12) & 1, g = e >> 13, bi = (dir * 32 + g) * 64 + n;
            float pre, pim; cpow_tab(t_ldre, t_theta, bi, dir == 0 ? 63 - s : s, pre, pim);
            const float zr = t_zre[bi], zi = t_zim[bi], wr_ = pre * zr - pim * zi, wi_ = pre * zi + pim * zr;
            const f32x4* br = (const f32x4*)(args.in[11] + (size_t)bi * 16); const f32x4* bm = (const f32x4*)(args.in[12] + (size_t)bi * 16);
            float re[16], im[16];
#pragma unroll
            for (int j4 = 0; j4 < 4; ++j4) { const f32x4 b1 = br[j4], b2 = bm[j4];
#pragma unroll
                for (int e2 = 0; e2 < 4; ++e2) { re[4 * j4 + e2] = wr_ * b1[e2] - wi_ * b2[e2]; im[4 * j4 + e2] = wr_ * b2[e2] + wi_ * b1[e2]; } }
            bf16* d0 = Ptab + ((size_t)(g * 256 + dir * 128 + 2 * n) * 1024 + s * 16);
            v4u o; o.x = pk2(re[0], re[1]); o.y = pk2(re[2], re[3]); o.z = pk2(re[4], re[5]); o.w = pk2(re[6], re[7]); *(v4u*)d0 = o;
            o.x = pk2(re[8], re[9]); o.y = pk2(re[10], re[11]); o.z = pk2(re[12], re[13]); o.w = pk2(re[14], re[15]); *(v4u*)(d0 + 8) = o;
            o.x = pk2(im[0], im[1]); o.y = pk2(im[2], im[3]); o.z = pk2(im[4], im[5]); o.w = pk2(im[6], im[7]); *(v4u*)(d0 + 1024) = o;
            o.x = pk2(im[8], im[9]); o.y = pk2(im[10], im[11]); o.z = pk2(im[12], im[13]); o.w = pk2(im[14], im[15]); *(v4u*)(d0 + 1032) = o;
        }
    }
    SEAM(1);

    if (IN(2)) {
        pg8::Gemm g{H1, WinT, M, NPROJ, D, D, D}; pg8::StaticOrder S; S.init(M, NPROJ, G, bx);
        EpiQKV E{Qb, Kb, Vb, Ub, cosT, sinT};
        pg8::gemm_phase<EpiQKV, pg8::StaticOrder, true, true>(lds + RING_OFF, g, S, E);
    }
    SEAM(2);

    if (IN(3)) {
        { pg8::Gemm g{Ub, Ptab, NG * 512, NG * 256, 1024, UP, 1024}; SchedState S{bx}; EpiState E{Sbuf};
          pg8::gemm_phase<EpiState, SchedState, true, true>(lds + RING_OFF, g, S, E); }
        for (int it = bx; it < 3 * 8 * 256; it += G) att::attn_item(lds + RING_OFF, Qb, Kb, Vb, Ob, Lse, it, wave, lane);
    }
    SEAM(3);

    if (IN(4)) {
        if (bx < 40) {
            const int ch = wave * 40 + bx; int seq, g, dir;
            if (ch < 64) { seq = 0; g = ch >> 1; dir = ch & 1; } else { const int q = ch - 64; seq = 1 + (q >> 6); g = (q >> 1) & 31; dir = q & 1; }
            const int nc = seq == 0 ? 256 : 64, chunk0 = seq == 0 ? 0 : 256 + 64 * (seq - 1);
            const int bi = (dir * 32 + g) * 64 + lane; const float ar = t_atre[bi], ai = t_atim[bi];
            float hr = 0.f, hi_ = 0.f;
            for (int i0 = 0; i0 < nc; i0 += 8) {
                float sr[8], si[8];
#pragma unroll
                for (int j = 0; j < 8; ++j) { const int c = dir == 0 ? i0 + j : nc - 1 - (i0 + j); const float* sp = Sbuf + ((size_t)(g * 512 + chunk0 + c) * 256 + dir * 128 + 2 * lane); sr[j] = sp[0]; si[j] = sp[1]; }
#pragma unroll
                for (int j = 0; j < 8; ++j) { const int c = dir == 0 ? i0 + j : nc - 1 - (i0 + j);
                    *(unsigned*)(Ub + ((size_t)(g * 512 + chunk0 + c) * UP + 1024 + dir * 128 + 2 * lane)) = pk2(hr, hi_);
                    const float nr = ar * hr - ai * hi_ + sr[j], ni = ar * hi_ + ai * hr + si[j]; hr = nr; hi_ = ni; }
            }
        }
        for (int e = gtid; e < 32 * 64 * 16 * 64; e += NT) {
            const int s = e & 63, c = (e >> 6) & 15, t = (e >> 10) & 63, g = e >> 16;
            const v4u* src = (const v4u*)(Klag + ((size_t)((g * 127 + (t - s + 63)) * 16 + c) * 16));
            v4u* dst = (v4u*)(Toep + ((size_t)(g * 1024 + t * 16 + c) * UP + s * 16));
            const v4u a = src[0], b = src[1]; dst[0] = a; dst[1] = b;
        }
        for (int e = gtid; e < 32 * 64 * 2 * 64; e += NT) {
            const int n = e & 63, dir = (e >> 6) & 1, t = (e >> 7) & 63, g = e >> 13, bi = (dir * 32 + g) * 64 + n;
            float pre, pim; cpow_tab(t_ldre, t_theta, bi, dir == 0 ? t + 1 : 64 - t, pre, pim);
#pragma unroll 4
            for (int c = 0; c < 16; ++c) {
                const float cr = args.in[13][(size_t)((dir * 32 + g) * 16 + c) * 64 + n], ci = args.in[14][(size_t)((dir * 32 + g) * 16 + c) * 64 + n];
                *(unsigned*)(Toep + ((size_t)(g * 1024 + t * 16 + c) * UP + 1024 + dir * 128 + 2 * n)) = pk2(cr * pre - ci * pim, -(cr * pim + ci * pre));
            }
        }
    }
    SEAM(4);

    if (IN(5)) {
        pg8::Gemm g{Ub, Toep, NG * 512, NG * 1024, UP, UP, UP}; SchedSsmOut S{bx}; EpiSsmOut E{Gb};
        pg8::gemm_phase<EpiSsmOut, SchedSsmOut, true, true>(lds + RING_OFF, g, S, E);
    }
    SEAM(5);

    if (IN(6)) {
        pg8::Gemm g{Gb, WgluT, M, 512, 512, 512, 512}; pg8::StaticOrder S; S.init(M, 512, G, bx);
        EpiGlu E{Gb, args.in[17], SsmRaw};
        pg8::gemm_phase<EpiGlu, pg8::StaticOrder, true, true>(lds + RING_OFF, g, S, E);
    }
    SEAM(6);

    if (IN(7)) {
        for (int t = gw; t < M; t += NGW) {
            const int hh = lane >> 3;
            float l0 = Lse[(size_t)t * 8 + hh], l1 = Lse[((size_t)M + t) * 8 + hh], l2 = Lse[((size_t)2 * M + t) * 8 + hh];
            const float lm = fmaxf(l0, fmaxf(l1, l2));
            float w0 = fexp2((l0 - lm) * LOG2E), w1 = fexp2((l1 - lm) * LOG2E), w2 = fexp2((l2 - lm) * LOG2E);
            const float wi = frcp(w0 + w1 + w2); w0 *= wi; w1 *= wi; w2 *= wi;
            const v4u a = *(const v4u*)(Ob + (size_t)t * 512 + 8 * lane), b = *(const v4u*)(Ob + ((size_t)M + t) * 512 + 8 * lane), c = *(const v4u*)(Ob + ((size_t)2 * M + t) * 512 + 8 * lane);
            float v[8];
            v[0] = w0 * bflo(a.x) + w1 * bflo(b.x) + w2 * bflo(c.x); v[1] = w0 * bfhi(a.x) + w1 * bfhi(b.x) + w2 * bfhi(c.x);
            v[2] = w0 * bflo(a.y) + w1 * bflo(b.y) + w2 * bflo(c.y); v[3] = w0 * bfhi(a.y) + w1 * bfhi(b.y) + w2 * bfhi(c.y);
            v[4] = w0 * bflo(a.z) + w1 * bflo(b.z) + w2 * bflo(c.z); v[5] = w0 * bfhi(a.z) + w1 * bfhi(b.z) + w2 * bfhi(c.z);
            v[6] = w0 * bflo(a.w) + w1 * bflo(b.w) + w2 * bflo(c.w); v[7] = w0 * bfhi(a.w) + w1 * bfhi(b.w) + w2 * bfhi(c.w);
            float s = 0.f;
#pragma unroll
            for (int j = 0; j < 8; ++j) s += v[j] * v[j];
            const float rs = __builtin_amdgcn_rsqf(wave_sum(s) * (1.f / 512.f) + EPS);
            const f32x4 g0 = *(const f32x4*)(args.in[18] + 8 * lane), g1 = *(const f32x4*)(args.in[18] + 8 * lane + 4);
            v4u o; o.x = pk2(v[0] * rs * g0[0], v[1] * rs * g0[1]); o.y = pk2(v[2] * rs * g0[2], v[3] * rs * g0[3]); o.z = pk2(v[4] * rs * g1[0], v[5] * rs * g1[1]); o.w = pk2(v[6] * rs * g1[2], v[7] * rs * g1[3]);
            *(v4u*)(MixA + (size_t)t * D + 8 * lane) = o;
            const v4u q = *(const v4u*)(SsmRaw + (size_t)t * 512 + 8 * lane);
            float u[8] = {bflo(q.x), bfhi(q.x), bflo(q.y), bfhi(q.y), bflo(q.z), bfhi(q.z), bflo(q.w), bfhi(q.w)};
            float s2 = 0.f;
#pragma unroll
            for (int j = 0; j < 8; ++j) s2 += u[j] * u[j];
            const float rs2 = __builtin_amdgcn_rsqf(wave_sum(s2) * (1.f / 512.f) + EPS);
            const f32x4 h0 = *(const f32x4*)(args.in[19] + 8 * lane), h1 = *(const f32x4*)(args.in[19] + 8 * lane + 4);
            o.x = pk2(u[0] * rs2 * h0[0], u[1] * rs2 * h0[1]); o.y = pk2(u[2] * rs2 * h0[2], u[3] * rs2 * h0[3]); o.z = pk2(u[4] * rs2 * h1[0], u[5] * rs2 * h1[1]); o.w = pk2(u[6] * rs2 * h1[2], u[7] * rs2 * h1[3]);
            *(v4u*)(MixA + (size_t)t * D + 512 + 8 * lane) = o;
        }
    }
    SEAM(7);

    if (IN(8)) {
        pg8::Gemm g{MixA, WoT, M, D, D, D, D}; pg8::StaticOrder S; S.init(M, D, G, bx);
        EpiResid E{args.in[0], args.in[1], args.out, modf + 2048, 0};
        pg8::gemm_phase<EpiResid, pg8::StaticOrder, true, true>(lds + RING_OFF, g, S, E);
    }
    SEAM(8);

    if (IN(9)) {
        LAS float* Gm = (LAS float*)(lds + RING_OFF + 65536); LAS float* Sh = Gm + 1024;
        for (int rb = vcu; rb < M / 128; rb += G) {
            const int row0 = rb * 128, b = batch_of(row0);
            __syncthreads();
            for (int k = tid; k < 1024; k += NWAVES * 64) { Gm[k] = args.in[21][k] * (1.f + modf[b * NMOD + 4096 + k]); Sh[k] = modf[b * NMOD + 3072 + k]; }
            __syncthreads();
            for (int i = 0; i < 16; ++i) { const int row = row0 + wave * 16 + i; norm_row_lds(args.out + (size_t)row * D, H2 + (size_t)row * D, Gm, Sh, lane); }
        }
    }
    SEAM(9);

    if (IN(10)) {
        pg8::Gemm g{H2, W13T, M, 2 * FF, D, D, D}; pg8::StaticOrder S; S.init(M, 2 * FF, G, bx);
        EpiUp E{Act};
        pg8::gemm_phase<EpiUp, pg8::StaticOrder, true, true>(lds + RING_OFF, g, S, E);
    }
    SEAM(10);

    if (IN(11)) {
        for (int it = gw; it < 44 * 32; it += NGW) transpose_item(args.in[24], FF, D, W2T, scr, it, lane, MapId{});
    }
    SEAM(11);

    if (IN(12)) {
        pg8::Gemm g{Act, W2T, M, D, FF, FF, FF}; pg8::StaticOrder S; S.init(M, D, G, bx);
        EpiResid E{args.in[0], args.in[1], args.out, modf + 5120, 1};
        pg8::gemm_phase<EpiResid, pg8::StaticOrder, true, true>(lds + RING_OFF, g, S, E);
    }
    SEAM(12);

    if (IN(13)) {
        for (int row = gw; row < M; row += NGW) {
            GAS f32x4* xr = (GAS f32x4*)(args.out + (size_t)row * D) + lane;
            f32x4 v[4]; float s = 0.f;
#pragma unroll
            for (int j = 0; j < 4; ++j) { v[j] = xr[64 * j]; s += (v[j].x * v[j].x + v[j].y * v[j].y) + (v[j].z * v[j].z + v[j].w * v[j].w); }
            const float rstd = __builtin_amdgcn_rsqf(wave_sum(s) * (1.f / D) + EPS);
#pragma unroll
            for (int j = 0; j < 4; ++j) { const f32x4 gg = *(const f32x4*)(args.in[25] + 256 * j + 4 * lane); xr[64 * j] = v[j] * rstd * gg; }
        }
    }
#undef IN
#undef SEAM
}

extern "C" void kernel_launch(void* const* d_in, const int* in_sizes, int n_in, void* d_out, int out_size, void* d_ws, size_t ws_size, hipStream_t stream) {
    static int grid = 0;
    if (grid == 0) {
        if (n_in != 26 || in_sizes[0] != MP * D || out_size != M * D || ws_size < WS_END) { fprintf(stderr, "kernel_launch: unexpected shapes (n_in %d, in0 %d, out %d, ws %zu); nothing launched\n", n_in, n_in > 0 ? in_sizes[0] : -1, out_size, ws_size); grid = -1; return; }
        int dev = 0, cus = 0, per_cu = 0;
        if (hipGetDevice(&dev) != hipSuccess || hipDeviceGetAttribute(&cus, hipDeviceAttributeMultiprocessorCount, dev) != hipSuccess) { grid = -1; return; }
        if (hipFuncSetAttribute((const void*)mk_fwd, hipFuncAttributeMaxDynamicSharedMemorySize, LDS_BYTES) != hipSuccess) { fprintf(stderr, "kernel_launch: hipFuncSetAttribute failed\n"); grid = -1; return; }
        if (hipOccupancyMaxActiveBlocksPerMultiprocessor(&per_cu, (const void*)mk_fwd, NWAVES * 64, LDS_BYTES) != hipSuccess || per_cu < 1) fprintf(stderr, "kernel_launch: occupancy query says %d\n", per_cu);
        (void)hipGetLastError();
        grid = cus;
    }
    if (grid < 0) return;
    if (hipMemsetAsync((char*)d_ws + WS_CTL, 0, CTL_ZERO_BYTES, stream) != hipSuccess) return;
    Args a{};
    for (int i = 0; i < 26; ++i) a.in[i] = (const float*)d_in[i];
    a.out = (float*)d_out; a.ws = (unsigned char*)d_ws;
    if (MK_N_LAUNCHES == 1) { a.ph_lo = 0; a.ph_hi = N_PHASES; hipLaunchKernelGGL(mk_fwd, dim3(grid), dim3(NWAVES * 64), LDS_BYTES, stream, a); }
    else for (int p = 0; p < N_PHASES; ++p) { a.ph_lo = p; a.ph_hi = p + 1; hipLaunchKernelGGL(mk_fwd, dim3(grid), dim3(NWAVES * 64), LDS_BYTES, stream, a); }
}
```

```cpp
#include <hip/hip_runtime.h>
#include <cstdio>
#include <cstdint>
#include <cmath>
namespace pg8 {
#define PG8_LAS __attribute__((address_space(3)))
typedef unsigned short bf16_t;
typedef short bf16x8 __attribute__((ext_vector_type(8)));
typedef float f32x4 __attribute__((ext_vector_type(4)));
typedef unsigned u32x4 __attribute__((ext_vector_type(4)));
constexpr int BM = 256, BK = 64, HALF = 128, HTB = HALF * BK * 2  , STAGE_BYTES = 8 * HTB, NXCD = 8, WGM = 8;

__host__ __device__ __forceinline__ int lds_byte(int r, int c) { const int st = (r >> 4) * 2 + (c >> 5), rr = r & 15, cc = c & 31, ob = rr * 64 + cc * 2; return st * 1024 + (ob ^ (((ob >> 9) & 1) << 5)); }
__host__ __device__ __forceinline__ void stage_rc(int b, int& R, int& C) { const int st = b / 1024, sb = b % 1024, swz = sb ^ (((sb >> 9) & 1) << 5); R = (st >> 1) * 16 + swz / 64; C = (st & 1) * 32 + (swz % 64) / 2; }
__host__ __device__ __forceinline__ int perm32(int rho) { const int n = rho >> 4, i = rho & 15; return 8 * (i >> 2) + 4 * n + (i & 3); }

struct Unit { int pm, pn; int ty = 0; };
struct Gemm { const bf16_t* A; const bf16_t* Bt; int M, N, K, lda, ldb; const bf16_t* A2 = nullptr; const bf16_t* Bt2 = nullptr; };

struct StaticOrder {
    int nM, nN, nwg, G, c;
    __host__ __device__ void init(int M, int N, int G_, int c_) { nM = M / BM; nN = N / BM; nwg = nM * nN; G = G_; c = c_; }
    __host__ __device__ bool next(int i, Unit& u) const {
        const long L = (long)i * G + c; if (L >= nwg) return false;
        int wgid = (int)L; { const int q = nwg / NXCD, r = nwg % NXCD, xcd = wgid % NXCD, off = wgid / NXCD; wgid = (xcd < r ? xcd * (q + 1) : r * (q + 1) + (xcd - r) * q) + off; }
        const int nig = WGM * nN, gid = wgid / nig, fm = gid * WGM, gsz = (nM - fm) < WGM ? (nM - fm) : WGM;
        u.pm = fm + ((wgid % nig) % gsz); u.pn = (wgid % nig) / gsz; return true;
    }
    __device__ __forceinline__ void a_ready(const Unit&) const {}
    __device__ __forceinline__ void done(const Unit&) const {}
};

__device__ __forceinline__ unsigned cvt_pk_bf16(float lo, float hi) { unsigned r; asm volatile("v_cvt_pk_bf16_f32 %0, %1, %2" : "=v"(r) : "v"(lo), "v"(hi)); return r; }
template <class Epi, class Sched, bool ALIGN_EPI = false, bool SP2 = false>
__device__ __forceinline__ void gemm_phase(PG8_LAS unsigned char* lds, const Gemm g, const Sched& S, const Epi& E) {
    const int tid = threadIdx.x, wid = __builtin_amdgcn_readfirstlane(tid >> 6), lane = tid & 63, wr = wid >> 2, wc = wid & 3, fr = lane & 15, fq = lane >> 4;
    const int K = g.K, nt = K / BK;
    unsigned voffA[2], voffB[2];
#pragma unroll
    for (int i = 0; i < 2; ++i) { int R, C; stage_rc(tid * 16 + i * 8192, R, C); const int Rb = Epi::PERM ? ((R & ~31) + perm32(R & 31)) : R;
        voffA[i] = (unsigned)(R * g.lda + C) * 2u; voffB[i] = (unsigned)(Rb * g.ldb + C) * 2u; }
    const size_t kstep = (size_t)(BK * 2);
    const size_t hstepA = (size_t)HALF * g.lda * 2, hstepB = (size_t)HALF * g.ldb * 2;
    const size_t tstepA = 2 * hstepA, tstepB = 2 * hstepB;
    const unsigned ldsw = (unsigned)wid * 1024u;
    const int aoff = lds_byte(wr * 64 + fr, fq * 8), boff = lds_byte(wc * 32 + fr, fq * 8);
#define PG8_SA(b, h) (((b) * 2 + (h)) * HTB)
#define PG8_SB(b, h) ((4 + (b) * 2 + (h)) * HTB)
#define PG8_STAGE(bufoff, gbase, voff) do { _Pragma("unroll") for (int _i = 0; _i < 2; ++_i) \
        __builtin_amdgcn_global_load_lds((const unsigned*)((const char*)(gbase) + (voff)[_i]), (PG8_LAS unsigned*)(lds + (bufoff) + ldsw + _i * 8192), 16, 0, 0); } while (0)
#define PG8_LDA(dst, b, h) do { _Pragma("unroll") for (int m = 0; m < 4; ++m) _Pragma("unroll") for (int k = 0; k < 2; ++k) dst[m][k] = *(const PG8_LAS bf16x8*)(lds + PG8_SA(b, h) + aoff + m * 2048 + k * 1024); } while (0)
#define PG8_LDB(dst, b, h) do { _Pragma("unroll") for (int n = 0; n < 2; ++n) _Pragma("unroll") for (int k = 0; k < 2; ++k) dst[n][k] = *(const PG8_LAS bf16x8*)(lds + PG8_SB(b, h) + boff + n * 2048 + k * 1024); } while (0)
#define PG8_MMA(ai, bj, At, Bt) do { __builtin_amdgcn_s_setprio(1); _Pragma("unroll") for (int m = 0; m < 4; ++m) _Pragma("unroll") for (int n = 0; n < 2; ++n) _Pragma("unroll") for (int k = 0; k < 2; ++k) \
        acc[ai][bj][m][n] = __builtin_amdgcn_mfma_f32_16x16x32_bf16(Bt[n][k], At[m][k], acc[ai][bj][m][n], 0, 0, 0); __builtin_amdgcn_s_setprio(0); } while (0)
#define PG8_WAIT_V(n) asm volatile("s_waitcnt vmcnt(" #n ")" ::: "memory")
#define PG8_WAIT_L(n) asm volatile("s_waitcnt lgkmcnt(" #n ")" ::: "memory")
#define PG8_BAR __builtin_amdgcn_s_barrier()
#define PG8_SCHED __builtin_amdgcn_sched_barrier(0)
    Unit cur, nxt; int ui = 0;
    if (!S.next(0, cur)) return;
    f32x4 acc[2][2][4][2];
#pragma unroll
    for (int a = 0; a < 2; ++a)
#pragma unroll
        for (int b = 0; b < 2; ++b)
#pragma unroll
            for (int m = 0; m < 4; ++m)
#pragma unroll
                for (int n = 0; n < 2; ++n) acc[a][b][m][n] = (f32x4){0.f, 0.f, 0.f, 0.f};
    bf16x8 At[4][2], B0[2][2], B1[2][2];
    const char* cA = (const char*)(cur.ty ? g.A2 : g.A) + (size_t)cur.pm * tstepA; const char* cB = (const char*)(cur.ty ? g.Bt2 : g.Bt) + (size_t)cur.pn * tstepB;
    S.a_ready(cur);
    if constexpr (SP2) {
        PG8_STAGE(PG8_SB(0, 0), cB, voffB); PG8_STAGE(PG8_SB(0, 1), cB + hstepB, voffB); PG8_STAGE(PG8_SA(0, 0), cA, voffA); PG8_STAGE(PG8_SA(0, 1), cA + hstepA, voffA);
        if (wr == 1) PG8_BAR;
        PG8_WAIT_V(2); PG8_BAR;
        PG8_STAGE(PG8_SB(1, 0), cB + kstep, voffB); PG8_STAGE(PG8_SA(1, 0), cA + kstep, voffA); PG8_STAGE(PG8_SB(1, 1), cB + hstepB + kstep, voffB);
        PG8_WAIT_V(6); PG8_BAR;
    } else {
        PG8_STAGE(PG8_SB(0, 0), cB, voffB); PG8_STAGE(PG8_SA(0, 0), cA, voffA); PG8_STAGE(PG8_SB(0, 1), cB + hstepB, voffB); PG8_STAGE(PG8_SA(0, 1), cA + hstepA, voffA);
        if (wr == 1) PG8_BAR;
        PG8_WAIT_V(4); PG8_BAR;
        PG8_STAGE(PG8_SB(1, 0), cB + kstep, voffB); PG8_STAGE(PG8_SA(1, 0), cA + kstep, voffA); PG8_STAGE(PG8_SB(1, 1), cB + hstepB + kstep, voffB);
        PG8_WAIT_V(6); PG8_BAR;
    }
    for (;;) {
        const bool has_next = S.next(ui + 1, nxt);
        const char* nA = has_next ? (const char*)(nxt.ty ? g.A2 : g.A) + (size_t)nxt.pm * tstepA : cA; const char* nB = has_next ? (const char*)(nxt.ty ? g.Bt2 : g.Bt) + (size_t)nxt.pn * tstepB : cB;
        for (int t = 0; t < nt; t += 2) {
            const bool last = (t == nt - 2);
            const char* a1 = cA + (size_t)(t + 1) * kstep;
            const char* a2 = last ? nA : cA + (size_t)(t + 2) * kstep; const char* b2 = last ? nB : cB + (size_t)(t + 2) * kstep;
            const char* a3 = a2 + kstep; const char* b3 = b2 + kstep;
            if (last && has_next) S.a_ready(nxt);
            if constexpr (SP2) {
            PG8_LDB(B0, 0, 0); PG8_LDB(B1, 0, 1); PG8_SCHED; PG8_LDA(At, 0, 0); PG8_STAGE(PG8_SA(1, 1), a1 + hstepA, voffA);
            PG8_WAIT_V(8); PG8_WAIT_L(0); PG8_BAR; PG8_MMA(0, 0, At, B0); PG8_MMA(0, 1, At, B1); PG8_BAR; PG8_SCHED;
            PG8_LDA(At, 0, 1); PG8_STAGE(PG8_SB(0, 0), b2, voffB); PG8_STAGE(PG8_SB(0, 1), b2 + hstepB, voffB); PG8_STAGE(PG8_SA(0, 0), a2, voffA);
            PG8_WAIT_V(8); PG8_WAIT_L(0); PG8_BAR; PG8_MMA(1, 0, At, B0); PG8_MMA(1, 1, At, B1); PG8_BAR; PG8_SCHED;
            PG8_LDB(B0, 1, 0); PG8_LDB(B1, 1, 1); PG8_SCHED; PG8_LDA(At, 1, 0); PG8_STAGE(PG8_SA(0, 1), a2 + hstepA, voffA);
            PG8_WAIT_V(8); PG8_WAIT_L(0); PG8_BAR; PG8_MMA(0, 0, At, B0); PG8_MMA(0, 1, At, B1); PG8_BAR; PG8_SCHED;
            PG8_LDA(At, 1, 1); PG8_STAGE(PG8_SB(1, 0), b3, voffB); PG8_STAGE(PG8_SB(1, 1), b3 + hstepB, voffB); PG8_STAGE(PG8_SA(1, 0), a3, voffA);
            PG8_WAIT_V(8); PG8_WAIT_L(0); PG8_BAR; PG8_MMA(1, 0, At, B0); PG8_MMA(1, 1, At, B1); PG8_BAR; PG8_SCHED;
            } else {
            PG8_LDB(B0, 0, 0); PG8_SCHED; PG8_LDA(At, 0, 0); PG8_STAGE(PG8_SA(1, 1), a1 + hstepA, voffA);
            PG8_WAIT_L(8); PG8_BAR; PG8_WAIT_L(0); PG8_MMA(0, 0, At, B0); PG8_BAR; PG8_SCHED;
            PG8_LDB(B1, 0, 1); PG8_STAGE(PG8_SB(0, 0), b2, voffB);
            PG8_BAR; PG8_WAIT_L(0); PG8_MMA(0, 1, At, B1); PG8_BAR;
            PG8_LDA(At, 0, 1); PG8_STAGE(PG8_SA(0, 0), a2, voffA);
            PG8_BAR; PG8_WAIT_L(0); PG8_MMA(1, 0, At, B0); PG8_BAR; PG8_SCHED;
            PG8_STAGE(PG8_SB(0, 1), b2 + hstepB, voffB);
            PG8_WAIT_V(6); PG8_BAR; PG8_MMA(1, 1, At, B1); PG8_BAR;
            PG8_LDB(B0, 1, 0); PG8_SCHED; PG8_LDA(At, 1, 0); PG8_STAGE(PG8_SA(0, 1), a2 + hstepA, voffA);
            PG8_WAIT_L(8); PG8_BAR; PG8_WAIT_L(0); PG8_MMA(0, 0, At, B0); PG8_BAR; PG8_SCHED;
            PG8_LDB(B1, 1, 1); PG8_STAGE(PG8_SB(1, 0), b3, voffB);
            PG8_BAR; PG8_WAIT_L(0); PG8_MMA(0, 1, At, B1); PG8_BAR;
            PG8_LDA(At, 1, 1); PG8_STAGE(PG8_SA(1, 0), a3, voffA);
            PG8_BAR; PG8_WAIT_L(0); PG8_MMA(1, 0, At, B0); PG8_BAR; PG8_SCHED;
            PG8_STAGE(PG8_SB(1, 1), b3 + hstepB, voffB);
            PG8_WAIT_V(6); PG8_BAR; PG8_MMA(1, 1, At, B1); PG8_BAR;
            }
        }
        if constexpr (ALIGN_EPI) { if (wr == 0) PG8_BAR; }
        if constexpr (!Epi::AFTER_DRAIN) { E(acc, cur, wr, wc, fr, fq); S.done(cur); }
        if (!has_next) break;
#pragma unroll
        for (int a = 0; a < 2; ++a)
#pragma unroll
            for (int b = 0; b < 2; ++b)
#pragma unroll
                for (int m = 0; m < 4; ++m)
#pragma unroll
                    for (int n = 0; n < 2; ++n) acc[a][b][m][n] = (f32x4){0.f, 0.f, 0.f, 0.f};
        cur = nxt; cA = nA; cB = nB; ++ui;
        if constexpr (ALIGN_EPI) { if (wr == 1) PG8_BAR; }
    }
    PG8_WAIT_V(0);
    if constexpr (!ALIGN_EPI) { if (wr == 0) PG8_BAR; }
    PG8_BAR;
    if constexpr (Epi::AFTER_DRAIN) { E.fused(acc, cur, wr, wc, fr, fq, lds, wid, lane); S.done(cur); }
#undef PG8_SA
#undef PG8_SB
#undef PG8_STAGE
#undef PG8_LDA
#undef PG8_LDB
#undef PG8_MMA
#undef PG8_WAIT_V
#undef PG8_WAIT_L
#undef PG8_BAR
#undef PG8_SCHED
}
}
#define GAS __attribute__((address_space(1)))
#define LAS __attribute__((address_space(3)))
typedef unsigned short bf16;
typedef unsigned v4u __attribute__((ext_vector_type(4)));
typedef float f32x4 __attribute__((ext_vector_type(4)));
typedef short bf16x8 __attribute__((ext_vector_type(8)));
typedef GAS unsigned gu32;
typedef GAS unsigned long long gu64;
#define RLX_AGENT __ATOMIC_RELAXED, __HIP_MEMORY_SCOPE_AGENT
#define LDS_WAIT() asm volatile("s_waitcnt lgkmcnt(0)" ::: "memory")
#define VM_WAIT() asm volatile("s_waitcnt vmcnt(0)" ::: "memory")
__device__ __forceinline__ unsigned long long rt() { return __builtin_amdgcn_s_memrealtime(); }
__device__ __forceinline__ unsigned f2bf(float f) { unsigned u = __builtin_bit_cast(unsigned, f); return (u + 0x7fffu + ((u >> 16) & 1u)) >> 16; }
__device__ __forceinline__ unsigned pk2(float lo, float hi) { return f2bf(lo) | (f2bf(hi) << 16); }

#define XB_TMO      128
#define XB_XCNT(j)  (256  + 64 * (j))
#define XB_XSUB(j)  (1280 + 64 * (j))
#define XB_XGEN(j)  (2304 + 64 * (j))
#define XB_TOP      3328
#define XB_TOPGEN   3392
#define XCD_BAR_WORDS 3456
#define XB_SPIN_CAP (1u << 18)

__device__ __forceinline__ unsigned xb_ld(unsigned* p)              { return __hip_atomic_load(p, __ATOMIC_RELAXED, __HIP_MEMORY_SCOPE_AGENT); }
__device__ __forceinline__ unsigned xb_add(unsigned* p, unsigned v) { return __hip_atomic_fetch_add(p, v, __ATOMIC_RELAXED, __HIP_MEMORY_SCOPE_AGENT); }
__device__ __forceinline__ unsigned xb_xcc_id() { return (unsigned)__builtin_amdgcn_s_getreg((3 << 11) | 20) & 0xFu; }
#define XB_SPIN(cond, bar) do { unsigned _sp = 0; while (cond) { __builtin_amdgcn_s_sleep(1); \
    if ((++_sp & 255u) == 0u) { if (xb_ld(&(bar)[XB_TMO])) break; if (_sp > XB_SPIN_CAP) { atomicAdd(&(bar)[XB_TMO], 1u); break; } } } } while (0)

struct XcdBarrier {
    unsigned* bar; unsigned x;
    volatile LAS unsigned* st;
};

__device__ __forceinline__ XcdBarrier xcd_barrier_post(unsigned* bar, volatile LAS unsigned* st) {
    XcdBarrier b; b.bar = bar; b.x = xb_xcc_id(); b.st = st;
    if (threadIdx.x == 0) (void)xb_add(&bar[XB_XCNT(b.x)], 1u);
    return b;
}
__device__ __forceinline__ void xcd_barrier_complete(unsigned* bar, unsigned x, unsigned& nloc, unsigned& nx) {
    const unsigned G = gridDim.x * gridDim.y * gridDim.z;
    unsigned sum, cnt, mine, sp = 0u;
    for (;;) {
        sum = 0u; cnt = 0u; mine = 0u;
#pragma unroll
        for (unsigned j = 0; j < 16; ++j) { const unsigned c = xb_ld(&bar[XB_XCNT(j)]); sum += c; cnt += (c > 0u) ? 1u : 0u; mine = (j == x) ? c : mine; }
        if (sum == G) break;
        __builtin_amdgcn_s_sleep(1);
        if ((++sp & 255u) == 0u) { if (xb_ld(&bar[XB_TMO])) break; if (sp > XB_SPIN_CAP) { atomicAdd(&bar[XB_TMO], 1u); break; } }
    }
    nloc = mine > 0u ? mine : 1u; nx = cnt > 0u ? cnt : 1u;
}

__device__ __forceinline__ void xcd_barrier(const XcdBarrier& b) {
    asm volatile("s_waitcnt vmcnt(0)" ::: "memory");
    __syncthreads();
    if (threadIdx.x == 0) {
        unsigned* bar = b.bar;
        __builtin_amdgcn_s_waitcnt(0);
        unsigned nloc = b.st[0], nx = b.st[1];
        if (nloc == 0u) { xcd_barrier_complete(bar, b.x, nloc, nx); b.st[0] = nloc; b.st[1] = nx; }
        const unsigned old = xb_add(&bar[XB_XSUB(b.x)], 1u);
        const unsigned gen = old / nloc;
        if (old + 1u == (gen + 1u) * nloc) {
            __builtin_amdgcn_fence(__ATOMIC_RELEASE, "agent");
            asm volatile("s_waitcnt vmcnt(0)" ::: "memory");
            const unsigned og = xb_add(&bar[XB_TOP], 1u);
            const unsigned tg = og / nx;
            if (og + 1u == (tg + 1u) * nx) xb_add(&bar[XB_TOPGEN], 1u);
            else XB_SPIN(xb_ld(&bar[XB_TOPGEN]) == tg, bar);
            __builtin_amdgcn_fence(__ATOMIC_ACQUIRE, "agent");
            xb_add(&bar[XB_XGEN(b.x)], 1u);
            asm volatile("s_waitcnt vmcnt(0)" ::: "memory");
        } else {
            XB_SPIN(xb_ld(&bar[XB_XGEN(b.x)]) == gen, bar);
            __builtin_amdgcn_fence(__ATOMIC_ACQUIRE, "agent");
            asm volatile("s_waitcnt vmcnt(0)" ::: "memory");
        }
    }
    __syncthreads();
}

constexpr int NWAVES = 8;
#ifndef MK_N_LAUNCHES
#define MK_N_LAUNCHES 1
#endif
constexpr int N_PHASES = 14;
constexpr int D = 1024, M = 32768, MP = 16384, SS = 4096;
constexpr int NG = 32, TCH = 32, NCG = 1024  , FF = 2816, NPROJ = 2048, NMOD = 6144, UP = 768  ;
constexpr float EPS = 1e-6f;
constexpr float LOG2E = 1.4426950408889634f, LN2F = 0.6931471805599453f;
constexpr float QSCALE = 0.125f * LOG2E;
constexpr double INV_2PI = 0.15915494309189533577;

constexpr size_t MiB = 1u << 20;
constexpr size_t WS_CTL = 0, CTL_ZERO_BYTES = 262144;
constexpr size_t WS_MODF = 262144;
constexpr size_t WS_XBUF = 524288;
constexpr size_t WS_LDRE = 393216, WS_ZRE = 409600, WS_ZIM = 425984, WS_ATRE = 442368, WS_ATIM = 458752, WS_THETA = 475136;
constexpr size_t WS_W13 = 1 * MiB;
constexpr size_t WS_PTAB = 12 * MiB, WS_SBUF = 20 * MiB, WS_WIN = 52 * MiB, WS_ROPE = 56 * MiB, WS_MODP = 60 * MiB, WS_WGLU = 254 * MiB, WS_WO = 252 * MiB, WS_KLAG = 63 * MiB;
constexpr size_t WS_SSMRAW = 12 * MiB, WS_H2 = 12 * MiB, WS_W2 = 12 * MiB;
constexpr size_t WS_U = 76 * MiB, WS_Q = 124 * MiB, WS_K = 156 * MiB, WS_V = 188 * MiB, WS_TOEP = 124 * MiB, WS_G = 196 * MiB, WS_MIXA = 12 * MiB  , WS_ACT = 76 * MiB, WS_END = 255 * MiB;
constexpr size_t DO_H1 = 0, DO_OB = 0, DO_LSE = 96 * MiB;
constexpr int CW_ATTQ = 2048;
constexpr int CW_BAR = 4096, CW_SEAM = 16384, SEAM_BANK = 8192;
constexpr int PARAM_OFF = 131520;
constexpr int CW_READY = CW_SEAM + 3 * SEAM_BANK;
constexpr int XLDS_OFF = 131584;

constexpr int RING_OFF = 0, RING_BYTES = 131072;
constexpr int LDSCTL_OFF = RING_BYTES, MISC_OFF = LDSCTL_OFF + 320;
constexpr int LDS_BYTES = 147456;

typedef short v4i16_t __attribute__((ext_vector_type(4)));
typedef unsigned v2u __attribute__((ext_vector_type(2)));
typedef float f32x2v __attribute__((ext_vector_type(2)));

struct Args { const float* in[26]; float* out; unsigned char* ws; int ph_lo, ph_hi; };

__device__ __forceinline__ float wave_sum(float v) {
#pragma unroll
    for (int o = 1; o < 64; o <<= 1) v += __shfl_xor(v, o);
    return v;
}
__device__ __forceinline__ float fexp2(float x) { return __builtin_amdgcn_exp2f(x); }
__device__ __forceinline__ float frcp(float x) { return __builtin_amdgcn_rcpf(x); }
__device__ __forceinline__ float sigm(float x) { return frcp(1.f + fexp2(-x * LOG2E)); }
__device__ __forceinline__ float gelu_tanh(float x) { const float u = 1.5957691216057308f * (x + 0.044715f * x * x * x); return x * sigm(u); }
__device__ __forceinline__ void sincos_rev(double revs, float& s, float& c) { const double fr = revs - __builtin_rint(revs); const float f = (float)fr; s = __builtin_amdgcn_sinf(f); c = __builtin_amdgcn_cosf(f); }
__device__ __forceinline__ float bf2f(unsigned short h) { return __builtin_bit_cast(float, (unsigned)h << 16); }
__device__ __forceinline__ float bflo(unsigned w) { return __builtin_bit_cast(float, w << 16); }
__device__ __forceinline__ float bfhi(unsigned w) { return __builtin_bit_cast(float, w & 0xffff0000u); }
__device__ __forceinline__ int batch_of(int row) { return row < MP ? 0 : 1 + ((row - MP) >> 12); }
__device__ __forceinline__ const float* xrow_ptr(const Args& a, int row) { return row < MP ? a.in[0] + (size_t)row * D : a.in[1] + (size_t)(row - MP) * D; }

struct SchedState {
    int c;
    __device__ bool next(int i, pg8::Unit& u) const { if (i > 0 || c >= 128) return false; u.pm = c; u.pn = c >> 2; return true; }
    __device__ __forceinline__ void a_ready(const pg8::Unit&) const {}
    __device__ __forceinline__ void done(const pg8::Unit&) const {}
};
struct SchedSsmOut {
    int c;
    __device__ bool next(int i, pg8::Unit& u) const { if (i > 0 || c >= 256) return false; const int g = c >> 3; u.pm = 4 * g + ((c >> 1) & 3); u.pn = 2 * g + (c & 1); return true; }
    __device__ __forceinline__ void a_ready(const pg8::Unit&) const {}
    __device__ __forceinline__ void done(const pg8::Unit&) const {}
};

#ifndef DUP_MASK
#define DUP_MASK 0
#endif
template <int DUP> struct DupOrder {
    pg8::StaticOrder S;
    __device__ bool next(int i, pg8::Unit& u) const { if (DUP == 2) { pg8::Unit t; int n = 0; while (S.next(n, t)) ++n; return i < 2 * n ? S.next(i % n, u) : false; } return S.next(DUP ? (i >> 1) : i, u); }
    __device__ __forceinline__ void a_ready(const pg8::Unit&) const {}
    __device__ __forceinline__ void done(const pg8::Unit&) const {}
};
struct SchedWoUp {
    int c; const unsigned* ready; int base, count;
    mutable int seen = -1;
    __device__ bool next(int i0, pg8::Unit& u) const {
        if (i0 >= count) return false;
        const int i = base + i0;
        const int x = c & 7, j = c >> 3, t = 1 + (x % 5), P0 = 16 * x;
        if (i == 0) { u.ty = 0; u.pm = P0 + (j & 7); u.pn = j >> 3; return true; }
        if (i == t) { u.ty = 0; u.pm = P0 + 8 + (j & 7); u.pn = j >> 3; return true; }
        u.ty = 1;
        if (i == 12) { if (j < 16) { u.pm = P0 + (j & 7); u.pn = 20 + (j >> 3); } else { u.pm = P0 + 8 + (j & 7); u.pn = 20 + ((j - 16) >> 3); } return true; }
        const int k = i - 1 - (i > t ? 1 : 0), half = k / 5, b = k % 5;
        u.pm = P0 + 8 * half + (j & 7); u.pn = 4 * b + (j >> 3); return true;
    }
    __device__ __forceinline__ void a_ready(const pg8::Unit& u) const {
        if (u.ty != 1 || u.pm == seen) return;
        seen = u.pm;
        if (threadIdx.x < 64) {
            unsigned sp = 0;
            while ((unsigned)__builtin_amdgcn_readfirstlane(__hip_atomic_load(ready + 64 * u.pm, __ATOMIC_RELAXED, __HIP_MEMORY_SCOPE_AGENT)) < 32u) { __builtin_amdgcn_s_sleep(2); if (++sp > (1u << 22)) break; }
            __builtin_amdgcn_fence(__ATOMIC_ACQUIRE, "agent");
            asm volatile("s_waitcnt vmcnt(0)" ::: "memory");
        }
        asm volatile("" ::: "memory"); __builtin_amdgcn_s_barrier(); asm volatile("" ::: "memory");
    }
    __device__ __forceinline__ void done(const pg8::Unit&) const {}
};
using pg8::f32x4; using pg8::u32x4; using pg8::cvt_pk_bf16;
#define EPI_ROWS(u, ai, m) ((u).pm * 256 + (ai) * 128 + wr * 64 + (m) * 16 + fr)
__device__ __forceinline__ u32x4 pack8(const f32x4& a, const f32x4& b) { u32x4 w; w.x = cvt_pk_bf16(a[0], a[1]); w.y = cvt_pk_bf16(a[2], a[3]); w.z = cvt_pk_bf16(b[0], b[1]); w.w = cvt_pk_bf16(b[2], b[3]); return w; }

struct EpiQKV {
    static constexpr bool PERM = true, AFTER_DRAIN = false;
    bf16 *Q, *K, *V, *U; const float *cosT, *sinT;
    __device__ __forceinline__ void operator()(const f32x4 (&acc)[2][2][4][2], const pg8::Unit& u, int wr, int wc, int fr, int fq) const {
        const int kind = u.pn >> 1, ph = u.pn & 1;
        if (kind < 2) {
            bf16* dst0 = kind == 0 ? Q : K; const float sc = kind == 0 ? QSCALE : 1.f;
            const int i0 = 16 * (wc & 1) + 4 * fq;
#pragma unroll
            for (int ai = 0; ai < 2; ++ai)
#pragma unroll
                for (int m = 0; m < 4; ++m) {
                    const int row = EPI_ROWS(u, ai, m); const int pos = row < MP ? row : ((row - MP) & (SS - 1));
                    const f32x4 cs = *(const f32x4*)(cosT + pos * 32 + i0), sn = *(const f32x4*)(sinT + pos * 32 + i0);
#pragma unroll
                    for (int bj = 0; bj < 2; ++bj) {
                        const int head = ph * 4 + bj * 2 + (wc >> 1);
                        const f32x4 x1 = acc[ai][bj][m][0], x2 = acc[ai][bj][m][1];
                        const f32x4 o1 = (x1 * cs - x2 * sn) * sc, o2 = (x2 * cs + x1 * sn) * sc;
                        bf16* d = dst0 + (size_t)row * 512 + head * 64 + i0;
                        v2u w1; w1.x = cvt_pk_bf16(o1[0], o1[1]); w1.y = cvt_pk_bf16(o1[2], o1[3]);
                        v2u w2; w2.x = cvt_pk_bf16(o2[0], o2[1]); w2.y = cvt_pk_bf16(o2[2], o2[3]);
                        *(v2u*)d = w1; *(v2u*)(d + 32) = w2;
                    }
                }
        } else {
#pragma unroll
            for (int ai = 0; ai < 2; ++ai)
#pragma unroll
                for (int m = 0; m < 4; ++m) {
                    const int row = EPI_ROWS(u, ai, m);
#pragma unroll
                    for (int bj = 0; bj < 2; ++bj) {
                        const int col = ph * 256 + bj * 128 + wc * 32 + 8 * fq;
                        const u32x4 w = pack8(acc[ai][bj][m][0], acc[ai][bj][m][1]);
                        if (kind == 2) *(u32x4*)(V + (size_t)row * 512 + col) = w;
                        else { const int g = col >> 4, c = col & 15; *(u32x4*)(U + ((size_t)(g * NCG + (row >> 5)) * UP + (row & 31) * 16 + c)) = w; }
                    }
                }
        }
    }
};
struct EpiState {
    static constexpr bool PERM = true, AFTER_DRAIN = false;
    float* S;
    __device__ __forceinline__ void operator()(const f32x4 (&acc)[2][2][4][2], const pg8::Unit& u, int wr, int wc, int fr, int fq) const {
        const int g = u.pn, mt = u.pm & 3;
#pragma unroll
        for (int ai = 0; ai < 2; ++ai)
#pragma unroll
            for (int m = 0; m < 4; ++m) {
                const int chunk = mt * 256 + ai * 128 + wr * 64 + m * 16 + fr;
#pragma unroll
                for (int bj = 0; bj < 2; ++bj) { float* p = S + ((size_t)(g * NCG + chunk) * 256 + bj * 128 + wc * 32 + 8 * fq); *(f32x4*)p = acc[ai][bj][m][0]; *(f32x4*)(p + 4) = acc[ai][bj][m][1]; }
            }
    }
};
struct EpiSsmOut {
    static constexpr bool PERM = true, AFTER_DRAIN = false;
    bf16* G;
    __device__ __forceinline__ void operator()(const f32x4 (&acc)[2][2][4][2], const pg8::Unit& u, int wr, int wc, int fr, int fq) const {
        const int g = u.pn >> 1, nt = u.pn & 1, mt = u.pm & 3;
#pragma unroll
        for (int ai = 0; ai < 2; ++ai)
#pragma unroll
            for (int m = 0; m < 4; ++m) {
                const int chunk = mt * 256 + ai * 128 + wr * 64 + m * 16 + fr;
#pragma unroll
                for (int bj = 0; bj < 2; ++bj) {
                    const int ncol = nt * 256 + bj * 128 + wc * 32 + 8 * fq, t = ncol >> 4, c0 = ncol & 15;
                    f32x4 a = acc[ai][bj][m][0], b = acc[ai][bj][m][1];
#pragma unroll
                    for (int e = 0; e < 4; ++e) { a[e] = gelu_tanh(a[e]); b[e] = gelu_tanh(b[e]); }
                    *(u32x4*)(G + (size_t)(chunk * TCH + t) * 512 + g * 16 + c0) = pack8(a, b);
                }
            }
    }
};
struct EpiGlu {
    static constexpr bool PERM = true, AFTER_DRAIN = false;
    const bf16* G; const float* bglu; bf16* O;
    __device__ __forceinline__ void operator()(const f32x4 (&acc)[2][2][4][2], const pg8::Unit& u, int wr, int wc, int fr, int fq) const {
#pragma unroll
        for (int bj = 0; bj < 2; ++bj) {
            const int col = u.pn * 256 + bj * 128 + wc * 32 + 8 * fq;
            const f32x4 b0 = *(const f32x4*)(bglu + col), b1 = *(const f32x4*)(bglu + col + 4);
#pragma unroll
            for (int ai = 0; ai < 2; ++ai)
#pragma unroll
                for (int m = 0; m < 4; ++m) {
                    const int row = EPI_ROWS(u, ai, m);
                    const u32x4 gv = *(const u32x4*)(G + (size_t)row * 512 + col);
                    const f32x4 z0 = acc[ai][bj][m][0] + b0, z1 = acc[ai][bj][m][1] + b1;
                    f32x4 o0, o1;
                    o0[0] = bflo(gv.x) * sigm(z0[0]); o0[1] = bfhi(gv.x) * sigm(z0[1]); o0[2] = bflo(gv.y) * sigm(z0[2]); o0[3] = bfhi(gv.y) * sigm(z0[3]);
                    o1[0] = bflo(gv.z) * sigm(z1[0]); o1[1] = bfhi(gv.z) * sigm(z1[1]); o1[2] = bflo(gv.w) * sigm(z1[2]); o1[3] = bfhi(gv.w) * sigm(z1[3]);
                    *(u32x4*)(O + (size_t)row * 512 + col) = pack8(o0, o1);
                }
        }
    }
};
struct EpiResid {
    static constexpr bool PERM = true, AFTER_DRAIN = false;
    const float* xp; const float* xs; float* out; const float* gate;
    int inplace;
    __device__ __forceinline__ void operator()(const f32x4 (&acc)[2][2][4][2], const pg8::Unit& u, int wr, int wc, int fr, int fq) const {
#pragma unroll
        for (int ai = 0; ai < 2; ++ai)
#pragma unroll
            for (int m = 0; m < 4; ++m) {
                const int row = EPI_ROWS(u, ai, m); const int b = batch_of(row);
                const float* base = inplace ? out + (size_t)row * D : (row < MP ? xp + (size_t)row * D : xs + (size_t)(row - MP) * D);
#pragma unroll
                for (int bj = 0; bj < 2; ++bj) {
                    const int col = u.pn * 256 + bj * 128 + wc * 32 + 8 * fq;
                    const f32x4 g0 = *(const f32x4*)(gate + b * NMOD + col), g1 = *(const f32x4*)(gate + b * NMOD + col + 4);
                    const f32x4 x0 = *(const f32x4*)(base + col), x1 = *(const f32x4*)(base + col + 4);
                    *(f32x4*)(out + (size_t)row * D + col) = x0 + g0 * acc[ai][bj][m][0];
                    *(f32x4*)(out + (size_t)row * D + col + 4) = x1 + g1 * acc[ai][bj][m][1];
                }
            }
    }
};
struct PB { const float* xp; const float* xs; float* out; unsigned char* ws; const float* p17; const float* p19; const float* p21; const float* p25; };
__device__ __forceinline__ PB load_pb(LAS unsigned char* lds) { asm volatile("" ::: "memory"); const LAS unsigned long long* p = (const LAS unsigned long long*)(lds + PARAM_OFF); PB r;
    r.xp = (const float*)p[0]; r.xs = (const float*)p[1]; r.out = (float*)p[2]; r.ws = (unsigned char*)p[3]; r.p17 = (const float*)p[4]; r.p19 = (const float*)p[5]; r.p21 = (const float*)p[6]; r.p25 = (const float*)p[7]; return r; }
template <int NTN, int BANK>
__device__ __forceinline__ void row_ssq_exchange(const f32x4 (&v)[2][2][4][2], const pg8::Unit& u, int wr, int wc, int fr, int fq, LAS unsigned char* ldsx, unsigned char* ws) {
    unsigned* xbuf = (unsigned*)(ws + WS_XBUF); unsigned* cnt = (unsigned*)(ws + WS_CTL) + CW_SEAM + BANK * SEAM_BANK + 64 * u.pm;
    int lane = threadIdx.x & 63; asm volatile("" : "+v"(lane)); const int wid = __builtin_amdgcn_readfirstlane(threadIdx.x >> 6);
    LAS float* P = (LAS float*)ldsx; LAS float* S = (LAS float*)(ldsx + 4096);
#pragma unroll
    for (int ai = 0; ai < 2; ++ai)
#pragma unroll
        for (int m = 0; m < 4; ++m) {
            float q = 0.f;
#pragma unroll
            for (int bj = 0; bj < 2; ++bj)
#pragma unroll
                for (int n = 0; n < 2; ++n) { const f32x4 x = v[ai][bj][m][n]; q += (x[0] * x[0] + x[1] * x[1]) + (x[2] * x[2] + x[3] * x[3]); }
            q += __shfl_xor(q, 16); q += __shfl_xor(q, 32);
            if (fq == 0) P[(ai * 128 + wr * 64 + m * 16 + fr) * 4 + wc] = q;
        }
    asm volatile("s_waitcnt lgkmcnt(0)" ::: "memory"); __builtin_amdgcn_s_barrier(); asm volatile("" ::: "memory");
    const int row = wid * 32 + (lane & 31);
    if (lane < 32) { const float t = (P[row * 4 + 0] + P[row * 4 + 1]) + (P[row * 4 + 2] + P[row * 4 + 3]);
        __hip_atomic_store(xbuf + ((size_t)(u.pm * 256 + row) * 4 + (u.pn & 3)), __float_as_uint(t), __ATOMIC_RELAXED, __HIP_MEMORY_SCOPE_AGENT); }
    asm volatile("s_waitcnt vmcnt(0)" ::: "memory");
    if (lane == 0) __hip_atomic_fetch_add(cnt, 1u, __ATOMIC_RELAXED, __HIP_MEMORY_SCOPE_AGENT);
    if (wid == 0) {
        unsigned sp = 0;
        while ((unsigned)__builtin_amdgcn_readfirstlane(__hip_atomic_load(cnt, __ATOMIC_RELAXED, __HIP_MEMORY_SCOPE_AGENT)) < 8u * NTN) { __builtin_amdgcn_s_sleep(2); if (++sp > (1u << 22)) break; }
        __builtin_amdgcn_fence(__ATOMIC_ACQUIRE, "agent");
    }
    asm volatile("s_waitcnt vmcnt(0) lgkmcnt(0)" ::: "memory"); __builtin_amdgcn_s_barrier(); asm volatile("" ::: "memory");
    if (lane < 32) { float t = 0.f;
#pragma unroll
        for (int k = 0; k < NTN; ++k) t += __uint_as_float(__hip_atomic_load(xbuf + ((size_t)(u.pm * 256 + row) * 4 + k), __ATOMIC_RELAXED, __HIP_MEMORY_SCOPE_AGENT));
        S[row] = __builtin_amdgcn_rsqf(t * (1.f / (256.f * NTN)) + EPS); }
    asm volatile("s_waitcnt lgkmcnt(0)" ::: "memory"); __builtin_amdgcn_s_barrier(); asm volatile("" ::: "memory");
}
struct EpiGluNorm {
    static constexpr bool PERM = true, AFTER_DRAIN = false;
    LAS unsigned char* lds;
    __device__ __forceinline__ void operator()(f32x4 (&acc)[2][2][4][2], const pg8::Unit& u, int wr, int wc, int fr, int fq) const {
        asm volatile("" : "+v"(fr), "+v"(fq));
        const PB pb = load_pb(lds); const bf16* G = (const bf16*)(pb.ws + WS_G); bf16* O = (bf16*)(pb.ws + WS_MIXA);
#pragma unroll
        for (int bj = 0; bj < 2; ++bj) {
            const int col = u.pn * 256 + bj * 128 + wc * 32 + 8 * fq;
            const f32x4 b0 = *(const f32x4*)(pb.p17 + col), b1 = *(const f32x4*)(pb.p17 + col + 4);
#pragma unroll
            for (int ai = 0; ai < 2; ++ai)
#pragma unroll
                for (int m = 0; m < 4; ++m) {
                    const int row = EPI_ROWS(u, ai, m);
                    const u32x4 gv = *(const u32x4*)(G + (size_t)row * 512 + col);
                    const f32x4 z0 = acc[ai][bj][m][0] + b0, z1 = acc[ai][bj][m][1] + b1;
                    f32x4 o0, o1;
                    o0[0] = bflo(gv.x) * sigm(z0[0]); o0[1] = bfhi(gv.x) * sigm(z0[1]); o0[2] = bflo(gv.y) * sigm(z0[2]); o0[3] = bfhi(gv.y) * sigm(z0[3]);
                    o1[0] = bflo(gv.z) * sigm(z1[0]); o1[1] = bfhi(gv.z) * sigm(z1[1]); o1[2] = bflo(gv.w) * sigm(z1[2]); o1[3] = bfhi(gv.w) * sigm(z1[3]);
                    acc[ai][bj][m][0] = o0; acc[ai][bj][m][1] = o1;
                    asm volatile("" : "+v"(acc[ai][bj][m][0]), "+v"(acc[ai][bj][m][1]));
                    if (m & 1) asm volatile("" ::: "memory");
                }
        }
        row_ssq_exchange<2, 0>(acc, u, wr, wc, fr, fq, lds + XLDS_OFF, pb.ws);
        const LAS float* S = (const LAS float*)(lds + XLDS_OFF + 4096);
#pragma unroll
        for (int bj = 0; bj < 2; ++bj) {
            const int col = u.pn * 256 + bj * 128 + wc * 32 + 8 * fq;
            const f32x4 g0 = *(const f32x4*)(pb.p19 + col), g1 = *(const f32x4*)(pb.p19 + col + 4);
#pragma unroll
            for (int ai = 0; ai < 2; ++ai)
#pragma unroll
                for (int m = 0; m < 4; ++m) {
                    const int rl = ai * 128 + wr * 64 + m * 16 + fr; const float rs = S[rl];
                    *(u32x4*)(O + (size_t)(u.pm * 256 + rl) * D + 512 + col) = pack8(acc[ai][bj][m][0] * rs * g0, acc[ai][bj][m][1] * rs * g1);
                }
        }
    }
};
struct EpiWoH2 {
    static constexpr bool PERM = true, AFTER_DRAIN = false;
    LAS unsigned char* lds;
    __device__ __forceinline__ void operator()(f32x4 (&acc)[2][2][4][2], const pg8::Unit& u, int wr, int wc, int fr, int fq) const {
        asm volatile("" : "+v"(fr), "+v"(fq));
        const PB pb = load_pb(lds);
        unsigned char* wsu = (unsigned char*)(((unsigned long long)(unsigned)__builtin_amdgcn_readfirstlane((int)((unsigned long long)pb.ws >> 32)) << 32) | (unsigned)__builtin_amdgcn_readfirstlane((int)(unsigned long long)pb.ws));
        const __amdgpu_buffer_rsrc_t h2r = __builtin_amdgcn_make_buffer_rsrc((void*)(wsu + WS_H2), (short)0, (int)((size_t)M * D * 2), 0x00020000);
        const int b = batch_of(u.pm * 256); const float* mb = (const float*)(pb.ws + WS_MODF) + b * NMOD;
#pragma unroll
        for (int bj = 0; bj < 2; ++bj) {
            const int col = u.pn * 256 + bj * 128 + wc * 32 + 8 * fq;
            const f32x4 g0 = *(const f32x4*)(mb + 2048 + col), g1 = *(const f32x4*)(mb + 2048 + col + 4);
#pragma unroll
            for (int ai = 0; ai < 2; ++ai)
#pragma unroll
                for (int m = 0; m < 4; ++m) {
                    const int row = EPI_ROWS(u, ai, m);
                    const float* base = (row < MP ? pb.xp + (size_t)row * D : pb.xs + (size_t)(row - MP) * D) + col;
                    const f32x4 x0 = __builtin_nontemporal_load((const f32x4*)base), x1 = __builtin_nontemporal_load((const f32x4*)(base + 4));
                    const f32x4 r0 = x0 + g0 * acc[ai][bj][m][0], r1 = x1 + g1 * acc[ai][bj][m][1];
                    acc[ai][bj][m][0] = r0; acc[ai][bj][m][1] = r1;
                    *(u32x4*)((unsigned char*)pb.out + (size_t)row * (D * 4) + 2048 + col * 2) = pack8(r0, r1);
                    if (ai == 1 && m == 3) asm volatile("" ::: "memory");
                }
        }
        row_ssq_exchange<4, 1>(acc, u, wr, wc, fr, fq, lds + XLDS_OFF, pb.ws);
        const LAS float* S = (const LAS float*)(lds + XLDS_OFF + 4096);
#pragma unroll
        for (int bj = 0; bj < 2; ++bj) {
            const int col = u.pn * 256 + bj * 128 + wc * 32 + 8 * fq;
            const f32x4 gm0 = *(const f32x4*)(pb.p21 + col) * (*(const f32x4*)(mb + 4096 + col) + 1.f), gm1 = *(const f32x4*)(pb.p21 + col + 4) * (*(const f32x4*)(mb + 4096 + col + 4) + 1.f);
            const f32x4 sh0 = *(const f32x4*)(mb + 3072 + col), sh1 = *(const f32x4*)(mb + 3072 + col + 4);
#pragma unroll
            for (int ai = 0; ai < 2; ++ai)
#pragma unroll
                for (int m = 0; m < 4; ++m) {
                    const int rl = ai * 128 + wr * 64 + m * 16 + fr; const float rs = S[rl];
                    __builtin_amdgcn_raw_buffer_store_b128(pack8(acc[ai][bj][m][0] * rs * gm0 + sh0, acc[ai][bj][m][1] * rs * gm1 + sh1), h2r, (int)(((size_t)(u.pm * 256 + rl) * D + col) * 2), 0, 16);
                }
        }
        asm volatile("s_waitcnt vmcnt(0)" ::: "memory");
        if ((threadIdx.x & 63) == 0) __hip_atomic_fetch_add((unsigned*)(pb.ws + WS_CTL) + CW_READY + 64 * u.pm, 1u, __ATOMIC_RELAXED, __HIP_MEMORY_SCOPE_AGENT);
    }
};
struct EpiDownFinal {
    static constexpr bool PERM = true, AFTER_DRAIN = false;
    LAS unsigned char* lds;
    __device__ __forceinline__ void operator()(f32x4 (&acc)[2][2][4][2], const pg8::Unit& u, int wr, int wc, int fr, int fq) const {
        asm volatile("" : "+v"(fr), "+v"(fq));
        const PB pb = load_pb(lds);
        const int b = batch_of(u.pm * 256); const float* mb = (const float*)(pb.ws + WS_MODF) + b * NMOD;
#if (DUP_MASK >> 12) & 3
        LAS int* vc = (LAS int*)(lds + XLDS_OFF + 5120); const int visit = *vc; const bool keep = ((DUP_MASK >> 13) & 1) ? (visit < 2) : ((visit & 1) == 0);
#else
        const bool keep = false;
#endif
#pragma unroll
        for (int bj = 0; bj < 2; ++bj) {
            const int col = u.pn * 256 + bj * 128 + wc * 32 + 8 * fq;
            const f32x4 g0 = *(const f32x4*)(mb + 5120 + col), g1 = *(const f32x4*)(mb + 5120 + col + 4);
#pragma unroll
            for (int ai = 0; ai < 2; ++ai)
#pragma unroll
                for (int m = 0; m < 4; ++m) {
                    const u32x4 xw = __builtin_nontemporal_load((const u32x4*)((const unsigned char*)pb.out + (size_t)EPI_ROWS(u, ai, m) * (D * 4) + 2048 + col * 2));
                    const f32x4 x0 = {bflo(xw.x), bfhi(xw.x), bflo(xw.y), bfhi(xw.y)}, x1 = {bflo(xw.z), bfhi(xw.z), bflo(xw.w), bfhi(xw.w)};
                    acc[ai][bj][m][0] = x0 + g0 * acc[ai][bj][m][0]; acc[ai][bj][m][1] = x1 + g1 * acc[ai][bj][m][1];
                    asm volatile("" : "+v"(acc[ai][bj][m][0]), "+v"(acc[ai][bj][m][1]));
                    if (ai == 1 && m == 3) asm volatile("" ::: "memory");
                }
        }
        row_ssq_exchange<4, 2>(acc, u, wr, wc, fr, fq, lds + XLDS_OFF, pb.ws);
#if (DUP_MASK >> 12) & 3
        if (threadIdx.x == 0) *vc = visit + 1;
#endif
        const LAS float* S = (const LAS float*)(lds + XLDS_OFF + 4096);
        asm volatile("" : "+v"(fr), "+v"(fq));
        if (!keep) {
#pragma unroll
        for (int bj = 0; bj < 2; ++bj) {
            const int col = u.pn * 256 + bj * 128 + wc * 32 + 8 * fq;
            const f32x4 f0 = *(const f32x4*)(pb.p25 + col), f1 = *(const f32x4*)(pb.p25 + col + 4);
#pragma unroll
            for (int ai = 0; ai < 2; ++ai)
#pragma unroll
                for (int m = 0; m < 4; ++m) {
                    const int rl = ai * 128 + wr * 64 + m * 16 + fr; const float rs = S[rl];
                    float* o = pb.out + (size_t)(u.pm * 256 + rl) * D + col;
                    __builtin_nontemporal_store(acc[ai][bj][m][0] * rs * f0, (f32x4*)o); __builtin_nontemporal_store(acc[ai][bj][m][1] * rs * f1, (f32x4*)(o + 4));
                }
        }
        }
    }
};

struct EpiWoUp {
    static constexpr bool PERM = true, AFTER_DRAIN = false;
    LAS unsigned char* lds;
    __device__ __forceinline__ void operator()(f32x4 (&acc)[2][2][4][2], const pg8::Unit& u, int wr, int wc, int fr, int fq) const {
        if (u.ty == 0) { EpiWoH2 E{lds}; E(acc, u, wr, wc, fr, fq); return; }
        asm volatile("" : "+v"(fr), "+v"(fq));
        const PB pb = load_pb(lds); bf16* O = (bf16*)(pb.ws + WS_ACT);
        const int j0 = u.pn * 128 + wc * 32 + 8 * fq;
#pragma unroll
        for (int ai = 0; ai < 2; ++ai)
#pragma unroll
            for (int m = 0; m < 4; ++m) {
                const int row = EPI_ROWS(u, ai, m);
                f32x4 o0, o1;
#pragma unroll
                for (int e = 0; e < 4; ++e) { const float a0 = acc[ai][0][m][0][e], a1 = acc[ai][0][m][1][e]; o0[e] = a0 * sigm(a0) * acc[ai][1][m][0][e]; o1[e] = a1 * sigm(a1) * acc[ai][1][m][1][e]; }
                *(u32x4*)(O + (size_t)row * FF + j0) = pack8(o0, o1);
            }
    }
};

template <class Map>
__device__ __forceinline__ void transpose_item(const float* W, int K, int N, bf16* WT, LAS float* scr, int item, int lane, Map map) {
    const int nblk = N / 32, kb = item / nblk, nb = item % nblk, k0 = 64 * kb, n0 = 32 * nb;
#pragma unroll 8
    for (int i = 0; i < 32; ++i) { const int kk = 2 * i + (lane >> 5); scr[kk * 33 + (lane & 31)] = W[(size_t)(k0 + kk) * N + n0 + (lane & 31)]; }
    LDS_WAIT(); asm volatile("" ::: "memory");
    const int c = lane & 7;
#pragma unroll
    for (int j = 0; j < 4; ++j) { const int n = (lane >> 3) + 8 * j; const LAS float* s = scr + (8 * c) * 33 + n;
        v4u o; o.x = pk2(s[0 * 33], s[1 * 33]); o.y = pk2(s[2 * 33], s[3 * 33]); o.z = pk2(s[4 * 33], s[5 * 33]); o.w = pk2(s[6 * 33], s[7 * 33]);
        *(GAS v4u*)(WT + (size_t)map(n0 + n) * K + k0 + 8 * c) = o; }
    LDS_WAIT(); asm volatile("" ::: "memory");
}
struct MapId { __device__ __forceinline__ int operator()(int n) const { return n; } };
struct MapWin { __device__ __forceinline__ int operator()(int n) const { if (n >= 1024) return n; const int d = n & 63; return (n & ~63) + ((d >> 2) & 7) * 8 + (d >> 5) * 4 + (d & 3); } };
struct MapW13 { int off; __device__ __forceinline__ int operator()(int j) const { return 256 * (j >> 7) + off + (j & 127); } };

template <int R>
__device__ __forceinline__ void norm_rows_lds(const float* const (&xrow)[R], bf16* const (&orow)[R], const LAS float* Gm, const LAS float* Sh, int lane) {
    f32x4 v[R][4];
#pragma unroll
    for (int r = 0; r < R; ++r)
#pragma unroll
        for (int j = 0; j < 4; ++j) v[r][j] = __builtin_nontemporal_load((const GAS f32x4*)xrow[r] + lane + 64 * j);
#pragma unroll
    for (int r = 0; r < R; ++r) {
        float s = 0.f;
#pragma unroll
        for (int j = 0; j < 4; ++j) s += (v[r][j].x * v[r][j].x + v[r][j].y * v[r][j].y) + (v[r][j].z * v[r][j].z + v[r][j].w * v[r][j].w);
        const float rstd = __builtin_amdgcn_rsqf(wave_sum(s) * (1.f / D) + EPS);
        GAS v2u* o8 = (GAS v2u*)orow[r] + lane;
#pragma unroll
        for (int j = 0; j < 4; ++j) { const f32x4 gm = *(const LAS f32x4*)(Gm + 256 * j + 4 * lane), sh = *(const LAS f32x4*)(Sh + 256 * j + 4 * lane);
            const f32x4 h = v[r][j] * rstd * gm + sh; v2u w; w.x = pk2(h.x, h.y); w.y = pk2(h.z, h.w); o8[64 * j] = w; }
    }
}

__device__ __forceinline__ void cpow_tab(const float* ldre, const double* theta, int bi, int e, float& pre, float& pim) {
    const float mag = fexp2((float)e * ldre[bi] * LOG2E); float s, c; sincos_rev((double)e * theta[bi], s, c); pre = mag * c; pim = mag * s;
}

__device__ __forceinline__ float xmax16_32(float m) {
    auto r = __builtin_amdgcn_permlane16_swap(__float_as_uint(m), __float_as_uint(m), false, false); m = fmaxf(__uint_as_float(r[0]), __uint_as_float(r[1]));
    auto q = __builtin_amdgcn_permlane32_swap(__float_as_uint(m), __float_as_uint(m), false, false); return fmaxf(__uint_as_float(q[0]), __uint_as_float(q[1])); }
__device__ __forceinline__ float xsum16_32(float m) {
    auto r = __builtin_amdgcn_permlane16_swap(__float_as_uint(m), __float_as_uint(m), false, false); m = __uint_as_float(r[0]) + __uint_as_float(r[1]);
    auto q = __builtin_amdgcn_permlane32_swap(__float_as_uint(m), __float_as_uint(m), false, false); return __uint_as_float(q[0]) + __uint_as_float(q[1]); }
namespace att {
constexpr int NITEMS = 3 * 8 * 256, VOFF = 32768, BUFB = 65536;
struct Item { int br, h, seq_base, ldil, r, kblk, nidx, cont; };
__device__ __forceinline__ Item decode(int hs, int pos) {
    Item I; const int bh = hs >> 6, L = (hs & 63) * 4 + pos; I.br = bh >> 3; I.h = bh & 7; I.ldil = 2 * I.br;
    int S, li;
    if (L < 128) { I.seq_base = 0; S = MP; li = L; } else { const int si = (L - 128) >> 5; I.seq_base = MP + SS * si; S = SS; li = (L - 128) & 31; }
    const int lnb = (S == MP ? 7 : 5) - I.ldil;
    I.r = li >> lnb; I.kblk = li & ((1 << lnb) - 1); I.nidx = S >> I.ldil; I.cont = (pos > 0 && I.kblk > 0) ? 1 : 0; return I;
}
__device__ __forceinline__ void glds16(const void* gsrc, unsigned lds_dst) { unsigned keep;
    asm volatile("s_mov_b32 %0, m0\n\ts_mov_b32 m0, %2\n\ts_nop 0\n\tglobal_load_lds_dwordx4 %1, off\n\ts_mov_b32 m0, %0" : "=&s"(keep) : "v"(gsrc), "s"(lds_dst) : "memory"); }
template <bool HALF>
__device__ __forceinline__ void stage(LAS unsigned char* buf, const bf16* K, const bf16* V, const Item& I, int wave, int lane) {
    const unsigned lbase = (unsigned)__builtin_amdgcn_readfirstlane((int)(unsigned)(uintptr_t)buf);
    const int rsub = lane >> 3, c16 = lane & 7, kbase = 128 * I.kblk - 64;
    if (kbase >= 0 && kbase + 256 <= I.nidx) {
        const size_t tok0 = (size_t)I.seq_base + I.r + ((size_t)(kbase + 8 * wave + rsub) << I.ldil);
        const bf16* k0 = K + tok0 * 512 + I.h * 64 + ((c16 ^ rsub) << 3);
        const bf16* v0 = V + tok0 * 512 + I.h * 64 + ((c16 ^ (((rsub >> 1) & 3) << 1)) << 3);
        const size_t st = (size_t)65536 << I.ldil;
        const char* k1 = (const char*)k0 + st; const char* k2 = k1 + st; const char* k3 = k2 + st;
        const char* v1 = (const char*)v0 + st; const char* v2 = v1 + st; const char* v3 = v2 + st;
        unsigned keep;
        if (HALF)
            asm volatile("s_mov_b32 %0, m0\n\ts_mov_b32 m0, %5\n\ts_nop 0\n\tglobal_load_lds_dwordx4 %1, off\n\t"
                         "s_add_u32 m0, m0, 0x8000\n\ts_nop 0\n\tglobal_load_lds_dwordx4 %3, off\n\t"
                         "s_sub_u32 m0, m0, 0x6000\n\ts_nop 0\n\tglobal_load_lds_dwordx4 %2, off\n\t"
                         "s_add_u32 m0, m0, 0x8000\n\ts_nop 0\n\tglobal_load_lds_dwordx4 %4, off\n\t"
                         "s_mov_b32 m0, %0"
                         : "=&s"(keep) : "v"(k2), "v"(k3), "v"(v2), "v"(v3), "s"(lbase + wave * 1024 + 16384) : "memory", "scc");
        else
            asm volatile("s_mov_b32 %0, m0\n\ts_mov_b32 m0, %9\n\ts_nop 0\n\tglobal_load_lds_dwordx4 %1, off\n\t"
                         "s_add_u32 m0, m0, 0x8000\n\ts_nop 0\n\tglobal_load_lds_dwordx4 %5, off\n\t"
                         "s_sub_u32 m0, m0, 0x6000\n\ts_nop 0\n\tglobal_load_lds_dwordx4 %2, off\n\t"
                         "s_add_u32 m0, m0, 0x8000\n\ts_nop 0\n\tglobal_load_lds_dwordx4 %6, off\n\t"
                         "s_sub_u32 m0, m0, 0x6000\n\ts_nop 0\n\tglobal_load_lds_dwordx4 %3, off\n\t"
                         "s_add_u32 m0, m0, 0x8000\n\ts_nop 0\n\tglobal_load_lds_dwordx4 %7, off\n\t"
                         "s_sub_u32 m0, m0, 0x6000\n\ts_nop 0\n\tglobal_load_lds_dwordx4 %4, off\n\t"
                         "s_add_u32 m0, m0, 0x8000\n\ts_nop 0\n\tglobal_load_lds_dwordx4 %8, off\n\t"
                         "s_mov_b32 m0, %0"
                         : "=&s"(keep) : "v"(k0), "v"(k1), "v"(k2), "v"(k3), "v"(v0), "v"(v1), "v"(v2), "v"(v3), "s"(lbase + wave * 1024) : "memory", "scc");
        return;
    }
#pragma unroll
    for (int i = (HALF ? 2 : 0); i < 4; ++i) {
        const int p = wave + 8 * i, row = 8 * p + rsub; int kidx = kbase + row; kidx = kidx < 0 ? 0 : (kidx >= I.nidx ? I.nidx - 1 : kidx);
        const size_t tok = (size_t)I.seq_base + I.r + ((size_t)kidx << I.ldil);
        glds16(K + tok * 512 + I.h * 64 + ((c16 ^ (row & 7)) << 3), lbase + p * 1024);
        glds16(V + tok * 512 + I.h * 64 + ((c16 ^ (((row >> 1) & 3) << 1)) << 3), lbase + VOFF + p * 1024);
    }
}
__device__ __forceinline__ void slide(LAS unsigned char* dst, const LAS unsigned char* src, int wave, int lane) {
#pragma unroll
    for (int i = 0; i < 2; ++i) { const int o = (wave + 8 * i) * 1024 + lane * 16;
        const u32x4 a = *(const LAS u32x4*)(src + 16384 + o), b = *(const LAS u32x4*)(src + VOFF + 16384 + o);
        *(LAS u32x4*)(dst + o) = a; *(LAS u32x4*)(dst + VOFF + o) = b; }
}
__device__ __forceinline__ size_t q_token(const Item& I, int wave, int lane) { return (size_t)I.seq_base + I.r + ((size_t)(128 * I.kblk + 16 * wave + (lane & 15)) << I.ldil); }
struct Out { v2u w[4]; float lse; bf16* od; float* lp; };
__device__ __forceinline__ void store_out(const Out& o, int lane) {
#pragma unroll
    for (int dt = 0; dt < 4; ++dt) *(v2u*)(o.od + 16 * dt) = o.w[dt];
    if ((lane >> 4) == 0) *o.lp = o.lse;
}
__device__ __forceinline__ void compute(LAS unsigned char* buf, const Item& I, const bf16x8 (&qf)[2], size_t qtok, bf16* Ob, float* Lse, int wave, int lane, Out& out) {
    const int qi = lane & 15, g4 = lane >> 4, kbase = 128 * I.kblk - 64;
    const LAS unsigned char* kp0 = buf + (16 * wave + qi) * 128 + ((g4 ^ (qi & 7)) << 4);
    const LAS unsigned char* kp1 = buf + (16 * wave + qi) * 128 + (((4 + g4) ^ (qi & 7)) << 4);
    bf16x8 kf0[9], kf1[9];
#pragma unroll
    for (int kt = 0; kt < 9; ++kt) { kf0[kt] = *(const LAS bf16x8*)(kp0 + kt * 2048); kf1[kt] = *(const LAS bf16x8*)(kp1 + kt * 2048); }
    __builtin_amdgcn_sched_barrier(0);
    f32x4 sc[9];
#pragma unroll
    for (int kt = 0; kt < 9; ++kt) sc[kt] = __builtin_amdgcn_mfma_f32_16x16x32_bf16(kf0[kt], qf[0], (f32x4){0.f, 0.f, 0.f, 0.f}, 0, 0, 0);
#pragma unroll
    for (int kt = 0; kt < 9; ++kt) sc[kt] = __builtin_amdgcn_mfma_f32_16x16x32_bf16(kf1[kt], qf[1], sc[kt], 0, 0, 0);
    __builtin_amdgcn_sched_barrier(0);
    const int il = lane & 15, q_ = il >> 2, p_ = il & 3, rr = 4 * g4 + q_, sw = (rr >> 1) & 3;
    const LAS unsigned char* vb = buf + VOFF + (16 * wave + rr) * 128 + p_ * 8;
    v4i16_t vlo[5][4], vhi[5][4];
#pragma unroll
    for (int ks = 0; ks < 5; ++ks) {
        const int hioff = (ks == 4 && wave == 7) ? 0 : 2048;
        if (ks > 0) asm volatile("s_waitcnt lgkmcnt(7)" ::: "memory");
#pragma unroll
        for (int dt = 0; dt < 4; ++dt) {
            vlo[ks][dt] = __builtin_amdgcn_ds_read_tr16_b64_v4i16((LAS v4i16_t*)(vb + ks * 4096 + ((dt ^ sw) << 5)));
            vhi[ks][dt] = __builtin_amdgcn_ds_read_tr16_b64_v4i16((LAS v4i16_t*)(vb + ks * 4096 + hioff + ((dt ^ sw) << 5)));
        }
    }
    __builtin_amdgcn_sched_barrier(0);
#pragma unroll
    for (int e = 0; e < 4; ++e) { const int jj = 4 * g4 + e; if (jj < qi) sc[0][e] = -INFINITY; if (jj > qi) sc[8][e] = -INFINITY; }
    if (kbase < 0 || kbase + 256 > I.nidx) {
#pragma unroll
        for (int kt = 0; kt < 9; ++kt)
#pragma unroll
            for (int e = 0; e < 4; ++e) { const int kidx = kbase + 16 * (wave + kt) + 4 * g4 + e; if ((unsigned)kidx >= (unsigned)I.nidx) sc[kt][e] = -INFINITY; }
    }
    float mx = sc[0][0];
#pragma unroll
    for (int kt = 0; kt < 9; ++kt)
#pragma unroll
        for (int e = 0; e < 4; ++e) mx = fmaxf(mx, sc[kt][e]);
    mx = xmax16_32(mx);
    bf16x8 pf[5]; float lsv = 0.f;
#pragma unroll
    for (int ks = 0; ks < 5; ++ks) {
        f32x4 pa, pb;
#pragma unroll
        for (int e = 0; e < 4; ++e) { pa[e] = fexp2(sc[2 * ks][e] - mx); pb[e] = (ks < 4) ? fexp2(sc[2 * ks + 1][e] - mx) : 0.f; }
#pragma unroll
        for (int e = 0; e < 4; ++e) lsv += pa[e] + pb[e];
        pf[ks] = __builtin_bit_cast(bf16x8, pack8(pa, pb));
    }
    __builtin_amdgcn_sched_barrier(0);
    f32x4 o[4];
#pragma unroll
    for (int dt = 0; dt < 4; ++dt) o[dt] = (f32x4){0.f, 0.f, 0.f, 0.f};
#pragma unroll
    for (int ks = 0; ks < 5; ++ks) {
#pragma unroll
        for (int dt = 0; dt < 4; ++dt) {
            const bf16x8 vf = (bf16x8){vlo[ks][dt][0], vlo[ks][dt][1], vlo[ks][dt][2], vlo[ks][dt][3], vhi[ks][dt][0], vhi[ks][dt][1], vhi[ks][dt][2], vhi[ks][dt][3]};
            o[dt] = __builtin_amdgcn_mfma_f32_16x16x32_bf16(vf, pf[ks], o[dt], 0, 0, 0);
        }
    }
    const float ls = xsum16_32(lsv);
    const float inv = frcp(ls);
    out.od = Ob + ((size_t)I.br * M + qtok) * 512 + I.h * 64 + 4 * g4; out.lp = Lse + ((size_t)I.br * M + qtok) * 8 + I.h;
#pragma unroll
    for (int dt = 0; dt < 4; ++dt) { out.w[dt].x = cvt_pk_bf16(o[dt][0] * inv, o[dt][1] * inv); out.w[dt].y = cvt_pk_bf16(o[dt][2] * inv, o[dt][3] * inv); }
    out.lse = (mx + __builtin_amdgcn_logf(ls)) * LN2F;
}
__device__ __forceinline__ int run_of(int bx, int G, int k) {
    if (G != 256) { const int hs = bx + k * G; return hs < 1536 ? hs : 1536; }
    if (bx < 128) return k < 5 ? bx + 128 * k : 1536;
    return k < 7 ? 640 + (bx - 128) + 128 * k : 1536;
}
__device__ __forceinline__ void phase(LAS unsigned char* ring, const bf16* Q, const bf16* K, const bf16* V, bf16* Ob, float* Lse, int bx, int G, int wave, int lane) {
    int i = 0, hsc = run_of(bx, G, 0), hsn = hsc;
    bf16x8 qc[2], qn[2]; size_t tokc = 0, tokn = 0;
    qc[0] = qc[1] = qn[0] = qn[1] = (bf16x8){0, 0, 0, 0, 0, 0, 0, 0};
    if (hsc < 1536) { const Item I = decode(hsc, 0); stage<false>(ring, K, V, I, wave, lane); tokc = q_token(I, wave, lane);
        qc[0] = *(const bf16x8*)(Q + tokc * 512 + I.h * 64 + 8 * (lane >> 4)); qc[1] = *(const bf16x8*)(Q + tokc * 512 + I.h * 64 + 32 + 8 * (lane >> 4)); }
    asm volatile("s_waitcnt vmcnt(0)" : "+v"(qc[0]), "+v"(qc[1]) :: "memory"); __builtin_amdgcn_s_barrier(); asm volatile("" ::: "memory");
    int b = 0; Out po; bool have = false;
    po.od = nullptr; po.lp = nullptr; po.lse = 0.f; po.w[0] = po.w[1] = po.w[2] = po.w[3] = (v2u){0u, 0u};
    while (hsc < 1536) {
        if (have) store_out(po, lane);
        const int in = i + 1; hsn = run_of(bx, G, in >> 2);
        if (hsn < 1536) { const Item In = decode(hsn, in & 3);
            if (In.cont) { slide(ring + (b ^ 1) * BUFB, ring + b * BUFB, wave, lane); stage<true>(ring + (b ^ 1) * BUFB, K, V, In, wave, lane); }
            else stage<false>(ring + (b ^ 1) * BUFB, K, V, In, wave, lane);
            tokn = q_token(In, wave, lane);
            qn[0] = *(const bf16x8*)(Q + tokn * 512 + In.h * 64 + 8 * (lane >> 4)); qn[1] = *(const bf16x8*)(Q + tokn * 512 + In.h * 64 + 32 + 8 * (lane >> 4)); }
        { const Item I = decode(hsc, i & 3); compute(ring + b * BUFB, I, qc, tokc, Ob, Lse, wave, lane, po); have = true; }
        asm volatile("s_waitcnt vmcnt(0) lgkmcnt(0)" : "+v"(qn[0]), "+v"(qn[1]) :: "memory"); __builtin_amdgcn_s_barrier(); asm volatile("" ::: "memory");
        i = in; hsc = hsn; qc[0] = qn[0]; qc[1] = qn[1]; tokc = tokn; b ^= 1;
    }
    if (have) store_out(po, lane);
    __syncthreads();
}
}

__global__ void __launch_bounds__(NWAVES * 64, 2) mk_fwd(Args args) {
    extern __shared__ __attribute__((aligned(16))) unsigned char lds_raw[];
    LAS unsigned char* lds = (LAS unsigned char*)lds_raw;
    volatile LAS unsigned* MISC = (volatile LAS unsigned*)(lds + MISC_OFF);
    const int tid = threadIdx.x, lane = tid & 63, wave = __builtin_amdgcn_readfirstlane(tid >> 6);
    const int G = gridDim.x, bx = blockIdx.x;
    const int vcu = (G % 8 == 0) ? (bx % 8) * (G / 8) + bx / 8 : bx;
    const int gw = vcu * NWAVES + wave, NGW = G * NWAVES;
    const int gtid = gw * 64 + lane, NT = NGW * 64;
    unsigned char* ws = args.ws;
    gu32* ctl = (gu32*)(ws + WS_CTL);
    for (int u = tid; u < (LDS_BYTES - LDSCTL_OFF) / 4; u += NWAVES * 64) ((LAS unsigned*)(lds + LDSCTL_OFF))[u] = 0u;
    __syncthreads();
    if (tid == 0) { LAS unsigned long long* p = (LAS unsigned long long*)(lds + PARAM_OFF); p[0] = (unsigned long long)args.in[0]; p[1] = (unsigned long long)args.in[1]; p[2] = (unsigned long long)args.out; p[3] = (unsigned long long)args.ws;
        p[4] = (unsigned long long)args.in[17]; p[5] = (unsigned long long)args.in[19]; p[6] = (unsigned long long)args.in[21]; p[7] = (unsigned long long)args.in[25]; }
    __syncthreads();
    XcdBarrier bar; bar.bar = (unsigned*)(ctl + CW_BAR); bar.x = 0; bar.st = nullptr;
    if (MK_N_LAUNCHES == 1) bar = xcd_barrier_post((unsigned*)(ctl + CW_BAR), MISC + 8);
    const int lo = args.ph_lo, hi = args.ph_hi;
#ifndef REP_MASK
#define REP_MASK 0
#endif
#define IN(k) (lo <= (k) && (k) < hi)
#define REPS(k) (1 + ((REP_MASK >> (k)) & 1))
#ifndef TIME_PHASE
#define TIME_PHASE -1
#endif
    unsigned long long tp0 = (TIME_PHASE >= 0) ? __builtin_amdgcn_s_memrealtime() : 0ull;
#define SEAM(k) do { if (IN(k) && IN((k) + 1)) { \
        xcd_barrier(bar); \
        if (TIME_PHASE >= 0 && bx == 0 && tid == 0) { unsigned long long t1 = __builtin_amdgcn_s_memrealtime(); \
            if ((k) == TIME_PHASE) { const unsigned long long dt = t1 - tp0; while (__builtin_amdgcn_s_memrealtime() - t1 < 9ull * dt) __builtin_amdgcn_s_sleep(8); t1 = __builtin_amdgcn_s_memrealtime(); } \
            tp0 = t1; } } } while (0)

    float* modf = (float*)(ws + WS_MODF); float* modp = (float*)(ws + WS_MODP);
    float* t_ldre = (float*)(ws + WS_LDRE); float* t_zre = (float*)(ws + WS_ZRE); float* t_zim = (float*)(ws + WS_ZIM); float* t_atre = (float*)(ws + WS_ATRE); float* t_atim = (float*)(ws + WS_ATIM); double* t_theta = (double*)(ws + WS_THETA);
    bf16* W13T = (bf16*)(ws + WS_W13); bf16* WinT = (bf16*)(ws + WS_WIN); bf16* WgluT = (bf16*)(ws + WS_WGLU); bf16* WoT = (bf16*)(ws + WS_WO); bf16* W2T = (bf16*)(ws + WS_W2);
    bf16* Ptab = (bf16*)(ws + WS_PTAB); float* Sbuf = (float*)(ws + WS_SBUF); bf16* Klag = (bf16*)(ws + WS_KLAG); bf16* Toep = (bf16*)(ws + WS_TOEP);
    float* cosT = (float*)(ws + WS_ROPE); float* sinT = cosT + 16384 * 32;
    bf16* Ub = (bf16*)(ws + WS_U); bf16* Qb = (bf16*)(ws + WS_Q); bf16* Kb = (bf16*)(ws + WS_K); bf16* Vb = (bf16*)(ws + WS_V);
    bf16* Gb = (bf16*)(ws + WS_G); bf16* SsmRaw = (bf16*)(ws + WS_SSMRAW); bf16* MixA = (bf16*)(ws + WS_MIXA); bf16* H2 = (bf16*)(ws + WS_H2); bf16* Act = (bf16*)(ws + WS_ACT);
    bf16* H1 = (bf16*)((unsigned char*)args.out + DO_H1); bf16* Ob = (bf16*)((unsigned char*)args.out + DO_OB); float* Lse = (float*)((unsigned char*)args.out + DO_LSE);
    LAS float* scr = (LAS float*)(lds + RING_OFF + wave * 16384);

    if (IN(0)) for (int rep_ = 0; rep_ < REPS(0); ++rep_) {
        constexpr int I_IN = 16 * 64, I_GLU = 8 * 16, I_O = 16 * 32, I_1 = 16 * 88;
        constexpr int NITEMS = I_IN + I_GLU + I_O + 2 * I_1;
#ifndef P0_PROBE
#define P0_PROBE 0
#endif
        for (int p0r = 0; p0r < 1 + (P0_PROBE & 1); ++p0r)
        for (int it = gw; it < NITEMS; it += NGW) {
            int r = it;
            if (r < I_IN) { transpose_item(args.in[7], D, NPROJ, WinT, scr, r, lane, MapWin{}); continue; } r -= I_IN;
            if (r < I_GLU) { transpose_item(args.in[16], 512, 512, WgluT, scr, r, lane, MapId{}); continue; } r -= I_GLU;
            if (r < I_O) { transpose_item(args.in[20], D, D, WoT, scr, r, lane, MapId{}); continue; } r -= I_O;
            if (r < I_1) { transpose_item(args.in[22], D, FF, W13T, scr, r, lane, MapW13{0}); continue; } r -= I_1;
            transpose_item(args.in[23], D, FF, W13T, scr, r, lane, MapW13{128});
        }
        {
            LAS float* sl = (LAS float*)(lds + RING_OFF);
            LAS f32x2v* red2 = (LAS f32x2v*)(lds + RING_OFF + 20480);
            __syncthreads();
            for (int i = tid; i < 5 * 1024; i += NWAVES * 64) { const float cv = i < 1024 ? args.in[2][i] : args.in[3][i - 1024]; sl[i] = cv * sigm(cv); }
            __syncthreads();
            for (int p0r = 0; p0r < 1 + ((P0_PROBE >> 1) & 1); ++p0r)
            for (int task = vcu; task < 48 * 16; task += G) {
                const int cb = task % 48, ks = task / 48, n = 128 * cb + 2 * lane, k0 = 64 * ks + 8 * wave;
                const float* W = args.in[4] + (size_t)k0 * NMOD + n;
                f32x2v w[8];
#pragma unroll
                for (int i = 0; i < 8; ++i) w[i] = *(const f32x2v*)(W + (size_t)i * NMOD);
                f32x2v a0 = {0.f, 0.f}, a1 = a0, a2 = a0, a3 = a0, a4 = a0;
#pragma unroll
                for (int i = 0; i < 8; ++i) { const int k = k0 + i; a0 += w[i] * sl[k]; a1 += w[i] * sl[1024 + k]; a2 += w[i] * sl[2048 + k]; a3 += w[i] * sl[3072 + k]; a4 += w[i] * sl[4096 + k]; }
                __syncthreads();
                red2[(wave * 5 + 0) * 64 + lane] = a0; red2[(wave * 5 + 1) * 64 + lane] = a1; red2[(wave * 5 + 2) * 64 + lane] = a2; red2[(wave * 5 + 3) * 64 + lane] = a3; red2[(wave * 5 + 4) * 64 + lane] = a4;
                __syncthreads();
                if (wave < 5) { f32x2v t = red2[(0 * 5 + wave) * 64 + lane];
#pragma unroll
                    for (int v = 1; v < 8; ++v) t += red2[(v * 5 + wave) * 64 + lane];
                    *(f32x2v*)(modp + (size_t)(ks * 5 + wave) * NMOD + n) = t; }
            }
            __syncthreads();
        }
        for (int p0r = 0; p0r < 1 + ((P0_PROBE >> 2) & 1); ++p0r)
        for (int idx = gtid; idx < 16384 * 32; idx += NT) { const int pos = idx >> 5, i = idx & 31;
            const float inv = fexp2(-(float)i * 0.41524101186092033f); const float ang = (float)pos * inv; float s, c; sincos_rev((double)ang * INV_2PI, s, c); cosT[idx] = c; sinT[idx] = s; }
        for (int idx = gtid; idx < 4096; idx += NT) {
            const float dt = fexp2(args.in[10][idx >> 6] * LOG2E), lr = args.in[8][idx], li = args.in[9][idx];
            const float ldre = lr * dt; const double th = (double)li * (double)dt * INV_2PI;
            float s, c; sincos_rev(th, s, c); const float mag = fexp2(ldre * LOG2E), are = mag * c, aim = mag * s;
            const float nr = are - 1.f, den = lr * lr + li * li;
            t_ldre[idx] = ldre; t_theta[idx] = th; t_zre[idx] = (nr * lr + aim * li) / den; t_zim[idx] = (aim * lr - nr * li) / den;
            float sT, cT; sincos_rev((double)TCH * th, sT, cT); const float mT = fexp2((float)TCH * ldre * LOG2E); t_atre[idx] = mT * cT; t_atim[idx] = mT * sT;
        }
    }
    SEAM(0);

    if (IN(1)) for (int rep_ = 0; rep_ < REPS(1); ++rep_) {
        for (int e = gtid; e < 5 * NMOD; e += NT) { const int b = e / NMOD, n = e % NMOD; float v = args.in[5][n];
#pragma unroll
            for (int ks = 0; ks < 16; ++ks) v += modp[(size_t)(ks * 5 + b) * NMOD + n];
            modf[e] = v; }
#pragma unroll 1
        for (int step = 0; step < 2; ++step) {
        if ((step == 0) == ((bx & 1) == 0)) {
        LAS float* Gm = (LAS float*)(lds + RING_OFF + 65536); LAS float* Sh = Gm + 1024;
        for (int rb = vcu; rb < M / 128; rb += G) {
            const int row0 = rb * 128, b = batch_of(row0);
            __syncthreads();
            for (int k = tid; k < 1024; k += NWAVES * 64) { float sc = args.in[5][1024 + k], sh = args.in[5][k];
#pragma unroll
                for (int ks = 0; ks < 16; ++ks) { sc += modp[(size_t)(ks * 5 + b) * NMOD + 1024 + k]; sh += modp[(size_t)(ks * 5 + b) * NMOD + k]; }
                Gm[k] = args.in[6][k] * (1.f + sc); Sh[k] = sh; }
            __syncthreads();
            for (int i = 0; i < 16; i += 8) { const int row = row0 + wave * 16 + i; const float* xb = xrow_ptr(args, row); bf16* ob = H1 + (size_t)row * D;
                const float* xr[8] = {xb, xb + D, xb + 2 * D, xb + 3 * D, xb + 4 * D, xb + 5 * D, xb + 6 * D, xb + 7 * D};
                bf16* orw[8] = {ob, ob + D, ob + 2 * D, ob + 3 * D, ob + 4 * D, ob + 5 * D, ob + 6 * D, ob + 7 * D}; norm_rows_lds<8>(xr, orw, Gm, Sh, lane); }
        }
        } else {
        for (int task = vcu; task < 256; task += G) {
            const int g = task >> 3, lb = task & 7;
            LAS float* Bre = (LAS float*)(lds + RING_OFF);
            LAS float* Bim = Bre + 2048;
            LAS float* CZr = Bim + 2048;
            LAS float* CZi = CZr + 2080;
            LAS float* PWr = CZi + 2080;
            LAS float* PWi = PWr + 520;
            LAS float* X0 = PWi + 520;
            __syncthreads();
            for (int i = tid; i < 2048; i += NWAVES * 64) {
                const int dir = i >> 10, rem = i & 1023, gd = dir * 32 + g;
                Bre[i] = args.in[11][(size_t)gd * 1024 + rem]; Bim[i] = args.in[12][(size_t)gd * 1024 + rem];
                const int c = rem >> 6, n = rem & 63, bi = gd * 64 + n;
                const float cr = args.in[13][(size_t)gd * 1024 + rem], ci = args.in[14][(size_t)gd * 1024 + rem], zr = t_zre[bi], zi = t_zim[bi];
                CZr[(dir * 16 + c) * 65 + n] = cr * zr - ci * zi; CZi[(dir * 16 + c) * 65 + n] = cr * zi + ci * zr;
            }
            { const int i = tid; const int dir = i >> 8, l = (i >> 6) & 3, n = i & 63; float pre, pim; cpow_tab(t_ldre, t_theta, (dir * 32 + g) * 64 + n, 4 * lb + l, pre, pim);
                PWr[(dir * 4 + l) * 65 + n] = pre; PWi[(dir * 4 + l) * 65 + n] = pim; }
            __syncthreads();
            const int dir = tid >> 8, l = (tid >> 6) & 3, c = (tid >> 2) & 15, cq = tid & 3, tau = 4 * lb + l;
            f32x4 acc = {0.f, 0.f, 0.f, 0.f};
            const LAS float* czr = CZr + (dir * 16 + c) * 65; const LAS float* czi = CZi + (dir * 16 + c) * 65;
            const LAS float* pwr = PWr + (dir * 4 + l) * 65; const LAS float* pwi = PWi + (dir * 4 + l) * 65;
#pragma unroll 8
            for (int n = 0; n < 64; ++n) {
                const float a = czr[n], b = czi[n], pr = pwr[n], pi = pwi[n], wr_ = a * pr - b * pi, wi_ = a * pi + b * pr;
                const f32x4 r0 = *(const LAS f32x4*)(Bre + dir * 1024 + n * 16 + 4 * cq), m0 = *(const LAS f32x4*)(Bim + dir * 1024 + n * 16 + 4 * cq);
                acc += r0 * wr_ - m0 * wi_;
            }
            if (tau == 0 && dir == 1) *(LAS f32x4*)(X0 + c * 16 + 4 * cq) = acc;
            __syncthreads();
            if (tau == 0 && dir == 0) { const float dsk = args.in[15][16 * g + c]; const f32x4 xo = *(const LAS f32x4*)(X0 + c * 16 + 4 * cq);
#pragma unroll
                for (int j = 0; j < 4; ++j) acc[j] += xo[j] + ((4 * cq + j == c) ? dsk : 0.f); }
            if (!(tau == 0 && dir == 1)) {
                const int ti = dir == 0 ? (TCH - 1) + tau : (TCH - 1) - tau;
                v2u o; o.x = pk2(acc[0], acc[1]); o.y = pk2(acc[2], acc[3]);
                *(v2u*)(Klag + ((size_t)((g * (2 * TCH - 1) + ti) * 16 + c) * 16 + 4 * cq)) = o;
            }
        }
        for (int e = gtid; e < 32 * 2 * 64 * TCH; e += NT) {
            const int s = e & 31, n = (e >> 5) & 63, dir = (e >> 11) & 1, g = e >> 12, bi = (dir * 32 + g) * 64 + n;
            float pre, pim; cpow_tab(t_ldre, t_theta, bi, dir == 0 ? (TCH - 1) - s : s, pre, pim);
            const float zr = t_zre[bi], zi = t_zim[bi], wr_ = pre * zr - pim * zi, wi_ = pre * zi + pim * zr;
            const f32x4* br = (const f32x4*)(args.in[11] + (size_t)bi * 16); const f32x4* bm = (const f32x4*)(args.in[12] + (size_t)bi * 16);
            float re[16], im[16];
#pragma unroll
            for (int j4 = 0; j4 < 4; ++j4) { const f32x4 b1 = br[j4], b2 = bm[j4];
#pragma unroll
                for (int e2 = 0; e2 < 4; ++e2) { re[4 * j4 + e2] = wr_ * b1[e2] - wi_ * b2[e2]; im[4 * j4 + e2] = wr_ * b2[e2] + wi_ * b1[e2]; } }
            bf16* d0 = Ptab + ((size_t)(g * 256 + dir * 128 + 2 * n) * (16 * TCH) + s * 16);
            v4u o; o.x = pk2(re[0], re[1]); o.y = pk2(re[2], re[3]); o.z = pk2(re[4], re[5]); o.w = pk2(re[6], re[7]); *(v4u*)d0 = o;
            o.x = pk2(re[8], re[9]); o.y = pk2(re[10], re[11]); o.z = pk2(re[12], re[13]); o.w = pk2(re[14], re[15]); *(v4u*)(d0 + 8) = o;
            o.x = pk2(im[0], im[1]); o.y = pk2(im[2], im[3]); o.z = pk2(im[4], im[5]); o.w = pk2(im[6], im[7]); *(v4u*)(d0 + 16 * TCH) = o;
            o.x = pk2(im[8], im[9]); o.y = pk2(im[10], im[11]); o.z = pk2(im[12], im[13]); o.w = pk2(im[14], im[15]); *(v4u*)(d0 + 16 * TCH + 8) = o;
        }
        }
        }
    }
    SEAM(1);

    if (IN(2)) for (int rep_ = 0; rep_ < REPS(2); ++rep_) {
        pg8::Gemm g{H1, WinT, M, NPROJ, D, D, D}; DupOrder<(DUP_MASK >> 2) & 1> S; S.S.init(M, NPROJ, G, bx);
        EpiQKV E{Qb, Kb, Vb, Ub, cosT, sinT};
        pg8::gemm_phase<EpiQKV, DupOrder<(DUP_MASK >> 2) & 1>, true, true>(lds + RING_OFF, g, S, E);
    }
    SEAM(2);

    if (IN(3)) {
        { pg8::Gemm g{Ub, Ptab, NG * NCG, NG * 256, 16 * TCH, UP, 16 * TCH}; SchedState S{bx}; EpiState E{Sbuf};
          pg8::gemm_phase<EpiState, SchedState, true, true>(lds + RING_OFF, g, S, E); }
        for (int rep_ = 0; rep_ < REPS(3); ++rep_) att::phase(lds + RING_OFF, Qb, Kb, Vb, Ob, Lse, bx, G, wave, lane);
    }
    SEAM(3);

    if (IN(4)) for (int rep_ = 0; rep_ < REPS(4); ++rep_) {
        if (bx < 128) {
            int seq, g, dir, nc, chunk0, sgi;
            if (bx < 64) { seq = 0; g = bx >> 1; dir = bx & 1; nc = 512; chunk0 = 0; sgi = wave; }
            else { const int q = (bx - 64) * 4 + (wave >> 1); seq = 1 + (q >> 6); g = (q >> 1) & 31; dir = q & 1; nc = 128; chunk0 = 512 + 128 * (seq - 1); sgi = wave & 1; }
            const int i_lo = 64 * sgi;
            const int bi = (dir * 32 + g) * 64 + lane; const float ar = t_atre[bi], ai = t_atim[bi];
            float hr = 0.f, hi_ = 0.f;
            LAS float* T = (LAS float*)(lds + RING_OFF);
#pragma unroll 1
            for (int i0 = i_lo; i0 < i_lo + 64; i0 += 32) {
                f32x2v sv[32];
#pragma unroll
                for (int j = 0; j < 32; ++j) { const int c = dir == 0 ? i0 + j : nc - 1 - (i0 + j); sv[j] = *(const f32x2v*)(Sbuf + ((size_t)(g * NCG + chunk0 + c) * 256 + dir * 128 + 2 * lane)); }
#pragma unroll
                for (int j = 0; j < 32; ++j) { const float nr = ar * hr - ai * hi_ + sv[j].x, ni = ar * hi_ + ai * hr + sv[j].y; hr = nr; hi_ = ni; }
            }
            __syncthreads();
            T[(wave * 64 + lane) * 2] = hr; T[(wave * 64 + lane) * 2 + 1] = hi_;
            __syncthreads();
            float pr = ar, pi = ai;
#pragma unroll
            for (int k = 0; k < 6; ++k) { const float nr = pr * pr - pi * pi, ni = 2.f * pr * pi; pr = nr; pi = ni; }
            hr = 0.f; hi_ = 0.f;
            for (int v = wave - sgi; v < wave; ++v) { const float tr = T[(v * 64 + lane) * 2], ti2 = T[(v * 64 + lane) * 2 + 1]; const float nr = pr * hr - pi * hi_ + tr, ni = pr * hi_ + pi * hr + ti2; hr = nr; hi_ = ni; }
#pragma unroll 1
            for (int i0 = i_lo; i0 < i_lo + 64; i0 += 32) {
                f32x2v sv[32];
#pragma unroll
                for (int j = 0; j < 32; ++j) { const int c = dir == 0 ? i0 + j : nc - 1 - (i0 + j); sv[j] = *(const f32x2v*)(Sbuf + ((size_t)(g * NCG + chunk0 + c) * 256 + dir * 128 + 2 * lane)); }
#pragma unroll
                for (int j = 0; j < 32; ++j) { const int c = dir == 0 ? i0 + j : nc - 1 - (i0 + j);
                    *(unsigned*)(Ub + ((size_t)(g * NCG + chunk0 + c) * UP + 16 * TCH + dir * 128 + 2 * lane)) = pk2(hr, hi_);
                    const float nr = ar * hr - ai * hi_ + sv[j].x, ni = ar * hi_ + ai * hr + sv[j].y; hr = nr; hi_ = ni; }
            }
        }
        for (int e = gtid; e < 32 * TCH * 16 * TCH; e += NT) {
            const int s = e & 31, c = (e >> 5) & 15, t = (e >> 9) & 31, g = e >> 14;
            const v4u* src = (const v4u*)(Klag + ((size_t)((g * (2 * TCH - 1) + (t - s + TCH - 1)) * 16 + c) * 16));
            v4u* dst = (v4u*)(Toep + ((size_t)(g * 16 * TCH + t * 16 + c) * UP + s * 16));
            const v4u a = src[0], b = src[1]; dst[0] = a; dst[1] = b;
        }
        for (int e = gtid; e < 32 * TCH * 2 * 64; e += NT) {
            const int n = e & 63, dir = (e >> 6) & 1, t = (e >> 7) & 31, g = e >> 12, bi = (dir * 32 + g) * 64 + n;
            float pre, pim; cpow_tab(t_ldre, t_theta, bi, dir == 0 ? t + 1 : TCH - t, pre, pim);
#pragma unroll 4
            for (int c = 0; c < 16; ++c) {
                const float cr = args.in[13][(size_t)((dir * 32 + g) * 16 + c) * 64 + n], ci = args.in[14][(size_t)((dir * 32 + g) * 16 + c) * 64 + n];
                *(unsigned*)(Toep + ((size_t)(g * 16 * TCH + t * 16 + c) * UP + 16 * TCH + dir * 128 + 2 * n)) = pk2(cr * pre - ci * pim, -(cr * pim + ci * pre));
            }
        }
    }
    SEAM(4);

    if (IN(5)) for (int rep_ = 0; rep_ < REPS(5); ++rep_) {
        pg8::Gemm g{Ub, Toep, NG * NCG, NG * 16 * TCH, UP, UP, UP}; SchedSsmOut S{vcu}; EpiSsmOut E{Gb};
        pg8::gemm_phase<EpiSsmOut, SchedSsmOut, true, true>(lds + RING_OFF, g, S, E);
    }
    SEAM(5);

    if (IN(6)) for (int rep_ = 0; rep_ < REPS(6); ++rep_) {
        pg8::Gemm g{Gb, WgluT, M, 512, 512, 512, 512}; DupOrder<(DUP_MASK >> 6) & 1> S; S.S.init(M, 512, G, bx);
        EpiGluNorm E{lds};
        pg8::gemm_phase<EpiGluNorm, DupOrder<(DUP_MASK >> 6) & 1>, true, true>(lds + RING_OFF, g, S, E);
#ifndef P6_PROBE
#define P6_PROBE 0
#endif
        for (int p6r = 0; p6r < 1 + (P6_PROBE & 1); ++p6r)
        for (int t0 = 2 * gw; t0 < M; t0 += 2 * NGW) {
            const int hh = lane >> 3;
            float l0[2], l1[2], l2[2]; v4u a[2], bb[2], c[2];
#pragma unroll
            for (int k = 0; k < 2; ++k) { const size_t t = t0 + k;
                l0[k] = __builtin_nontemporal_load(Lse + t * 8 + hh); l1[k] = __builtin_nontemporal_load(Lse + ((size_t)M + t) * 8 + hh); l2[k] = __builtin_nontemporal_load(Lse + ((size_t)2 * M + t) * 8 + hh);
                a[k] = __builtin_nontemporal_load((const v4u*)(Ob + t * 512 + 8 * lane)); bb[k] = __builtin_nontemporal_load((const v4u*)(Ob + ((size_t)M + t) * 512 + 8 * lane)); c[k] = __builtin_nontemporal_load((const v4u*)(Ob + ((size_t)2 * M + t) * 512 + 8 * lane)); }
            const f32x4 g0 = *(const f32x4*)(args.in[18] + 8 * lane), g1 = *(const f32x4*)(args.in[18] + 8 * lane + 4);
#pragma unroll
            for (int k = 0; k < 2; ++k) {
                const float lm = fmaxf(l0[k], fmaxf(l1[k], l2[k]));
                float w0 = fexp2((l0[k] - lm) * LOG2E), w1 = fexp2((l1[k] - lm) * LOG2E), w2 = fexp2((l2[k] - lm) * LOG2E);
                const float wi = frcp(w0 + w1 + w2); w0 *= wi; w1 *= wi; w2 *= wi;
                float v[8];
                v[0] = w0 * bflo(a[k].x) + w1 * bflo(bb[k].x) + w2 * bflo(c[k].x); v[1] = w0 * bfhi(a[k].x) + w1 * bfhi(bb[k].x) + w2 * bfhi(c[k].x);
                v[2] = w0 * bflo(a[k].y) + w1 * bflo(bb[k].y) + w2 * bflo(c[k].y); v[3] = w0 * bfhi(a[k].y) + w1 * bfhi(bb[k].y) + w2 * bfhi(c[k].y);
                v[4] = w0 * bflo(a[k].z) + w1 * bflo(bb[k].z) + w2 * bflo(c[k].z); v[5] = w0 * bfhi(a[k].z) + w1 * bfhi(bb[k].z) + w2 * bfhi(c[k].z);
                v[6] = w0 * bflo(a[k].w) + w1 * bflo(bb[k].w) + w2 * bflo(c[k].w); v[7] = w0 * bfhi(a[k].w) + w1 * bfhi(bb[k].w) + w2 * bfhi(c[k].w);
                float sq = 0.f;
#pragma unroll
                for (int j = 0; j < 8; ++j) sq += v[j] * v[j];
                const float rs = __builtin_amdgcn_rsqf(wave_sum(sq) * (1.f / 512.f) + EPS);
                v4u o; o.x = pk2(v[0] * rs * g0[0], v[1] * rs * g0[1]); o.y = pk2(v[2] * rs * g0[2], v[3] * rs * g0[3]); o.z = pk2(v[4] * rs * g1[0], v[5] * rs * g1[1]); o.w = pk2(v[6] * rs * g1[2], v[7] * rs * g1[3]);
                *(v4u*)(MixA + (size_t)(t0 + k) * D + 8 * lane) = o;
            }
        }
    }
    SEAM(6);


    if (IN(8)) {
        pg8::Gemm g{MixA, WoT, M, D, D, D, D, H2, W13T}; EpiWoUp E{lds};
        if (G == 256) {
#pragma unroll 1
            for (int part = 0; part < 2; ++part) { SchedWoUp S{bx, (const unsigned*)(ctl + CW_READY), part == 0 ? 0 : 1, part == 0 ? 1 : 12};
                pg8::gemm_phase<EpiWoUp, SchedWoUp, true, true>(lds + RING_OFF, g, S, E); }
        }
    }
    SEAM(8);

    if (IN(11)) for (int rep_ = 0; rep_ < REPS(11); ++rep_) {
        for (int it = gw; it < 44 * 32; it += NGW) transpose_item(args.in[24], FF, D, W2T, scr, it, lane, MapId{});
    }
    SEAM(11);
#ifdef EXTRA_BARS
    for (int xb_ = 0; xb_ < EXTRA_BARS; ++xb_) xcd_barrier(bar);
#endif

    if (IN(12)) {
        pg8::Gemm g{Act, W2T, M, D, FF, FF, FF}; DupOrder<((DUP_MASK >> 12) & 1) + 2 * ((DUP_MASK >> 13) & 1)> S; S.S.init(M, D, G, bx);
        EpiDownFinal E{lds};
        pg8::gemm_phase<EpiDownFinal, DupOrder<((DUP_MASK >> 12) & 1) + 2 * ((DUP_MASK >> 13) & 1)>, true, true>(lds + RING_OFF, g, S, E);
    }
    if (TIME_PHASE == 12 && bx == 0) { __syncthreads(); if (tid == 0) { const unsigned long long t1 = __builtin_amdgcn_s_memrealtime(); const unsigned long long dt = t1 - tp0; while (__builtin_amdgcn_s_memrealtime() - t1 < 9ull * dt) __builtin_amdgcn_s_sleep(8); } }
#undef IN
#undef SEAM
}

extern "C" void kernel_launch(void* const* d_in, const int* in_sizes, int n_in, void* d_out, int out_size, void* d_ws, size_t ws_size, hipStream_t stream) {
    static int grid = 0;
    if (grid == 0) {
        if (n_in != 26 || in_sizes[0] != MP * D || out_size != M * D || ws_size < WS_END) { fprintf(stderr, "kernel_launch: unexpected shapes (n_in %d, in0 %d, out %d, ws %zu); nothing launched\n", n_in, n_in > 0 ? in_sizes[0] : -1, out_size, ws_size); grid = -1; return; }
        int dev = 0, cus = 0, per_cu = 0;
        if (hipGetDevice(&dev) != hipSuccess || hipDeviceGetAttribute(&cus, hipDeviceAttributeMultiprocessorCount, dev) != hipSuccess) { grid = -1; return; }
        if (hipFuncSetAttribute((const void*)mk_fwd, hipFuncAttributeMaxDynamicSharedMemorySize, LDS_BYTES) != hipSuccess) { fprintf(stderr, "kernel_launch: hipFuncSetAttribute failed\n"); grid = -1; return; }
        if (hipOccupancyMaxActiveBlocksPerMultiprocessor(&per_cu, (const void*)mk_fwd, NWAVES * 64, LDS_BYTES) != hipSuccess || per_cu < 1) fprintf(stderr, "kernel_launch: occupancy query says %d\n", per_cu);
        (void)hipGetLastError();
        grid = cus;
    }
    if (grid < 0) return;
    if (hipMemsetAsync((char*)d_ws + WS_CTL, 0, CTL_ZERO_BYTES, stream) != hipSuccess) return;
    Args a{};
    for (int i = 0; i < 26; ++i) a.in[i] = (const float*)d_in[i];
    a.out = (float*)d_out; a.ws = (unsigned char*)d_ws;
    if (MK_N_LAUNCHES == 1) { a.ph_lo = 0; a.ph_hi = N_PHASES; hipLaunchKernelGGL(mk_fwd, dim3(grid), dim3(NWAVES * 64), LDS_BYTES, stream, a); }
    else for (int p = 0; p < N_PHASES; ++p) { a.ph_lo = p; a.ph_hi = p + 1; hipLaunchKernelGGL(mk_fwd, dim3(grid), dim3(NWAVES * 64), LDS_BYTES, stream, a); }
}
```

```cpp
#include <hip/hip_runtime.h>
#include <cstdio>
#include <cstdint>
#include <cmath>
namespace pg8 {
#define PG8_LAS __attribute__((address_space(3)))
typedef unsigned short bf16_t;
typedef short bf16x8 __attribute__((ext_vector_type(8)));
typedef float f32x4 __attribute__((ext_vector_type(4)));
typedef unsigned u32x4 __attribute__((ext_vector_type(4)));
constexpr int BM = 256, BK = 64, HALF = 128, HTB = HALF * BK * 2  , STAGE_BYTES = 8 * HTB, NXCD = 8, WGM = 8;

__host__ __device__ __forceinline__ int lds_byte(int r, int c) { const int st = (r >> 4) * 2 + (c >> 5), rr = r & 15, cc = c & 31, ob = rr * 64 + cc * 2; return st * 1024 + (ob ^ (((ob >> 9) & 1) << 5)); }
__host__ __device__ __forceinline__ void stage_rc(int b, int& R, int& C) { const int st = b / 1024, sb = b % 1024, swz = sb ^ (((sb >> 9) & 1) << 5); R = (st >> 1) * 16 + swz / 64; C = (st & 1) * 32 + (swz % 64) / 2; }
__host__ __device__ __forceinline__ int perm32(int rho) { const int n = rho >> 4, i = rho & 15; return 8 * (i >> 2) + 4 * n + (i & 3); }

struct Unit { int pm, pn; int ty = 0; };
struct Gemm { const bf16_t* A; const bf16_t* Bt; int M, N, K, lda, ldb; const bf16_t* A2 = nullptr; const bf16_t* Bt2 = nullptr; };

struct StaticOrder {
    int nM, nN, nwg, G, c;
    __host__ __device__ void init(int M, int N, int G_, int c_) { nM = M / BM; nN = N / BM; nwg = nM * nN; G = G_; c = c_; }
    __host__ __device__ bool next(int i, Unit& u) const {
        const long L = (long)i * G + c; if (L >= nwg) return false;
        int wgid = (int)L; { const int q = nwg / NXCD, r = nwg % NXCD, xcd = wgid % NXCD, off = wgid / NXCD; wgid = (xcd < r ? xcd * (q + 1) : r * (q + 1) + (xcd - r) * q) + off; }
        const int nig = WGM * nN, gid = wgid / nig, fm = gid * WGM, gsz = (nM - fm) < WGM ? (nM - fm) : WGM;
        u.pm = fm + ((wgid % nig) % gsz); u.pn = (wgid % nig) / gsz; return true;
    }
    __device__ __forceinline__ void a_ready(const Unit&) const {}
    __device__ __forceinline__ void done(const Unit&) const {}
};

__device__ __forceinline__ unsigned cvt_pk_bf16(float lo, float hi) { unsigned r; asm volatile("v_cvt_pk_bf16_f32 %0, %1, %2" : "=v"(r) : "v"(lo), "v"(hi)); return r; }
template <class Epi, class Sched, bool ALIGN_EPI = false, bool SP2 = false>
__device__ __forceinline__ void gemm_phase(PG8_LAS unsigned char* lds, const Gemm g, const Sched& S, const Epi& E) {
    const int tid = threadIdx.x, wid = __builtin_amdgcn_readfirstlane(tid >> 6), lane = tid & 63, wr = wid >> 2, wc = wid & 3, fr = lane & 15, fq = lane >> 4;
    const int K = g.K, nt = K / BK;
    unsigned voffA[2], voffB[2];
#pragma unroll
    for (int i = 0; i < 2; ++i) { int R, C; stage_rc(tid * 16 + i * 8192, R, C); const int Rb = Epi::PERM ? ((R & ~31) + perm32(R & 31)) : R;
        voffA[i] = (unsigned)(R * g.lda + C) * 2u; voffB[i] = (unsigned)(Rb * g.ldb + C) * 2u; }
    const size_t kstep = (size_t)(BK * 2);
    const size_t hstepA = (size_t)HALF * g.lda * 2, hstepB = (size_t)HALF * g.ldb * 2;
    const size_t tstepA = 2 * hstepA, tstepB = 2 * hstepB;
    const unsigned ldsw = (unsigned)wid * 1024u;
    const int aoff = lds_byte(wr * 64 + fr, fq * 8), boff = lds_byte(wc * 32 + fr, fq * 8);
#define PG8_SA(b, h) (((b) * 2 + (h)) * HTB)
#define PG8_SB(b, h) ((4 + (b) * 2 + (h)) * HTB)
#define PG8_STAGE(bufoff, gbase, voff) do { _Pragma("unroll") for (int _i = 0; _i < 2; ++_i) \
        __builtin_amdgcn_global_load_lds((const unsigned*)((const char*)(gbase) + (voff)[_i]), (PG8_LAS unsigned*)(lds + (bufoff) + ldsw + _i * 8192), 16, 0, 0); } while (0)
#define PG8_LDA(dst, b, h) do { _Pragma("unroll") for (int m = 0; m < 4; ++m) _Pragma("unroll") for (int k = 0; k < 2; ++k) dst[m][k] = *(const PG8_LAS bf16x8*)(lds + PG8_SA(b, h) + aoff + m * 2048 + k * 1024); } while (0)
#define PG8_LDB(dst, b, h) do { _Pragma("unroll") for (int n = 0; n < 2; ++n) _Pragma("unroll") for (int k = 0; k < 2; ++k) dst[n][k] = *(const PG8_LAS bf16x8*)(lds + PG8_SB(b, h) + boff + n * 2048 + k * 1024); } while (0)
#define PG8_MMA(ai, bj, At, Bt) do { __builtin_amdgcn_s_setprio(1); _Pragma("unroll") for (int m = 0; m < 4; ++m) _Pragma("unroll") for (int n = 0; n < 2; ++n) _Pragma("unroll") for (int k = 0; k < 2; ++k) \
        acc[ai][bj][m][n] = __builtin_amdgcn_mfma_f32_16x16x32_bf16(Bt[n][k], At[m][k], acc[ai][bj][m][n], 0, 0, 0); __builtin_amdgcn_s_setprio(0); } while (0)
#define PG8_WAIT_V(n) asm volatile("s_waitcnt vmcnt(" #n ")" ::: "memory")
#define PG8_WAIT_L(n) asm volatile("s_waitcnt lgkmcnt(" #n ")" ::: "memory")
#define PG8_BAR __builtin_amdgcn_s_barrier()
#define PG8_SCHED __builtin_amdgcn_sched_barrier(0)
    Unit cur, nxt; int ui = 0;
    if (!S.next(0, cur)) return;
    f32x4 acc[2][2][4][2];
#pragma unroll
    for (int a = 0; a < 2; ++a)
#pragma unroll
        for (int b = 0; b < 2; ++b)
#pragma unroll
            for (int m = 0; m < 4; ++m)
#pragma unroll
                for (int n = 0; n < 2; ++n) acc[a][b][m][n] = (f32x4){0.f, 0.f, 0.f, 0.f};
    bf16x8 At[4][2], B0[2][2], B1[2][2];
    const char* cA = (const char*)(cur.ty ? g.A2 : g.A) + (size_t)cur.pm * tstepA; const char* cB = (const char*)(cur.ty ? g.Bt2 : g.Bt) + (size_t)cur.pn * tstepB;
    S.a_ready(cur);
    if constexpr (SP2) {
        PG8_STAGE(PG8_SB(0, 0), cB, voffB); PG8_STAGE(PG8_SB(0, 1), cB + hstepB, voffB); PG8_STAGE(PG8_SA(0, 0), cA, voffA); PG8_STAGE(PG8_SA(0, 1), cA + hstepA, voffA);
        if (wr == 1) PG8_BAR;
        PG8_WAIT_V(2); PG8_BAR;
        PG8_STAGE(PG8_SB(1, 0), cB + kstep, voffB); PG8_STAGE(PG8_SA(1, 0), cA + kstep, voffA); PG8_STAGE(PG8_SB(1, 1), cB + hstepB + kstep, voffB);
        PG8_WAIT_V(6); PG8_BAR;
    } else {
        PG8_STAGE(PG8_SB(0, 0), cB, voffB); PG8_STAGE(PG8_SA(0, 0), cA, voffA); PG8_STAGE(PG8_SB(0, 1), cB + hstepB, voffB); PG8_STAGE(PG8_SA(0, 1), cA + hstepA, voffA);
        if (wr == 1) PG8_BAR;
        PG8_WAIT_V(4); PG8_BAR;
        PG8_STAGE(PG8_SB(1, 0), cB + kstep, voffB); PG8_STAGE(PG8_SA(1, 0), cA + kstep, voffA); PG8_STAGE(PG8_SB(1, 1), cB + hstepB + kstep, voffB);
        PG8_WAIT_V(6); PG8_BAR;
    }
    for (;;) {
        const bool has_next = S.next(ui + 1, nxt);
        const char* nA = has_next ? (const char*)(nxt.ty ? g.A2 : g.A) + (size_t)nxt.pm * tstepA : cA; const char* nB = has_next ? (const char*)(nxt.ty ? g.Bt2 : g.Bt) + (size_t)nxt.pn * tstepB : cB;
        for (int t = 0; t < nt; t += 2) {
            const bool last = (t == nt - 2);
            const char* a1 = cA + (size_t)(t + 1) * kstep;
            const char* a2 = last ? nA : cA + (size_t)(t + 2) * kstep; const char* b2 = last ? nB : cB + (size_t)(t + 2) * kstep;
            const char* a3 = a2 + kstep; const char* b3 = b2 + kstep;
            if (last && has_next) S.a_ready(nxt);
            if constexpr (SP2) {
            PG8_LDB(B0, 0, 0); PG8_LDB(B1, 0, 1); PG8_SCHED; PG8_LDA(At, 0, 0); PG8_STAGE(PG8_SA(1, 1), a1 + hstepA, voffA);
            PG8_WAIT_V(8); PG8_WAIT_L(0); PG8_BAR; PG8_MMA(0, 0, At, B0); PG8_MMA(0, 1, At, B1); PG8_BAR; PG8_SCHED;
            PG8_LDA(At, 0, 1); PG8_STAGE(PG8_SB(0, 0), b2, voffB); PG8_STAGE(PG8_SB(0, 1), b2 + hstepB, voffB); PG8_STAGE(PG8_SA(0, 0), a2, voffA);
            PG8_WAIT_V(8); PG8_WAIT_L(0); PG8_BAR; PG8_MMA(1, 0, At, B0); PG8_MMA(1, 1, At, B1); PG8_BAR; PG8_SCHED;
            PG8_LDB(B0, 1, 0); PG8_LDB(B1, 1, 1); PG8_SCHED; PG8_LDA(At, 1, 0); PG8_STAGE(PG8_SA(0, 1), a2 + hstepA, voffA);
            PG8_WAIT_V(8); PG8_WAIT_L(0); PG8_BAR; PG8_MMA(0, 0, At, B0); PG8_MMA(0, 1, At, B1); PG8_BAR; PG8_SCHED;
            PG8_LDA(At, 1, 1); PG8_STAGE(PG8_SB(1, 0), b3, voffB); PG8_STAGE(PG8_SB(1, 1), b3 + hstepB, voffB); PG8_STAGE(PG8_SA(1, 0), a3, voffA);
            PG8_WAIT_V(8); PG8_WAIT_L(0); PG8_BAR; PG8_MMA(1, 0, At, B0); PG8_MMA(1, 1, At, B1); PG8_BAR; PG8_SCHED;
            } else {
            PG8_LDB(B0, 0, 0); PG8_SCHED; PG8_LDA(At, 0, 0); PG8_STAGE(PG8_SA(1, 1), a1 + hstepA, voffA);
            PG8_WAIT_L(8); PG8_BAR; PG8_WAIT_L(0); PG8_MMA(0, 0, At, B0); PG8_BAR; PG8_SCHED;
            PG8_LDB(B1, 0, 1); PG8_STAGE(PG8_SB(0, 0), b2, voffB);
            PG8_BAR; PG8_WAIT_L(0); PG8_MMA(0, 1, At, B1); PG8_BAR;
            PG8_LDA(At, 0, 1); PG8_STAGE(PG8_SA(0, 0), a2, voffA);
            PG8_BAR; PG8_WAIT_L(0); PG8_MMA(1, 0, At, B0); PG8_BAR; PG8_SCHED;
            PG8_STAGE(PG8_SB(0, 1), b2 + hstepB, voffB);
            PG8_WAIT_V(6); PG8_BAR; PG8_MMA(1, 1, At, B1); PG8_BAR;
            PG8_LDB(B0, 1, 0); PG8_SCHED; PG8_LDA(At, 1, 0); PG8_STAGE(PG8_SA(0, 1), a2 + hstepA, voffA);
            PG8_WAIT_L(8); PG8_BAR; PG8_WAIT_L(0); PG8_MMA(0, 0, At, B0); PG8_BAR; PG8_SCHED;
            PG8_LDB(B1, 1, 1); PG8_STAGE(PG8_SB(1, 0), b3, voffB);
            PG8_BAR; PG8_WAIT_L(0); PG8_MMA(0, 1, At, B1); PG8_BAR;
            PG8_LDA(At, 1, 1); PG8_STAGE(PG8_SA(1, 0), a3, voffA);
            PG8_BAR; PG8_WAIT_L(0); PG8_MMA(1, 0, At, B0); PG8_BAR; PG8_SCHED;
            PG8_STAGE(PG8_SB(1, 1), b3 + hstepB, voffB);
            PG8_WAIT_V(6); PG8_BAR; PG8_MMA(1, 1, At, B1); PG8_BAR;
            }
        }
        if constexpr (ALIGN_EPI) { if (wr == 0) PG8_BAR; }
        if constexpr (!Epi::AFTER_DRAIN) { E(acc, cur, wr, wc, fr, fq); S.done(cur); }
        if (!has_next) break;
#pragma unroll
        for (int a = 0; a < 2; ++a)
#pragma unroll
            for (int b = 0; b < 2; ++b)
#pragma unroll
                for (int m = 0; m < 4; ++m)
#pragma unroll
                    for (int n = 0; n < 2; ++n) acc[a][b][m][n] = (f32x4){0.f, 0.f, 0.f, 0.f};
        cur = nxt; cA = nA; cB = nB; ++ui;
        if constexpr (ALIGN_EPI) { if (wr == 1) PG8_BAR; }
    }
    PG8_WAIT_V(0);
    if constexpr (!ALIGN_EPI) { if (wr == 0) PG8_BAR; }
    PG8_BAR;
    if constexpr (Epi::AFTER_DRAIN) { E.fused(acc, cur, wr, wc, fr, fq, lds, wid, lane); S.done(cur); }
#undef PG8_SA
#undef PG8_SB
#undef PG8_STAGE
#undef PG8_LDA
#undef PG8_LDB
#undef PG8_MMA
#undef PG8_WAIT_V
#undef PG8_WAIT_L
#undef PG8_BAR
#undef PG8_SCHED
}
}
#define GAS __attribute__((address_space(1)))
#define LAS __attribute__((address_space(3)))
typedef unsigned short bf16;
typedef unsigned v4u __attribute__((ext_vector_type(4)));
typedef float f32x4 __attribute__((ext_vector_type(4)));
typedef short bf16x8 __attribute__((ext_vector_type(8)));
typedef GAS unsigned gu32;
typedef GAS unsigned long long gu64;
#define RLX_AGENT __ATOMIC_RELAXED, __HIP_MEMORY_SCOPE_AGENT
#define LDS_WAIT() asm volatile("s_waitcnt lgkmcnt(0)" ::: "memory")
#define VM_WAIT() asm volatile("s_waitcnt vmcnt(0)" ::: "memory")
__device__ __forceinline__ unsigned long long rt() { return __builtin_amdgcn_s_memrealtime(); }
__device__ __forceinline__ unsigned f2bf(float f) { unsigned u = __builtin_bit_cast(unsigned, f); return (u + 0x7fffu + ((u >> 16) & 1u)) >> 16; }
__device__ __forceinline__ unsigned pk2(float lo, float hi) { return f2bf(lo) | (f2bf(hi) << 16); }

#define XB_TMO      128
#define XB_XCNT(j)  (256  + 64 * (j))
#define XB_XSUB(j)  (1280 + 64 * (j))
#define XB_XGEN(j)  (2304 + 64 * (j))
#define XB_TOP      3328
#define XB_TOPGEN   3392
#define XCD_BAR_WORDS 3456
#define XB_SPIN_CAP (1u << 18)

__device__ __forceinline__ unsigned xb_ld(unsigned* p)              { return __hip_atomic_load(p, __ATOMIC_RELAXED, __HIP_MEMORY_SCOPE_AGENT); }
__device__ __forceinline__ unsigned xb_add(unsigned* p, unsigned v) { return __hip_atomic_fetch_add(p, v, __ATOMIC_RELAXED, __HIP_MEMORY_SCOPE_AGENT); }
__device__ __forceinline__ unsigned xb_xcc_id() { return (unsigned)__builtin_amdgcn_s_getreg((3 << 11) | 20) & 0xFu; }
#define XB_SPIN(cond, bar) do { unsigned _sp = 0; while (cond) { __builtin_amdgcn_s_sleep(1); \
    if ((++_sp & 255u) == 0u) { if (xb_ld(&(bar)[XB_TMO])) break; if (_sp > XB_SPIN_CAP) { atomicAdd(&(bar)[XB_TMO], 1u); break; } } } } while (0)

struct XcdBarrier {
    unsigned* bar; unsigned x;
    volatile LAS unsigned* st;
};

__device__ __forceinline__ XcdBarrier xcd_barrier_post(unsigned* bar, volatile LAS unsigned* st) {
    XcdBarrier b; b.bar = bar; b.x = xb_xcc_id(); b.st = st;
    if (threadIdx.x == 0) (void)xb_add(&bar[XB_XCNT(b.x)], 1u);
    return b;
}
__device__ __forceinline__ void xcd_barrier_complete(unsigned* bar, unsigned x, unsigned& nloc, unsigned& nx) {
    const unsigned G = gridDim.x * gridDim.y * gridDim.z;
    unsigned sum, cnt, mine, sp = 0u;
    for (;;) {
        sum = 0u; cnt = 0u; mine = 0u;
#pragma unroll
        for (unsigned j = 0; j < 16; ++j) { const unsigned c = xb_ld(&bar[XB_XCNT(j)]); sum += c; cnt += (c > 0u) ? 1u : 0u; mine = (j == x) ? c : mine; }
        if (sum == G) break;
        __builtin_amdgcn_s_sleep(1);
        if ((++sp & 255u) == 0u) { if (xb_ld(&bar[XB_TMO])) break; if (sp > XB_SPIN_CAP) { atomicAdd(&bar[XB_TMO], 1u); break; } }
    }
    nloc = mine > 0u ? mine : 1u; nx = cnt > 0u ? cnt : 1u;
}

__device__ __forceinline__ void xcd_barrier(const XcdBarrier& b) {
    asm volatile("s_waitcnt vmcnt(0)" ::: "memory");
    __syncthreads();
    if (threadIdx.x == 0) {
        unsigned* bar = b.bar;
        __builtin_amdgcn_s_waitcnt(0);
        unsigned nloc = b.st[0], nx = b.st[1];
        if (nloc == 0u) { xcd_barrier_complete(bar, b.x, nloc, nx); b.st[0] = nloc; b.st[1] = nx; }
        const unsigned old = xb_add(&bar[XB_XSUB(b.x)], 1u);
        const unsigned gen = old / nloc;
        if (old + 1u == (gen + 1u) * nloc) {
            __builtin_amdgcn_fence(__ATOMIC_RELEASE, "agent");
            asm volatile("s_waitcnt vmcnt(0)" ::: "memory");
            const unsigned og = xb_add(&bar[XB_TOP], 1u);
            const unsigned tg = og / nx;
            if (og + 1u == (tg + 1u) * nx) xb_add(&bar[XB_TOPGEN], 1u);
            else XB_SPIN(xb_ld(&bar[XB_TOPGEN]) == tg, bar);
            __builtin_amdgcn_fence(__ATOMIC_ACQUIRE, "agent");
            xb_add(&bar[XB_XGEN(b.x)], 1u);
            asm volatile("s_waitcnt vmcnt(0)" ::: "memory");
        } else {
            XB_SPIN(xb_ld(&bar[XB_XGEN(b.x)]) == gen, bar);
            __builtin_amdgcn_fence(__ATOMIC_ACQUIRE, "agent");
            asm volatile("s_waitcnt vmcnt(0)" ::: "memory");
        }
    }
    __syncthreads();
}

constexpr int NWAVES = 8;
#ifndef MK_N_LAUNCHES
#define MK_N_LAUNCHES 1
#endif
constexpr int N_PHASES = 14;
constexpr int D = 1024, M = 32768, MP = 16384, SS = 4096;
constexpr int NG = 32, TCH = 32, NCG = 1024  , FF = 2816, NPROJ = 2048, NMOD = 6144, UP = 768  ;
constexpr float EPS = 1e-6f;
constexpr float LOG2E = 1.4426950408889634f, LN2F = 0.6931471805599453f;
constexpr float QSCALE = 0.125f * LOG2E;
constexpr double INV_2PI = 0.15915494309189533577;

constexpr size_t MiB = 1u << 20;
constexpr size_t WS_CTL = 0, CTL_ZERO_BYTES = 262144;
constexpr size_t WS_MODF = 262144;
constexpr size_t WS_XBUF = 524288;
constexpr size_t WS_LDRE = 393216, WS_ZRE = 409600, WS_ZIM = 425984, WS_ATRE = 442368, WS_ATIM = 458752, WS_THETA = 475136;
constexpr size_t WS_W13 = 1 * MiB;
constexpr size_t WS_PTAB = 12 * MiB, WS_SBUF = 20 * MiB, WS_WIN = 52 * MiB, WS_ROPE = 56 * MiB, WS_MODP = 60 * MiB, WS_WGLU = 254 * MiB, WS_WO = 252 * MiB, WS_KLAG = 63 * MiB;
constexpr size_t WS_SSMRAW = 12 * MiB, WS_H2 = 12 * MiB, WS_W2 = 12 * MiB;
constexpr size_t WS_U = 76 * MiB, WS_Q = 124 * MiB, WS_K = 156 * MiB, WS_V = 188 * MiB, WS_TOEP = 124 * MiB, WS_G = 196 * MiB, WS_MIXA = 12 * MiB  , WS_ACT = 76 * MiB, WS_END = 255 * MiB;
constexpr size_t DO_H1 = 0, DO_OB = 0, DO_LSE = 96 * MiB;
constexpr int CW_ATTQ = 2048;
constexpr int CW_BAR = 4096, CW_SEAM = 16384, SEAM_BANK = 8192;
constexpr int PARAM_OFF = 131520;
constexpr int CW_READY = CW_SEAM + 3 * SEAM_BANK;
constexpr int XLDS_OFF = 131584;

constexpr int RING_OFF = 0, RING_BYTES = 131072;
constexpr int LDSCTL_OFF = RING_BYTES, MISC_OFF = LDSCTL_OFF + 320;
constexpr int LDS_BYTES = 147456;

typedef short v4i16_t __attribute__((ext_vector_type(4)));
typedef unsigned v2u __attribute__((ext_vector_type(2)));
typedef float f32x2v __attribute__((ext_vector_type(2)));

struct Args { const float* in[26]; float* out; unsigned char* ws; int ph_lo, ph_hi; };

__device__ __forceinline__ float wave_sum(float v) {
#pragma unroll
    for (int o = 1; o < 64; o <<= 1) v += __shfl_xor(v, o);
    return v;
}
__device__ __forceinline__ float fexp2(float x) { return __builtin_amdgcn_exp2f(x); }
__device__ __forceinline__ float frcp(float x) { return __builtin_amdgcn_rcpf(x); }
__device__ __forceinline__ float sigm(float x) { return frcp(1.f + fexp2(-x * LOG2E)); }
__device__ __forceinline__ float gelu_tanh(float x) { const float u = 1.5957691216057308f * (x + 0.044715f * x * x * x); return x * sigm(u); }
__device__ __forceinline__ void sincos_rev(double revs, float& s, float& c) { const double fr = revs - __builtin_rint(revs); const float f = (float)fr; s = __builtin_amdgcn_sinf(f); c = __builtin_amdgcn_cosf(f); }
__device__ __forceinline__ float bf2f(unsigned short h) { return __builtin_bit_cast(float, (unsigned)h << 16); }
__device__ __forceinline__ float bflo(unsigned w) { return __builtin_bit_cast(float, w << 16); }
__device__ __forceinline__ float bfhi(unsigned w) { return __builtin_bit_cast(float, w & 0xffff0000u); }
__device__ __forceinline__ int batch_of(int row) { return row < MP ? 0 : 1 + ((row - MP) >> 12); }
__device__ __forceinline__ const float* xrow_ptr(const Args& a, int row) { return row < MP ? a.in[0] + (size_t)row * D : a.in[1] + (size_t)(row - MP) * D; }

struct SchedState {
    int c;
    __device__ bool next(int i, pg8::Unit& u) const { if (i > 0 || c >= 128) return false; u.pm = c; u.pn = c >> 2; return true; }
    __device__ __forceinline__ void a_ready(const pg8::Unit&) const {}
    __device__ __forceinline__ void done(const pg8::Unit&) const {}
};
struct SchedSsmOut {
    int c;
    __device__ bool next(int i, pg8::Unit& u) const { if (i > 0 || c >= 256) return false; const int g = c >> 3; u.pm = 4 * g + ((c >> 1) & 3); u.pn = 2 * g + (c & 1); return true; }
    __device__ __forceinline__ void a_ready(const pg8::Unit&) const {}
    __device__ __forceinline__ void done(const pg8::Unit&) const {}
};

#ifndef DUP_MASK
#define DUP_MASK 0
#endif
template <int DUP> struct DupOrder {
    pg8::StaticOrder S;
    __device__ bool next(int i, pg8::Unit& u) const { if (DUP == 2) { pg8::Unit t; int n = 0; while (S.next(n, t)) ++n; return i < 2 * n ? S.next(i % n, u) : false; } return S.next(DUP ? (i >> 1) : i, u); }
    __device__ __forceinline__ void a_ready(const pg8::Unit&) const {}
    __device__ __forceinline__ void done(const pg8::Unit&) const {}
};
struct SchedWoUp {
    int c; const unsigned* ready; int base, count;
    mutable int seen = -1;
    __device__ bool next(int i0, pg8::Unit& u) const {
        if (i0 >= count) return false;
        const int i = base + i0;
        const int x = c & 7, j = c >> 3, t = 1 + (x % 5), P0 = 16 * x;
        if (i == 0) { u.ty = 0; u.pm = P0 + (j & 7); u.pn = j >> 3; return true; }
        if (i == t) { u.ty = 0; u.pm = P0 + 8 + (j & 7); u.pn = j >> 3; return true; }
        u.ty = 1;
        if (i == 12) { if (j < 16) { u.pm = P0 + (j & 7); u.pn = 20 + (j >> 3); } else { u.pm = P0 + 8 + (j & 7); u.pn = 20 + ((j - 16) >> 3); } return true; }
        const int k = i - 1 - (i > t ? 1 : 0), half = k / 5, b = k % 5;
        u.pm = P0 + 8 * half + (j & 7); u.pn = 4 * b + (j >> 3); return true;
    }
    __device__ __forceinline__ void a_ready(const pg8::Unit& u) const {
        if (u.ty != 1 || u.pm == seen) return;
        seen = u.pm;
        if (threadIdx.x < 64) {
            unsigned sp = 0;
            while ((unsigned)__builtin_amdgcn_readfirstlane(__hip_atomic_load(ready + 64 * u.pm, __ATOMIC_RELAXED, __HIP_MEMORY_SCOPE_AGENT)) < 32u) { __builtin_amdgcn_s_sleep(2); if (++sp > (1u << 22)) break; }
            __builtin_amdgcn_fence(__ATOMIC_ACQUIRE, "agent");
            asm volatile("s_waitcnt vmcnt(0)" ::: "memory");
        }
        asm volatile("" ::: "memory"); __builtin_amdgcn_s_barrier(); asm volatile("" ::: "memory");
    }
    __device__ __forceinline__ void done(const pg8::Unit&) const {}
};
using pg8::f32x4; using pg8::u32x4; using pg8::cvt_pk_bf16;
#define EPI_ROWS(u, ai, m) ((u).pm * 256 + (ai) * 128 + wr * 64 + (m) * 16 + fr)
__device__ __forceinline__ u32x4 pack8(const f32x4& a, const f32x4& b) { u32x4 w; w.x = cvt_pk_bf16(a[0], a[1]); w.y = cvt_pk_bf16(a[2], a[3]); w.z = cvt_pk_bf16(b[0], b[1]); w.w = cvt_pk_bf16(b[2], b[3]); return w; }

struct EpiQKV {
    static constexpr bool PERM = true, AFTER_DRAIN = false;
    bf16 *Q, *K, *V, *U; const float *cosT, *sinT;
    __device__ __forceinline__ void operator()(const f32x4 (&acc)[2][2][4][2], const pg8::Unit& u, int wr, int wc, int fr, int fq) const {
        const int kind = u.pn >> 1, ph = u.pn & 1;
        if (kind < 2) {
            bf16* dst0 = kind == 0 ? Q : K; const float sc = kind == 0 ? QSCALE : 1.f;
            const int i0 = 16 * (wc & 1) + 4 * fq;
#pragma unroll
            for (int ai = 0; ai < 2; ++ai)
#pragma unroll
                for (int m = 0; m < 4; ++m) {
                    const int row = EPI_ROWS(u, ai, m); const int pos = row < MP ? row : ((row - MP) & (SS - 1));
                    const f32x4 cs = *(const f32x4*)(cosT + pos * 32 + i0), sn = *(const f32x4*)(sinT + pos * 32 + i0);
#pragma unroll
                    for (int bj = 0; bj < 2; ++bj) {
                        const int head = ph * 4 + bj * 2 + (wc >> 1);
                        const f32x4 x1 = acc[ai][bj][m][0], x2 = acc[ai][bj][m][1];
                        const f32x4 o1 = (x1 * cs - x2 * sn) * sc, o2 = (x2 * cs + x1 * sn) * sc;
                        bf16* d = dst0 + (size_t)row * 512 + head * 64 + i0;
                        v2u w1; w1.x = cvt_pk_bf16(o1[0], o1[1]); w1.y = cvt_pk_bf16(o1[2], o1[3]);
                        v2u w2; w2.x = cvt_pk_bf16(o2[0], o2[1]); w2.y = cvt_pk_bf16(o2[2], o2[3]);
                        *(v2u*)d = w1; *(v2u*)(d + 32) = w2;
                    }
                }
        } else {
#pragma unroll
            for (int ai = 0; ai < 2; ++ai)
#pragma unroll
                for (int m = 0; m < 4; ++m) {
                    const int row = EPI_ROWS(u, ai, m);
#pragma unroll
                    for (int bj = 0; bj < 2; ++bj) {
                        const int col = ph * 256 + bj * 128 + wc * 32 + 8 * fq;
                        const u32x4 w = pack8(acc[ai][bj][m][0], acc[ai][bj][m][1]);
                        if (kind == 2) *(u32x4*)(V + (size_t)row * 512 + col) = w;
                        else { const int g = col >> 4, c = col & 15; *(u32x4*)(U + ((size_t)(g * NCG + (row >> 5)) * UP + (row & 31) * 16 + c)) = w; }
                    }
                }
        }
    }
};
struct EpiState {
    static constexpr bool PERM = true, AFTER_DRAIN = false;
    float* S;
    __device__ __forceinline__ void operator()(const f32x4 (&acc)[2][2][4][2], const pg8::Unit& u, int wr, int wc, int fr, int fq) const {
        const int g = u.pn, mt = u.pm & 3;
#pragma unroll
        for (int ai = 0; ai < 2; ++ai)
#pragma unroll
            for (int m = 0; m < 4; ++m) {
                const int chunk = mt * 256 + ai * 128 + wr * 64 + m * 16 + fr;
#pragma unroll
                for (int bj = 0; bj < 2; ++bj) { float* p = S + ((size_t)(g * NCG + chunk) * 256 + bj * 128 + wc * 32 + 8 * fq); *(f32x4*)p = acc[ai][bj][m][0]; *(f32x4*)(p + 4) = acc[ai][bj][m][1]; }
            }
    }
};
struct EpiSsmOut {
    static constexpr bool PERM = true, AFTER_DRAIN = false;
    bf16* G;
    __device__ __forceinline__ void operator()(const f32x4 (&acc)[2][2][4][2], const pg8::Unit& u, int wr, int wc, int fr, int fq) const {
        const int g = u.pn >> 1, nt = u.pn & 1, mt = u.pm & 3;
#pragma unroll
        for (int ai = 0; ai < 2; ++ai)
#pragma unroll
            for (int m = 0; m < 4; ++m) {
                const int chunk = mt * 256 + ai * 128 + wr * 64 + m * 16 + fr;
#pragma unroll
                for (int bj = 0; bj < 2; ++bj) {
                    const int ncol = nt * 256 + bj * 128 + wc * 32 + 8 * fq, t = ncol >> 4, c0 = ncol & 15;
                    f32x4 a = acc[ai][bj][m][0], b = acc[ai][bj][m][1];
#pragma unroll
                    for (int e = 0; e < 4; ++e) { a[e] = gelu_tanh(a[e]); b[e] = gelu_tanh(b[e]); }
                    *(u32x4*)(G + (size_t)(chunk * TCH + t) * 512 + g * 16 + c0) = pack8(a, b);
                }
            }
    }
};
struct EpiGlu {
    static constexpr bool PERM = true, AFTER_DRAIN = false;
    const bf16* G; const float* bglu; bf16* O;
    __device__ __forceinline__ void operator()(const f32x4 (&acc)[2][2][4][2], const pg8::Unit& u, int wr, int wc, int fr, int fq) const {
#pragma unroll
        for (int bj = 0; bj < 2; ++bj) {
            const int col = u.pn * 256 + bj * 128 + wc * 32 + 8 * fq;
            const f32x4 b0 = *(const f32x4*)(bglu + col), b1 = *(const f32x4*)(bglu + col + 4);
#pragma unroll
            for (int ai = 0; ai < 2; ++ai)
#pragma unroll
                for (int m = 0; m < 4; ++m) {
                    const int row = EPI_ROWS(u, ai, m);
                    const u32x4 gv = *(const u32x4*)(G + (size_t)row * 512 + col);
                    const f32x4 z0 = acc[ai][bj][m][0] + b0, z1 = acc[ai][bj][m][1] + b1;
                    f32x4 o0, o1;
                    o0[0] = bflo(gv.x) * sigm(z0[0]); o0[1] = bfhi(gv.x) * sigm(z0[1]); o0[2] = bflo(gv.y) * sigm(z0[2]); o0[3] = bfhi(gv.y) * sigm(z0[3]);
                    o1[0] = bflo(gv.z) * sigm(z1[0]); o1[1] = bfhi(gv.z) * sigm(z1[1]); o1[2] = bflo(gv.w) * sigm(z1[2]); o1[3] = bfhi(gv.w) * sigm(z1[3]);
                    *(u32x4*)(O + (size_t)row * 512 + col) = pack8(o0, o1);
                }
        }
    }
};
struct EpiResid {
    static constexpr bool PERM = true, AFTER_DRAIN = false;
    const float* xp; const float* xs; float* out; const float* gate;
    int inplace;
    __device__ __forceinline__ void operator()(const f32x4 (&acc)[2][2][4][2], const pg8::Unit& u, int wr, int wc, int fr, int fq) const {
#pragma unroll
        for (int ai = 0; ai < 2; ++ai)
#pragma unroll
            for (int m = 0; m < 4; ++m) {
                const int row = EPI_ROWS(u, ai, m); const int b = batch_of(row);
                const float* base = inplace ? out + (size_t)row * D : (row < MP ? xp + (size_t)row * D : xs + (size_t)(row - MP) * D);
#pragma unroll
                for (int bj = 0; bj < 2; ++bj) {
                    const int col = u.pn * 256 + bj * 128 + wc * 32 + 8 * fq;
                    const f32x4 g0 = *(const f32x4*)(gate + b * NMOD + col), g1 = *(const f32x4*)(gate + b * NMOD + col + 4);
                    const f32x4 x0 = *(const f32x4*)(base + col), x1 = *(const f32x4*)(base + col + 4);
                    *(f32x4*)(out + (size_t)row * D + col) = x0 + g0 * acc[ai][bj][m][0];
                    *(f32x4*)(out + (size_t)row * D + col + 4) = x1 + g1 * acc[ai][bj][m][1];
                }
            }
    }
};
struct PB { const float* xp; const float* xs; float* out; unsigned char* ws; const float* p17; const float* p19; const float* p21; const float* p25; };
__device__ __forceinline__ PB load_pb(LAS unsigned char* lds) { asm volatile("" ::: "memory"); const LAS unsigned long long* p = (const LAS unsigned long long*)(lds + PARAM_OFF); PB r;
    r.xp = (const float*)p[0]; r.xs = (const float*)p[1]; r.out = (float*)p[2]; r.ws = (unsigned char*)p[3]; r.p17 = (const float*)p[4]; r.p19 = (const float*)p[5]; r.p21 = (const float*)p[6]; r.p25 = (const float*)p[7]; return r; }
template <int NTN, int BANK>
__device__ __forceinline__ void row_ssq_exchange(const f32x4 (&v)[2][2][4][2], const pg8::Unit& u, int wr, int wc, int fr, int fq, LAS unsigned char* ldsx, unsigned char* ws) {
    unsigned* xbuf = (unsigned*)(ws + WS_XBUF); unsigned* cnt = (unsigned*)(ws + WS_CTL) + CW_SEAM + BANK * SEAM_BANK + 64 * u.pm;
    int lane = threadIdx.x & 63; asm volatile("" : "+v"(lane)); const int wid = __builtin_amdgcn_readfirstlane(threadIdx.x >> 6);
    LAS float* P = (LAS float*)ldsx; LAS float* S = (LAS float*)(ldsx + 4096);
#pragma unroll
    for (int ai = 0; ai < 2; ++ai)
#pragma unroll
        for (int m = 0; m < 4; ++m) {
            float q = 0.f;
#pragma unroll
            for (int bj = 0; bj < 2; ++bj)
#pragma unroll
                for (int n = 0; n < 2; ++n) { const f32x4 x = v[ai][bj][m][n]; q += (x[0] * x[0] + x[1] * x[1]) + (x[2] * x[2] + x[3] * x[3]); }
            q += __shfl_xor(q, 16); q += __shfl_xor(q, 32);
            if (fq == 0) P[(ai * 128 + wr * 64 + m * 16 + fr) * 4 + wc] = q;
        }
    asm volatile("s_waitcnt lgkmcnt(0)" ::: "memory"); __builtin_amdgcn_s_barrier(); asm volatile("" ::: "memory");
    const int row = wid * 32 + (lane & 31);
    if (lane < 32) { const float t = (P[row * 4 + 0] + P[row * 4 + 1]) + (P[row * 4 + 2] + P[row * 4 + 3]);
        __hip_atomic_store(xbuf + ((size_t)(u.pm * 256 + row) * 4 + (u.pn & 3)), __float_as_uint(t), __ATOMIC_RELAXED, __HIP_MEMORY_SCOPE_AGENT); }
    asm volatile("s_waitcnt vmcnt(0)" ::: "memory");
    if (lane == 0) __hip_atomic_fetch_add(cnt, 1u, __ATOMIC_RELAXED, __HIP_MEMORY_SCOPE_AGENT);
    if (wid == 0) {
        unsigned sp = 0;
        while ((unsigned)__builtin_amdgcn_readfirstlane(__hip_atomic_load(cnt, __ATOMIC_RELAXED, __HIP_MEMORY_SCOPE_AGENT)) < 8u * NTN) { __builtin_amdgcn_s_sleep(2); if (++sp > (1u << 22)) break; }
        __builtin_amdgcn_fence(__ATOMIC_ACQUIRE, "agent");
    }
    asm volatile("s_waitcnt vmcnt(0) lgkmcnt(0)" ::: "memory"); __builtin_amdgcn_s_barrier(); asm volatile("" ::: "memory");
    if (lane < 32) { float t = 0.f;
#pragma unroll
        for (int k = 0; k < NTN; ++k) t += __uint_as_float(__hip_atomic_load(xbuf + ((size_t)(u.pm * 256 + row) * 4 + k), __ATOMIC_RELAXED, __HIP_MEMORY_SCOPE_AGENT));
        S[row] = __builtin_amdgcn_rsqf(t * (1.f / (256.f * NTN)) + EPS); }
    asm volatile("s_waitcnt lgkmcnt(0)" ::: "memory"); __builtin_amdgcn_s_barrier(); asm volatile("" ::: "memory");
}
struct EpiGluNorm {
    static constexpr bool PERM = true, AFTER_DRAIN = false;
    LAS unsigned char* lds;
    __device__ __forceinline__ void operator()(f32x4 (&acc)[2][2][4][2], const pg8::Unit& u, int wr, int wc, int fr, int fq) const {
        asm volatile("" : "+v"(fr), "+v"(fq));
        const PB pb = load_pb(lds); const bf16* G = (const bf16*)(pb.ws + WS_G); bf16* O = (bf16*)(pb.ws + WS_MIXA);
#pragma unroll
        for (int bj = 0; bj < 2; ++bj) {
            const int col = u.pn * 256 + bj * 128 + wc * 32 + 8 * fq;
            const f32x4 b0 = *(const f32x4*)(pb.p17 + col), b1 = *(const f32x4*)(pb.p17 + col + 4);
#pragma unroll
            for (int ai = 0; ai < 2; ++ai)
#pragma unroll
                for (int m = 0; m < 4; ++m) {
                    const int row = EPI_ROWS(u, ai, m);
                    const u32x4 gv = *(const u32x4*)(G + (size_t)row * 512 + col);
                    const f32x4 z0 = acc[ai][bj][m][0] + b0, z1 = acc[ai][bj][m][1] + b1;
                    f32x4 o0, o1;
                    o0[0] = bflo(gv.x) * sigm(z0[0]); o0[1] = bfhi(gv.x) * sigm(z0[1]); o0[2] = bflo(gv.y) * sigm(z0[2]); o0[3] = bfhi(gv.y) * sigm(z0[3]);
                    o1[0] = bflo(gv.z) * sigm(z1[0]); o1[1] = bfhi(gv.z) * sigm(z1[1]); o1[2] = bflo(gv.w) * sigm(z1[2]); o1[3] = bfhi(gv.w) * sigm(z1[3]);
                    acc[ai][bj][m][0] = o0; acc[ai][bj][m][1] = o1;
                    asm volatile("" : "+v"(acc[ai][bj][m][0]), "+v"(acc[ai][bj][m][1]));
                    if (m & 1) asm volatile("" ::: "memory");
                }
        }
        row_ssq_exchange<2, 0>(acc, u, wr, wc, fr, fq, lds + XLDS_OFF, pb.ws);
        const LAS float* S = (const LAS float*)(lds + XLDS_OFF + 4096);
#pragma unroll
        for (int bj = 0; bj < 2; ++bj) {
            const int col = u.pn * 256 + bj * 128 + wc * 32 + 8 * fq;
            const f32x4 g0 = *(const f32x4*)(pb.p19 + col), g1 = *(const f32x4*)(pb.p19 + col + 4);
#pragma unroll
            for (int ai = 0; ai < 2; ++ai)
#pragma unroll
                for (int m = 0; m < 4; ++m) {
                    const int rl = ai * 128 + wr * 64 + m * 16 + fr; const float rs = S[rl];
                    *(u32x4*)(O + (size_t)(u.pm * 256 + rl) * D + 512 + col) = pack8(acc[ai][bj][m][0] * rs * g0, acc[ai][bj][m][1] * rs * g1);
                }
        }
    }
};
struct EpiWoH2 {
    static constexpr bool PERM = true, AFTER_DRAIN = false;
    LAS unsigned char* lds;
    __device__ __forceinline__ void operator()(f32x4 (&acc)[2][2][4][2], const pg8::Unit& u, int wr, int wc, int fr, int fq) const {
        asm volatile("" : "+v"(fr), "+v"(fq));
        const PB pb = load_pb(lds);
        unsigned char* wsu = (unsigned char*)(((unsigned long long)(unsigned)__builtin_amdgcn_readfirstlane((int)((unsigned long long)pb.ws >> 32)) << 32) | (unsigned)__builtin_amdgcn_readfirstlane((int)(unsigned long long)pb.ws));
        const __amdgpu_buffer_rsrc_t h2r = __builtin_amdgcn_make_buffer_rsrc((void*)(wsu + WS_H2), (short)0, (int)((size_t)M * D * 2), 0x00020000);
        const int b = batch_of(u.pm * 256); const float* mb = (const float*)(pb.ws + WS_MODF) + b * NMOD;
#pragma unroll
        for (int bj = 0; bj < 2; ++bj) {
            const int col = u.pn * 256 + bj * 128 + wc * 32 + 8 * fq;
            const f32x4 g0 = *(const f32x4*)(mb + 2048 + col), g1 = *(const f32x4*)(mb + 2048 + col + 4);
#pragma unroll
            for (int ai = 0; ai < 2; ++ai)
#pragma unroll
                for (int m = 0; m < 4; ++m) {
                    const int row = EPI_ROWS(u, ai, m);
                    const float* base = (row < MP ? pb.xp + (size_t)row * D : pb.xs + (size_t)(row - MP) * D) + col;
                    const f32x4 x0 = *(const f32x4*)base, x1 = *(const f32x4*)(base + 4);
                    const f32x4 r0 = x0 + g0 * acc[ai][bj][m][0], r1 = x1 + g1 * acc[ai][bj][m][1];
                    acc[ai][bj][m][0] = r0; acc[ai][bj][m][1] = r1;
                    *(u32x4*)((unsigned char*)pb.out + (size_t)row * (D * 4) + 2048 + col * 2) = pack8(r0, r1);
                    if (ai == 1 && m == 3) asm volatile("" ::: "memory");
                }
        }
        row_ssq_exchange<4, 1>(acc, u, wr, wc, fr, fq, lds + XLDS_OFF, pb.ws);
        const LAS float* S = (const LAS float*)(lds + XLDS_OFF + 4096);
#pragma unroll
        for (int bj = 0; bj < 2; ++bj) {
            const int col = u.pn * 256 + bj * 128 + wc * 32 + 8 * fq;
            const f32x4 gm0 = *(const f32x4*)(pb.p21 + col) * (*(const f32x4*)(mb + 4096 + col) + 1.f), gm1 = *(const f32x4*)(pb.p21 + col + 4) * (*(const f32x4*)(mb + 4096 + col + 4) + 1.f);
            const f32x4 sh0 = *(const f32x4*)(mb + 3072 + col), sh1 = *(const f32x4*)(mb + 3072 + col + 4);
#pragma unroll
            for (int ai = 0; ai < 2; ++ai)
#pragma unroll
                for (int m = 0; m < 4; ++m) {
                    const int rl = ai * 128 + wr * 64 + m * 16 + fr; const float rs = S[rl];
                    __builtin_amdgcn_raw_buffer_store_b128(pack8(acc[ai][bj][m][0] * rs * gm0 + sh0, acc[ai][bj][m][1] * rs * gm1 + sh1), h2r, (int)(((size_t)(u.pm * 256 + rl) * D + col) * 2), 0, 16);
                }
        }
        asm volatile("s_waitcnt vmcnt(0)" ::: "memory");
        if ((threadIdx.x & 63) == 0) __hip_atomic_fetch_add((unsigned*)(pb.ws + WS_CTL) + CW_READY + 64 * u.pm, 1u, __ATOMIC_RELAXED, __HIP_MEMORY_SCOPE_AGENT);
    }
};
struct EpiDownFinal {
    static constexpr bool PERM = true, AFTER_DRAIN = false;
    LAS unsigned char* lds;
    __device__ __forceinline__ void operator()(f32x4 (&acc)[2][2][4][2], const pg8::Unit& u, int wr, int wc, int fr, int fq) const {
        asm volatile("" : "+v"(fr), "+v"(fq));
        const PB pb = load_pb(lds);
        const int b = batch_of(u.pm * 256); const float* mb = (const float*)(pb.ws + WS_MODF) + b * NMOD;
#if (DUP_MASK >> 12) & 3
        LAS int* vc = (LAS int*)(lds + XLDS_OFF + 5120); const int visit = *vc; const bool keep = ((DUP_MASK >> 13) & 1) ? (visit < 2) : ((visit & 1) == 0);
#else
        const bool keep = false;
#endif
#pragma unroll
        for (int bj = 0; bj < 2; ++bj) {
            const int col = u.pn * 256 + bj * 128 + wc * 32 + 8 * fq;
            const f32x4 g0 = *(const f32x4*)(mb + 5120 + col), g1 = *(const f32x4*)(mb + 5120 + col + 4);
#pragma unroll
            for (int ai = 0; ai < 2; ++ai)
#pragma unroll
                for (int m = 0; m < 4; ++m) {
                    const u32x4 xw = *(const u32x4*)((const unsigned char*)pb.out + (size_t)EPI_ROWS(u, ai, m) * (D * 4) + 2048 + col * 2);
                    const f32x4 x0 = {bflo(xw.x), bfhi(xw.x), bflo(xw.y), bfhi(xw.y)}, x1 = {bflo(xw.z), bfhi(xw.z), bflo(xw.w), bfhi(xw.w)};
                    acc[ai][bj][m][0] = x0 + g0 * acc[ai][bj][m][0]; acc[ai][bj][m][1] = x1 + g1 * acc[ai][bj][m][1];
                    asm volatile("" : "+v"(acc[ai][bj][m][0]), "+v"(acc[ai][bj][m][1]));
                    if (ai == 1 && m == 3) asm volatile("" ::: "memory");
                }
        }
        row_ssq_exchange<4, 2>(acc, u, wr, wc, fr, fq, lds + XLDS_OFF, pb.ws);
#if (DUP_MASK >> 12) & 3
        if (threadIdx.x == 0) *vc = visit + 1;
#endif
        const LAS float* S = (const LAS float*)(lds + XLDS_OFF + 4096);
        asm volatile("" : "+v"(fr), "+v"(fq));
        if (!keep) {
#pragma unroll
        for (int bj = 0; bj < 2; ++bj) {
            const int col = u.pn * 256 + bj * 128 + wc * 32 + 8 * fq;
            const f32x4 f0 = *(const f32x4*)(pb.p25 + col), f1 = *(const f32x4*)(pb.p25 + col + 4);
#pragma unroll
            for (int ai = 0; ai < 2; ++ai)
#pragma unroll
                for (int m = 0; m < 4; ++m) {
                    const int rl = ai * 128 + wr * 64 + m * 16 + fr; const float rs = S[rl];
                    float* o = pb.out + (size_t)(u.pm * 256 + rl) * D + col;
                    *(f32x4*)o = acc[ai][bj][m][0] * rs * f0; *(f32x4*)(o + 4) = acc[ai][bj][m][1] * rs * f1;
                }
        }
        }
    }
};

struct EpiWoUp {
    static constexpr bool PERM = true, AFTER_DRAIN = false;
    LAS unsigned char* lds;
    __device__ __forceinline__ void operator()(f32x4 (&acc)[2][2][4][2], const pg8::Unit& u, int wr, int wc, int fr, int fq) const {
        if (u.ty == 0) { EpiWoH2 E{lds}; E(acc, u, wr, wc, fr, fq); return; }
        asm volatile("" : "+v"(fr), "+v"(fq));
        const PB pb = load_pb(lds); bf16* O = (bf16*)(pb.ws + WS_ACT);
        const int j0 = u.pn * 128 + wc * 32 + 8 * fq;
#pragma unroll
        for (int ai = 0; ai < 2; ++ai)
#pragma unroll
            for (int m = 0; m < 4; ++m) {
                const int row = EPI_ROWS(u, ai, m);
                f32x4 o0, o1;
#pragma unroll
                for (int e = 0; e < 4; ++e) { const float a0 = acc[ai][0][m][0][e], a1 = acc[ai][0][m][1][e]; o0[e] = a0 * sigm(a0) * acc[ai][1][m][0][e]; o1[e] = a1 * sigm(a1) * acc[ai][1][m][1][e]; }
                *(u32x4*)(O + (size_t)row * FF + j0) = pack8(o0, o1);
            }
    }
};

template <class Map>
__device__ __forceinline__ void transpose_item(const float* W, int K, int N, bf16* WT, LAS float* scr, int item, int lane, Map map) {
    const int nblk = N / 32, kb = item / nblk, nb = item % nblk, k0 = 64 * kb, n0 = 32 * nb;
#pragma unroll 8
    for (int i = 0; i < 32; ++i) { const int kk = 2 * i + (lane >> 5); scr[kk * 33 + (lane & 31)] = W[(size_t)(k0 + kk) * N + n0 + (lane & 31)]; }
    LDS_WAIT(); asm volatile("" ::: "memory");
    const int c = lane & 7;
#pragma unroll
    for (int j = 0; j < 4; ++j) { const int n = (lane >> 3) + 8 * j; const LAS float* s = scr + (8 * c) * 33 + n;
        v4u o; o.x = pk2(s[0 * 33], s[1 * 33]); o.y = pk2(s[2 * 33], s[3 * 33]); o.z = pk2(s[4 * 33], s[5 * 33]); o.w = pk2(s[6 * 33], s[7 * 33]);
        *(GAS v4u*)(WT + (size_t)map(n0 + n) * K + k0 + 8 * c) = o; }
    LDS_WAIT(); asm volatile("" ::: "memory");
}
struct MapId { __device__ __forceinline__ int operator()(int n) const { return n; } };
struct MapWin { __device__ __forceinline__ int operator()(int n) const { if (n >= 1024) return n; const int d = n & 63; return (n & ~63) + ((d >> 2) & 7) * 8 + (d >> 5) * 4 + (d & 3); } };
struct MapW13 { int off; __device__ __forceinline__ int operator()(int j) const { return 256 * (j >> 7) + off + (j & 127); } };

template <int R>
__device__ __forceinline__ void norm_rows_lds(const float* const (&xrow)[R], bf16* const (&orow)[R], const LAS float* Gm, const LAS float* Sh, int lane) {
    f32x4 v[R][4];
#pragma unroll
    for (int r = 0; r < R; ++r)
#pragma unroll
        for (int j = 0; j < 4; ++j) v[r][j] = ((const GAS f32x4*)xrow[r] + lane)[64 * j];
#pragma unroll
    for (int r = 0; r < R; ++r) {
        float s = 0.f;
#pragma unroll
        for (int j = 0; j < 4; ++j) s += (v[r][j].x * v[r][j].x + v[r][j].y * v[r][j].y) + (v[r][j].z * v[r][j].z + v[r][j].w * v[r][j].w);
        const float rstd = __builtin_amdgcn_rsqf(wave_sum(s) * (1.f / D) + EPS);
        GAS v2u* o8 = (GAS v2u*)orow[r] + lane;
#pragma unroll
        for (int j = 0; j < 4; ++j) { const f32x4 gm = *(const LAS f32x4*)(Gm + 256 * j + 4 * lane), sh = *(const LAS f32x4*)(Sh + 256 * j + 4 * lane);
            const f32x4 h = v[r][j] * rstd * gm + sh; v2u w; w.x = pk2(h.x, h.y); w.y = pk2(h.z, h.w); o8[64 * j] = w; }
    }
}

__device__ __forceinline__ void cpow_tab(const float* ldre, const double* theta, int bi, int e, float& pre, float& pim) {
    const float mag = fexp2((float)e * ldre[bi] * LOG2E); float s, c; sincos_rev((double)e * theta[bi], s, c); pre = mag * c; pim = mag * s;
}

__device__ __forceinline__ float xmax16_32(float m) {
    auto r = __builtin_amdgcn_permlane16_swap(__float_as_uint(m), __float_as_uint(m), false, false); m = fmaxf(__uint_as_float(r[0]), __uint_as_float(r[1]));
    auto q = __builtin_amdgcn_permlane32_swap(__float_as_uint(m), __float_as_uint(m), false, false); return fmaxf(__uint_as_float(q[0]), __uint_as_float(q[1])); }
__device__ __forceinline__ float xsum16_32(float m) {
    auto r = __builtin_amdgcn_permlane16_swap(__float_as_uint(m), __float_as_uint(m), false, false); m = __uint_as_float(r[0]) + __uint_as_float(r[1]);
    auto q = __builtin_amdgcn_permlane32_swap(__float_as_uint(m), __float_as_uint(m), false, false); return __uint_as_float(q[0]) + __uint_as_float(q[1]); }
namespace att {
constexpr int NITEMS = 3 * 8 * 256, VOFF = 32768, BUFB = 65536;
struct Item { int br, h, seq_base, ldil, r, kblk, nidx, cont; };
__device__ __forceinline__ Item decode(int hs, int pos) {
    Item I; const int bh = hs >> 6, L = (hs & 63) * 4 + pos; I.br = bh >> 3; I.h = bh & 7; I.ldil = 2 * I.br;
    int S, li;
    if (L < 128) { I.seq_base = 0; S = MP; li = L; } else { const int si = (L - 128) >> 5; I.seq_base = MP + SS * si; S = SS; li = (L - 128) & 31; }
    const int lnb = (S == MP ? 7 : 5) - I.ldil;
    I.r = li >> lnb; I.kblk = li & ((1 << lnb) - 1); I.nidx = S >> I.ldil; I.cont = (pos > 0 && I.kblk > 0) ? 1 : 0; return I;
}
__device__ __forceinline__ void glds16(const void* gsrc, unsigned lds_dst) { unsigned keep;
    asm volatile("s_mov_b32 %0, m0\n\ts_mov_b32 m0, %2\n\ts_nop 0\n\tglobal_load_lds_dwordx4 %1, off nt\n\ts_mov_b32 m0, %0" : "=&s"(keep) : "v"(gsrc), "s"(lds_dst) : "memory"); }
template <bool HALF>
__device__ __forceinline__ void stage(LAS unsigned char* buf, const bf16* K, const bf16* V, const Item& I, int wave, int lane) {
    const unsigned lbase = (unsigned)__builtin_amdgcn_readfirstlane((int)(unsigned)(uintptr_t)buf);
    const int rsub = lane >> 3, c16 = lane & 7, kbase = 128 * I.kblk - 64;
    if (kbase >= 0 && kbase + 256 <= I.nidx) {
        const size_t tok0 = (size_t)I.seq_base + I.r + ((size_t)(kbase + 8 * wave + rsub) << I.ldil);
        const bf16* k0 = K + tok0 * 512 + I.h * 64 + ((c16 ^ rsub) << 3);
        const bf16* v0 = V + tok0 * 512 + I.h * 64 + ((c16 ^ (((rsub >> 1) & 3) << 1)) << 3);
        const size_t st = (size_t)65536 << I.ldil;
        const char* k1 = (const char*)k0 + st; const char* k2 = k1 + st; const char* k3 = k2 + st;
        const char* v1 = (const char*)v0 + st; const char* v2 = v1 + st; const char* v3 = v2 + st;
        unsigned keep;
        if (HALF)
            asm volatile("s_mov_b32 %0, m0\n\ts_mov_b32 m0, %5\n\ts_nop 0\n\tglobal_load_lds_dwordx4 %1, off nt\n\t"
                         "s_add_u32 m0, m0, 0x8000\n\ts_nop 0\n\tglobal_load_lds_dwordx4 %3, off nt\n\t"
                         "s_sub_u32 m0, m0, 0x6000\n\ts_nop 0\n\tglobal_load_lds_dwordx4 %2, off nt\n\t"
                         "s_add_u32 m0, m0, 0x8000\n\ts_nop 0\n\tglobal_load_lds_dwordx4 %4, off nt\n\t"
                         "s_mov_b32 m0, %0"
                         : "=&s"(keep) : "v"(k2), "v"(k3), "v"(v2), "v"(v3), "s"(lbase + wave * 1024 + 16384) : "memory", "scc");
        else
            asm volatile("s_mov_b32 %0, m0\n\ts_mov_b32 m0, %9\n\ts_nop 0\n\tglobal_load_lds_dwordx4 %1, off nt\n\t"
                         "s_add_u32 m0, m0, 0x8000\n\ts_nop 0\n\tglobal_load_lds_dwordx4 %5, off nt\n\t"
                         "s_sub_u32 m0, m0, 0x6000\n\ts_nop 0\n\tglobal_load_lds_dwordx4 %2, off nt\n\t"
                         "s_add_u32 m0, m0, 0x8000\n\ts_nop 0\n\tglobal_load_lds_dwordx4 %6, off nt\n\t"
                         "s_sub_u32 m0, m0, 0x6000\n\ts_nop 0\n\tglobal_load_lds_dwordx4 %3, off nt\n\t"
                         "s_add_u32 m0, m0, 0x8000\n\ts_nop 0\n\tglobal_load_lds_dwordx4 %7, off nt\n\t"
                         "s_sub_u32 m0, m0, 0x6000\n\ts_nop 0\n\tglobal_load_lds_dwordx4 %4, off nt\n\t"
                         "s_add_u32 m0, m0, 0x8000\n\ts_nop 0\n\tglobal_load_lds_dwordx4 %8, off nt\n\t"
                         "s_mov_b32 m0, %0"
                         : "=&s"(keep) : "v"(k0), "v"(k1), "v"(k2), "v"(k3), "v"(v0), "v"(v1), "v"(v2), "v"(v3), "s"(lbase + wave * 1024) : "memory", "scc");
        return;
    }
#pragma unroll
    for (int i = (HALF ? 2 : 0); i < 4; ++i) {
        const int p = wave + 8 * i, row = 8 * p + rsub; int kidx = kbase + row; kidx = kidx < 0 ? 0 : (kidx >= I.nidx ? I.nidx - 1 : kidx);
        const size_t tok = (size_t)I.seq_base + I.r + ((size_t)kidx << I.ldil);
        glds16(K + tok * 512 + I.h * 64 + ((c16 ^ (row & 7)) << 3), lbase + p * 1024);
        glds16(V + tok * 512 + I.h * 64 + ((c16 ^ (((row >> 1) & 3) << 1)) << 3), lbase + VOFF + p * 1024);
    }
}
__device__ __forceinline__ void slide(LAS unsigned char* dst, const LAS unsigned char* src, int wave, int lane) {
#pragma unroll
    for (int i = 0; i < 2; ++i) { const int o = (wave + 8 * i) * 1024 + lane * 16;
        const u32x4 a = *(const LAS u32x4*)(src + 16384 + o), b = *(const LAS u32x4*)(src + VOFF + 16384 + o);
        *(LAS u32x4*)(dst + o) = a; *(LAS u32x4*)(dst + VOFF + o) = b; }
}
__device__ __forceinline__ size_t q_token(const Item& I, int wave, int lane) { return (size_t)I.seq_base + I.r + ((size_t)(128 * I.kblk + 16 * wave + (lane & 15)) << I.ldil); }
struct Out { v2u w[4]; float lse; bf16* od; float* lp; };
__device__ __forceinline__ void store_out(const Out& o, int lane) {
#pragma unroll
    for (int dt = 0; dt < 4; ++dt) *(v2u*)(o.od + 16 * dt) = o.w[dt];
    if ((lane >> 4) == 0) *o.lp = o.lse;
}
__device__ __forceinline__ void compute(LAS unsigned char* buf, const Item& I, const bf16x8 (&qf)[2], size_t qtok, bf16* Ob, float* Lse, int wave, int lane, Out& out) {
    const int qi = lane & 15, g4 = lane >> 4, kbase = 128 * I.kblk - 64;
    const LAS unsigned char* kp0 = buf + (16 * wave + qi) * 128 + ((g4 ^ (qi & 7)) << 4);
    const LAS unsigned char* kp1 = buf + (16 * wave + qi) * 128 + (((4 + g4) ^ (qi & 7)) << 4);
    bf16x8 kf0[9], kf1[9];
#pragma unroll
    for (int kt = 0; kt < 9; ++kt) { kf0[kt] = *(const LAS bf16x8*)(kp0 + kt * 2048); kf1[kt] = *(const LAS bf16x8*)(kp1 + kt * 2048); }
    __builtin_amdgcn_sched_barrier(0);
    f32x4 sc[9];
#pragma unroll
    for (int kt = 0; kt < 9; ++kt) sc[kt] = __builtin_amdgcn_mfma_f32_16x16x32_bf16(kf0[kt], qf[0], (f32x4){0.f, 0.f, 0.f, 0.f}, 0, 0, 0);
#pragma unroll
    for (int kt = 0; kt < 9; ++kt) sc[kt] = __builtin_amdgcn_mfma_f32_16x16x32_bf16(kf1[kt], qf[1], sc[kt], 0, 0, 0);
    __builtin_amdgcn_sched_barrier(0);
    const int il = lane & 15, q_ = il >> 2, p_ = il & 3, rr = 4 * g4 + q_, sw = (rr >> 1) & 3;
    const LAS unsigned char* vb = buf + VOFF + (16 * wave + rr) * 128 + p_ * 8;
    v4i16_t vlo[5][4], vhi[5][4];
#pragma unroll
    for (int ks = 0; ks < 5; ++ks) {
        const int hioff = (ks == 4 && wave == 7) ? 0 : 2048;
        if (ks > 0) asm volatile("s_waitcnt lgkmcnt(7)" ::: "memory");
#pragma unroll
        for (int dt = 0; dt < 4; ++dt) {
            vlo[ks][dt] = __builtin_amdgcn_ds_read_tr16_b64_v4i16((LAS v4i16_t*)(vb + ks * 4096 + ((dt ^ sw) << 5)));
            vhi[ks][dt] = __builtin_amdgcn_ds_read_tr16_b64_v4i16((LAS v4i16_t*)(vb + ks * 4096 + hioff + ((dt ^ sw) << 5)));
        }
    }
    __builtin_amdgcn_sched_barrier(0);
#pragma unroll
    for (int e = 0; e < 4; ++e) { const int jj = 4 * g4 + e; if (jj < qi) sc[0][e] = -INFINITY; if (jj > qi) sc[8][e] = -INFINITY; }
    if (kbase < 0 || kbase + 256 > I.nidx) {
#pragma unroll
        for (int kt = 0; kt < 9; ++kt)
#pragma unroll
            for (int e = 0; e < 4; ++e) { const int kidx = kbase + 16 * (wave + kt) + 4 * g4 + e; if ((unsigned)kidx >= (unsigned)I.nidx) sc[kt][e] = -INFINITY; }
    }
    float mx = sc[0][0];
#pragma unroll
    for (int kt = 0; kt < 9; ++kt)
#pragma unroll
        for (int e = 0; e < 4; ++e) mx = fmaxf(mx, sc[kt][e]);
    mx = xmax16_32(mx);
    bf16x8 pf[5]; float lsv = 0.f;
#pragma unroll
    for (int ks = 0; ks < 5; ++ks) {
        f32x4 pa, pb;
#pragma unroll
        for (int e = 0; e < 4; ++e) { pa[e] = fexp2(sc[2 * ks][e] - mx); pb[e] = (ks < 4) ? fexp2(sc[2 * ks + 1][e] - mx) : 0.f; }
#pragma unroll
        for (int e = 0; e < 4; ++e) lsv += pa[e] + pb[e];
        pf[ks] = __builtin_bit_cast(bf16x8, pack8(pa, pb));
    }
    __builtin_amdgcn_sched_barrier(0);
    f32x4 o[4];
#pragma unroll
    for (int dt = 0; dt < 4; ++dt) o[dt] = (f32x4){0.f, 0.f, 0.f, 0.f};
#pragma unroll
    for (int ks = 0; ks < 5; ++ks) {
#pragma unroll
        for (int dt = 0; dt < 4; ++dt) {
            const bf16x8 vf = (bf16x8){vlo[ks][dt][0], vlo[ks][dt][1], vlo[ks][dt][2], vlo[ks][dt][3], vhi[ks][dt][0], vhi[ks][dt][1], vhi[ks][dt][2], vhi[ks][dt][3]};
            o[dt] = __builtin_amdgcn_mfma_f32_16x16x32_bf16(vf, pf[ks], o[dt], 0, 0, 0);
        }
    }
    const float ls = xsum16_32(lsv);
    const float inv = frcp(ls);
    out.od = Ob + ((size_t)I.br * M + qtok) * 512 + I.h * 64 + 4 * g4; out.lp = Lse + ((size_t)I.br * M + qtok) * 8 + I.h;
#pragma unroll
    for (int dt = 0; dt < 4; ++dt) { out.w[dt].x = cvt_pk_bf16(o[dt][0] * inv, o[dt][1] * inv); out.w[dt].y = cvt_pk_bf16(o[dt][2] * inv, o[dt][3] * inv); }
    out.lse = (mx + __builtin_amdgcn_logf(ls)) * LN2F;
}
__device__ __forceinline__ int run_of(int bx, int G, int k) {
    if (G != 256) { const int hs = bx + k * G; return hs < 1536 ? hs : 1536; }
    if (bx < 128) return k < 5 ? bx + 128 * k : 1536;
    return k < 7 ? 640 + (bx - 128) + 128 * k : 1536;
}
__device__ __forceinline__ void phase(LAS unsigned char* ring, const bf16* Q, const bf16* K, const bf16* V, bf16* Ob, float* Lse, int bx, int G, int wave, int lane) {
    int i = 0, hsc = run_of(bx, G, 0), hsn = hsc;
    bf16x8 qc[2], qn[2]; size_t tokc = 0, tokn = 0;
    qc[0] = qc[1] = qn[0] = qn[1] = (bf16x8){0, 0, 0, 0, 0, 0, 0, 0};
    if (hsc < 1536) { const Item I = decode(hsc, 0); stage<false>(ring, K, V, I, wave, lane); tokc = q_token(I, wave, lane);
        qc[0] = *(const bf16x8*)(Q + tokc * 512 + I.h * 64 + 8 * (lane >> 4)); qc[1] = *(const bf16x8*)(Q + tokc * 512 + I.h * 64 + 32 + 8 * (lane >> 4)); }
    asm volatile("s_waitcnt vmcnt(0)" : "+v"(qc[0]), "+v"(qc[1]) :: "memory"); __builtin_amdgcn_s_barrier(); asm volatile("" ::: "memory");
    int b = 0; Out po; bool have = false;
    po.od = nullptr; po.lp = nullptr; po.lse = 0.f; po.w[0] = po.w[1] = po.w[2] = po.w[3] = (v2u){0u, 0u};
    while (hsc < 1536) {
        if (have) store_out(po, lane);
        const int in = i + 1; hsn = run_of(bx, G, in >> 2);
        if (hsn < 1536) { const Item In = decode(hsn, in & 3);
            if (In.cont) { slide(ring + (b ^ 1) * BUFB, ring + b * BUFB, wave, lane); stage<true>(ring + (b ^ 1) * BUFB, K, V, In, wave, lane); }
            else stage<false>(ring + (b ^ 1) * BUFB, K, V, In, wave, lane);
            tokn = q_token(In, wave, lane);
            qn[0] = *(const bf16x8*)(Q + tokn * 512 + In.h * 64 + 8 * (lane >> 4)); qn[1] = *(const bf16x8*)(Q + tokn * 512 + In.h * 64 + 32 + 8 * (lane >> 4)); }
        { const Item I = decode(hsc, i & 3); compute(ring + b * BUFB, I, qc, tokc, Ob, Lse, wave, lane, po); have = true; }
        asm volatile("s_waitcnt vmcnt(0) lgkmcnt(0)" : "+v"(qn[0]), "+v"(qn[1]) :: "memory"); __builtin_amdgcn_s_barrier(); asm volatile("" ::: "memory");
        i = in; hsc = hsn; qc[0] = qn[0]; qc[1] = qn[1]; tokc = tokn; b ^= 1;
    }
    if (have) store_out(po, lane);
    __syncthreads();
}
}

__global__ void __launch_bounds__(NWAVES * 64, 2) mk_fwd(Args args) {
    extern __shared__ __attribute__((aligned(16))) unsigned char lds_raw[];
    LAS unsigned char* lds = (LAS unsigned char*)lds_raw;
    volatile LAS unsigned* MISC = (volatile LAS unsigned*)(lds + MISC_OFF);
    const int tid = threadIdx.x, lane = tid & 63, wave = __builtin_amdgcn_readfirstlane(tid >> 6);
    const int G = gridDim.x, bx = blockIdx.x;
    const int vcu = (G % 8 == 0) ? (bx % 8) * (G / 8) + bx / 8 : bx;
    const int gw = vcu * NWAVES + wave, NGW = G * NWAVES;
    const int gtid = gw * 64 + lane, NT = NGW * 64;
    unsigned char* ws = args.ws;
    gu32* ctl = (gu32*)(ws + WS_CTL);
    for (int u = tid; u < (LDS_BYTES - LDSCTL_OFF) / 4; u += NWAVES * 64) ((LAS unsigned*)(lds + LDSCTL_OFF))[u] = 0u;
    __syncthreads();
    if (tid == 0) { LAS unsigned long long* p = (LAS unsigned long long*)(lds + PARAM_OFF); p[0] = (unsigned long long)args.in[0]; p[1] = (unsigned long long)args.in[1]; p[2] = (unsigned long long)args.out; p[3] = (unsigned long long)args.ws;
        p[4] = (unsigned long long)args.in[17]; p[5] = (unsigned long long)args.in[19]; p[6] = (unsigned long long)args.in[21]; p[7] = (unsigned long long)args.in[25]; }
    __syncthreads();
    XcdBarrier bar; bar.bar = (unsigned*)(ctl + CW_BAR); bar.x = 0; bar.st = nullptr;
    if (MK_N_LAUNCHES == 1) bar = xcd_barrier_post((unsigned*)(ctl + CW_BAR), MISC + 8);
    const int lo = args.ph_lo, hi = args.ph_hi;
#ifndef REP_MASK
#define REP_MASK 0
#endif
#define IN(k) (lo <= (k) && (k) < hi)
#define REPS(k) (1 + ((REP_MASK >> (k)) & 1))
#ifndef TIME_PHASE
#define TIME_PHASE -1
#endif
    unsigned long long tp0 = (TIME_PHASE >= 0) ? __builtin_amdgcn_s_memrealtime() : 0ull;
#define SEAM(k) do { if (IN(k) && IN((k) + 1)) { \
        xcd_barrier(bar); \
        if (TIME_PHASE >= 0 && bx == 0 && tid == 0) { unsigned long long t1 = __builtin_amdgcn_s_memrealtime(); \
            if ((k) == TIME_PHASE) { const unsigned long long dt = t1 - tp0; while (__builtin_amdgcn_s_memrealtime() - t1 < 9ull * dt) __builtin_amdgcn_s_sleep(8); t1 = __builtin_amdgcn_s_memrealtime(); } \
            tp0 = t1; } } } while (0)

    float* modf = (float*)(ws + WS_MODF); float* modp = (float*)(ws + WS_MODP);
    float* t_ldre = (float*)(ws + WS_LDRE); float* t_zre = (float*)(ws + WS_ZRE); float* t_zim = (float*)(ws + WS_ZIM); float* t_atre = (float*)(ws + WS_ATRE); float* t_atim = (float*)(ws + WS_ATIM); double* t_theta = (double*)(ws + WS_THETA);
    bf16* W13T = (bf16*)(ws + WS_W13); bf16* WinT = (bf16*)(ws + WS_WIN); bf16* WgluT = (bf16*)(ws + WS_WGLU); bf16* WoT = (bf16*)(ws + WS_WO); bf16* W2T = (bf16*)(ws + WS_W2);
    bf16* Ptab = (bf16*)(ws + WS_PTAB); float* Sbuf = (float*)(ws + WS_SBUF); bf16* Klag = (bf16*)(ws + WS_KLAG); bf16* Toep = (bf16*)(ws + WS_TOEP);
    float* cosT = (float*)(ws + WS_ROPE); float* sinT = cosT + 16384 * 32;
    bf16* Ub = (bf16*)(ws + WS_U); bf16* Qb = (bf16*)(ws + WS_Q); bf16* Kb = (bf16*)(ws + WS_K); bf16* Vb = (bf16*)(ws + WS_V);
    bf16* Gb = (bf16*)(ws + WS_G); bf16* SsmRaw = (bf16*)(ws + WS_SSMRAW); bf16* MixA = (bf16*)(ws + WS_MIXA); bf16* H2 = (bf16*)(ws + WS_H2); bf16* Act = (bf16*)(ws + WS_ACT);
    bf16* H1 = (bf16*)((unsigned char*)args.out + DO_H1); bf16* Ob = (bf16*)((unsigned char*)args.out + DO_OB); float* Lse = (float*)((unsigned char*)args.out + DO_LSE);
    LAS float* scr = (LAS float*)(lds + RING_OFF + wave * 16384);

    if (IN(0)) for (int rep_ = 0; rep_ < REPS(0); ++rep_) {
        constexpr int I_IN = 16 * 64, I_GLU = 8 * 16, I_O = 16 * 32, I_1 = 16 * 88;
        constexpr int NITEMS = I_IN + I_GLU + I_O + 2 * I_1;
#ifndef P0_PROBE
#define P0_PROBE 0
#endif
        for (int p0r = 0; p0r < 1 + (P0_PROBE & 1); ++p0r)
        for (int it = gw; it < NITEMS; it += NGW) {
            int r = it;
            if (r < I_IN) { transpose_item(args.in[7], D, NPROJ, WinT, scr, r, lane, MapWin{}); continue; } r -= I_IN;
            if (r < I_GLU) { transpose_item(args.in[16], 512, 512, WgluT, scr, r, lane, MapId{}); continue; } r -= I_GLU;
            if (r < I_O) { transpose_item(args.in[20], D, D, WoT, scr, r, lane, MapId{}); continue; } r -= I_O;
            if (r < I_1) { transpose_item(args.in[22], D, FF, W13T, scr, r, lane, MapW13{0}); continue; } r -= I_1;
            transpose_item(args.in[23], D, FF, W13T, scr, r, lane, MapW13{128});
        }
        {
            LAS float* sl = (LAS float*)(lds + RING_OFF);
            LAS f32x2v* red2 = (LAS f32x2v*)(lds + RING_OFF + 20480);
            __syncthreads();
            for (int i = tid; i < 5 * 1024; i += NWAVES * 64) { const float cv = i < 1024 ? args.in[2][i] : args.in[3][i - 1024]; sl[i] = cv * sigm(cv); }
            __syncthreads();
            for (int p0r = 0; p0r < 1 + ((P0_PROBE >> 1) & 1); ++p0r)
            for (int task = vcu; task < 48 * 16; task += G) {
                const int cb = task % 48, ks = task / 48, n = 128 * cb + 2 * lane, k0 = 64 * ks + 8 * wave;
                const float* W = args.in[4] + (size_t)k0 * NMOD + n;
                f32x2v w[8];
#pragma unroll
                for (int i = 0; i < 8; ++i) w[i] = *(const f32x2v*)(W + (size_t)i * NMOD);
                f32x2v a0 = {0.f, 0.f}, a1 = a0, a2 = a0, a3 = a0, a4 = a0;
#pragma unroll
                for (int i = 0; i < 8; ++i) { const int k = k0 + i; a0 += w[i] * sl[k]; a1 += w[i] * sl[1024 + k]; a2 += w[i] * sl[2048 + k]; a3 += w[i] * sl[3072 + k]; a4 += w[i] * sl[4096 + k]; }
                __syncthreads();
                red2[(wave * 5 + 0) * 64 + lane] = a0; red2[(wave * 5 + 1) * 64 + lane] = a1; red2[(wave * 5 + 2) * 64 + lane] = a2; red2[(wave * 5 + 3) * 64 + lane] = a3; red2[(wave * 5 + 4) * 64 + lane] = a4;
                __syncthreads();
                if (wave < 5) { f32x2v t = red2[(0 * 5 + wave) * 64 + lane];
#pragma unroll
                    for (int v = 1; v < 8; ++v) t += red2[(v * 5 + wave) * 64 + lane];
                    *(f32x2v*)(modp + (size_t)(ks * 5 + wave) * NMOD + n) = t; }
            }
            __syncthreads();
        }
        for (int p0r = 0; p0r < 1 + ((P0_PROBE >> 2) & 1); ++p0r)
        for (int idx = gtid; idx < 16384 * 32; idx += NT) { const int pos = idx >> 5, i = idx & 31;
            const float inv = fexp2(-(float)i * 0.41524101186092033f); const float ang = (float)pos * inv; float s, c; sincos_rev((double)ang * INV_2PI, s, c); cosT[idx] = c; sinT[idx] = s; }
        for (int idx = gtid; idx < 4096; idx += NT) {
            const float dt = fexp2(args.in[10][idx >> 6] * LOG2E), lr = args.in[8][idx], li = args.in[9][idx];
            const float ldre = lr * dt; const double th = (double)li * (double)dt * INV_2PI;
            float s, c; sincos_rev(th, s, c); const float mag = fexp2(ldre * LOG2E), are = mag * c, aim = mag * s;
            const float nr = are - 1.f, den = lr * lr + li * li;
            t_ldre[idx] = ldre; t_theta[idx] = th; t_zre[idx] = (nr * lr + aim * li) / den; t_zim[idx] = (aim * lr - nr * li) / den;
            float sT, cT; sincos_rev((double)TCH * th, sT, cT); const float mT = fexp2((float)TCH * ldre * LOG2E); t_atre[idx] = mT * cT; t_atim[idx] = mT * sT;
        }
    }
    SEAM(0);

    if (IN(1)) for (int rep_ = 0; rep_ < REPS(1); ++rep_) {
        for (int e = gtid; e < 5 * NMOD; e += NT) { const int b = e / NMOD, n = e % NMOD; float v = args.in[5][n];
#pragma unroll
            for (int ks = 0; ks < 16; ++ks) v += modp[(size_t)(ks * 5 + b) * NMOD + n];
            modf[e] = v; }
#pragma unroll 1
        for (int step = 0; step < 2; ++step) {
        if ((step == 0) == ((bx & 1) == 0)) {
        LAS float* Gm = (LAS float*)(lds + RING_OFF + 65536); LAS float* Sh = Gm + 1024;
        for (int rb = vcu; rb < M / 128; rb += G) {
            const int row0 = rb * 128, b = batch_of(row0);
            __syncthreads();
            for (int k = tid; k < 1024; k += NWAVES * 64) { float sc = args.in[5][1024 + k], sh = args.in[5][k];
#pragma unroll
                for (int ks = 0; ks < 16; ++ks) { sc += modp[(size_t)(ks * 5 + b) * NMOD + 1024 + k]; sh += modp[(size_t)(ks * 5 + b) * NMOD + k]; }
                Gm[k] = args.in[6][k] * (1.f + sc); Sh[k] = sh; }
            __syncthreads();
            for (int i = 0; i < 16; i += 8) { const int row = row0 + wave * 16 + i; const float* xb = xrow_ptr(args, row); bf16* ob = H1 + (size_t)row * D;
                const float* xr[8] = {xb, xb + D, xb + 2 * D, xb + 3 * D, xb + 4 * D, xb + 5 * D, xb + 6 * D, xb + 7 * D};
                bf16* orw[8] = {ob, ob + D, ob + 2 * D, ob + 3 * D, ob + 4 * D, ob + 5 * D, ob + 6 * D, ob + 7 * D}; norm_rows_lds<8>(xr, orw, Gm, Sh, lane); }
        }
        } else {
        for (int task = vcu; task < 256; task += G) {
            const int g = task >> 3, lb = task & 7;
            LAS float* Bre = (LAS float*)(lds + RING_OFF);
            LAS float* Bim = Bre + 2048;
            LAS float* CZr = Bim + 2048;
            LAS float* CZi = CZr + 2080;
            LAS float* PWr = CZi + 2080;
            LAS float* PWi = PWr + 520;
            LAS float* X0 = PWi + 520;
            __syncthreads();
            for (int i = tid; i < 2048; i += NWAVES * 64) {
                const int dir = i >> 10, rem = i & 1023, gd = dir * 32 + g;
                Bre[i] = args.in[11][(size_t)gd * 1024 + rem]; Bim[i] = args.in[12][(size_t)gd * 1024 + rem];
                const int c = rem >> 6, n = rem & 63, bi = gd * 64 + n;
                const float cr = args.in[13][(size_t)gd * 1024 + rem], ci = args.in[14][(size_t)gd * 1024 + rem], zr = t_zre[bi], zi = t_zim[bi];
                CZr[(dir * 16 + c) * 65 + n] = cr * zr - ci * zi; CZi[(dir * 16 + c) * 65 + n] = cr * zi + ci * zr;
            }
            { const int i = tid; const int dir = i >> 8, l = (i >> 6) & 3, n = i & 63; float pre, pim; cpow_tab(t_ldre, t_theta, (dir * 32 + g) * 64 + n, 4 * lb + l, pre, pim);
                PWr[(dir * 4 + l) * 65 + n] = pre; PWi[(dir * 4 + l) * 65 + n] = pim; }
            __syncthreads();
            const int dir = tid >> 8, l = (tid >> 6) & 3, c = (tid >> 2) & 15, cq = tid & 3, tau = 4 * lb + l;
            f32x4 acc = {0.f, 0.f, 0.f, 0.f};
            const LAS float* czr = CZr + (dir * 16 + c) * 65; const LAS float* czi = CZi + (dir * 16 + c) * 65;
            const LAS float* pwr = PWr + (dir * 4 + l) * 65; const LAS float* pwi = PWi + (dir * 4 + l) * 65;
#pragma unroll 8
            for (int n = 0; n < 64; ++n) {
                const float a = czr[n], b = czi[n], pr = pwr[n], pi = pwi[n], wr_ = a * pr - b * pi, wi_ = a * pi + b * pr;
                const f32x4 r0 = *(const LAS f32x4*)(Bre + dir * 1024 + n * 16 + 4 * cq), m0 = *(const LAS f32x4*)(Bim + dir * 1024 + n * 16 + 4 * cq);
                acc += r0 * wr_ - m0 * wi_;
            }
            if (tau == 0 && dir == 1) *(LAS f32x4*)(X0 + c * 16 + 4 * cq) = acc;
            __syncthreads();
            if (tau == 0 && dir == 0) { const float dsk = args.in[15][16 * g + c]; const f32x4 xo = *(const LAS f32x4*)(X0 + c * 16 + 4 * cq);
#pragma unroll
                for (int j = 0; j < 4; ++j) acc[j] += xo[j] + ((4 * cq + j == c) ? dsk : 0.f); }
            if (!(tau == 0 && dir == 1)) {
                const int ti = dir == 0 ? (TCH - 1) + tau : (TCH - 1) - tau;
                v2u o; o.x = pk2(acc[0], acc[1]); o.y = pk2(acc[2], acc[3]);
                *(v2u*)(Klag + ((size_t)((g * (2 * TCH - 1) + ti) * 16 + c) * 16 + 4 * cq)) = o;
            }
        }
        for (int e = gtid; e < 32 * 2 * 64 * TCH; e += NT) {
            const int s = e & 31, n = (e >> 5) & 63, dir = (e >> 11) & 1, g = e >> 12, bi = (dir * 32 + g) * 64 + n;
            float pre, pim; cpow_tab(t_ldre, t_theta, bi, dir == 0 ? (TCH - 1) - s : s, pre, pim);
            const float zr = t_zre[bi], zi = t_zim[bi], wr_ = pre * zr - pim * zi, wi_ = pre * zi + pim * zr;
            const f32x4* br = (const f32x4*)(args.in[11] + (size_t)bi * 16); const f32x4* bm = (const f32x4*)(args.in[12] + (size_t)bi * 16);
            float re[16], im[16];
#pragma unroll
            for (int j4 = 0; j4 < 4; ++j4) { const f32x4 b1 = br[j4], b2 = bm[j4];
#pragma unroll
                for (int e2 = 0; e2 < 4; ++e2) { re[4 * j4 + e2] = wr_ * b1[e2] - wi_ * b2[e2]; im[4 * j4 + e2] = wr_ * b2[e2] + wi_ * b1[e2]; } }
            bf16* d0 = Ptab + ((size_t)(g * 256 + dir * 128 + 2 * n) * (16 * TCH) + s * 16);
            v4u o; o.x = pk2(re[0], re[1]); o.y = pk2(re[2], re[3]); o.z = pk2(re[4], re[5]); o.w = pk2(re[6], re[7]); *(v4u*)d0 = o;
            o.x = pk2(re[8], re[9]); o.y = pk2(re[10], re[11]); o.z = pk2(re[12], re[13]); o.w = pk2(re[14], re[15]); *(v4u*)(d0 + 8) = o;
            o.x = pk2(im[0], im[1]); o.y = pk2(im[2], im[3]); o.z = pk2(im[4], im[5]); o.w = pk2(im[6], im[7]); *(v4u*)(d0 + 16 * TCH) = o;
            o.x = pk2(im[8], im[9]); o.y = pk2(im[10], im[11]); o.z = pk2(im[12], im[13]); o.w = pk2(im[14], im[15]); *(v4u*)(d0 + 16 * TCH + 8) = o;
        }
        }
        }
    }
    SEAM(1);

    if (IN(2)) for (int rep_ = 0; rep_ < REPS(2); ++rep_) {
        pg8::Gemm g{H1, WinT, M, NPROJ, D, D, D}; DupOrder<(DUP_MASK >> 2) & 1> S; S.S.init(M, NPROJ, G, bx);
        EpiQKV E{Qb, Kb, Vb, Ub, cosT, sinT};
        pg8::gemm_phase<EpiQKV, DupOrder<(DUP_MASK >> 2) & 1>, true, true>(lds + RING_OFF, g, S, E);
    }
    SEAM(2);

    if (IN(3)) {
        { pg8::Gemm g{Ub, Ptab, NG * NCG, NG * 256, 16 * TCH, UP, 16 * TCH}; SchedState S{bx}; EpiState E{Sbuf};
          pg8::gemm_phase<EpiState, SchedState, true, true>(lds + RING_OFF, g, S, E); }
        for (int rep_ = 0; rep_ < REPS(3); ++rep_) att::phase(lds + RING_OFF, Qb, Kb, Vb, Ob, Lse, bx, G, wave, lane);
    }
    SEAM(3);

    if (IN(4)) for (int rep_ = 0; rep_ < REPS(4); ++rep_) {
        if (bx < 128) {
            int seq, g, dir, nc, chunk0, sgi;
            if (bx < 64) { seq = 0; g = bx >> 1; dir = bx & 1; nc = 512; chunk0 = 0; sgi = wave; }
            else { const int q = (bx - 64) * 4 + (wave >> 1); seq = 1 + (q >> 6); g = (q >> 1) & 31; dir = q & 1; nc = 128; chunk0 = 512 + 128 * (seq - 1); sgi = wave & 1; }
            const int i_lo = 64 * sgi;
            const int bi = (dir * 32 + g) * 64 + lane; const float ar = t_atre[bi], ai = t_atim[bi];
            float hr = 0.f, hi_ = 0.f;
            LAS float* T = (LAS float*)(lds + RING_OFF);
#pragma unroll 1
            for (int i0 = i_lo; i0 < i_lo + 64; i0 += 32) {
                f32x2v sv[32];
#pragma unroll
                for (int j = 0; j < 32; ++j) { const int c = dir == 0 ? i0 + j : nc - 1 - (i0 + j); sv[j] = *(const f32x2v*)(Sbuf + ((size_t)(g * NCG + chunk0 + c) * 256 + dir * 128 + 2 * lane)); }
#pragma unroll
                for (int j = 0; j < 32; ++j) { const float nr = ar * hr - ai * hi_ + sv[j].x, ni = ar * hi_ + ai * hr + sv[j].y; hr = nr; hi_ = ni; }
            }
            __syncthreads();
            T[(wave * 64 + lane) * 2] = hr; T[(wave * 64 + lane) * 2 + 1] = hi_;
            __syncthreads();
            float pr = ar, pi = ai;
#pragma unroll
            for (int k = 0; k < 6; ++k) { const float nr = pr * pr - pi * pi, ni = 2.f * pr * pi; pr = nr; pi = ni; }
            hr = 0.f; hi_ = 0.f;
            for (int v = wave - sgi; v < wave; ++v) { const float tr = T[(v * 64 + lane) * 2], ti2 = T[(v * 64 + lane) * 2 + 1]; const float nr = pr * hr - pi * hi_ + tr, ni = pr * hi_ + pi * hr + ti2; hr = nr; hi_ = ni; }
#pragma unroll 1
            for (int i0 = i_lo; i0 < i_lo + 64; i0 += 32) {
                f32x2v sv[32];
#pragma unroll
                for (int j = 0; j < 32; ++j) { const int c = dir == 0 ? i0 + j : nc - 1 - (i0 + j); sv[j] = *(const f32x2v*)(Sbuf + ((size_t)(g * NCG + chunk0 + c) * 256 + dir * 128 + 2 * lane)); }
#pragma unroll
                for (int j = 0; j < 32; ++j) { const int c = dir == 0 ? i0 + j : nc - 1 - (i0 + j);
                    *(unsigned*)(Ub + ((size_t)(g * NCG + chunk0 + c) * UP + 16 * TCH + dir * 128 + 2 * lane)) = pk2(hr, hi_);
                    const float nr = ar * hr - ai * hi_ + sv[j].x, ni = ar * hi_ + ai * hr + sv[j].y; hr = nr; hi_ = ni; }
            }
        }
        for (int e = gtid; e < 32 * TCH * 16 * TCH; e += NT) {
            const int s = e & 31, c = (e >> 5) & 15, t = (e >> 9) & 31, g = e >> 14;
            const v4u* src = (const v4u*)(Klag + ((size_t)((g * (2 * TCH - 1) + (t - s + TCH - 1)) * 16 + c) * 16));
            v4u* dst = (v4u*)(Toep + ((size_t)(g * 16 * TCH + t * 16 + c) * UP + s * 16));
            const v4u a = src[0], b = src[1]; dst[0] = a; dst[1] = b;
        }
        for (int e = gtid; e < 32 * TCH * 2 * 64; e += NT) {
            const int n = e & 63, dir = (e >> 6) & 1, t = (e >> 7) & 31, g = e >> 12, bi = (dir * 32 + g) * 64 + n;
            float pre, pim; cpow_tab(t_ldre, t_theta, bi, dir == 0 ? t + 1 : TCH - t, pre, pim);
#pragma unroll 4
            for (int c = 0; c < 16; ++c) {
                const float cr = args.in[13][(size_t)((dir * 32 + g) * 16 + c) * 64 + n], ci = args.in[14][(size_t)((dir * 32 + g) * 16 + c) * 64 + n];
                *(unsigned*)(Toep + ((size_t)(g * 16 * TCH + t * 16 + c) * UP + 16 * TCH + dir * 128 + 2 * n)) = pk2(cr * pre - ci * pim, -(cr * pim + ci * pre));
            }
        }
    }
    SEAM(4);

    if (IN(5)) for (int rep_ = 0; rep_ < REPS(5); ++rep_) {
        pg8::Gemm g{Ub, Toep, NG * NCG, NG * 16 * TCH, UP, UP, UP}; SchedSsmOut S{vcu}; EpiSsmOut E{Gb};
        pg8::gemm_phase<EpiSsmOut, SchedSsmOut, true, true>(lds + RING_OFF, g, S, E);
    }
    SEAM(5);

    if (IN(6)) for (int rep_ = 0; rep_ < REPS(6); ++rep_) {
        pg8::Gemm g{Gb, WgluT, M, 512, 512, 512, 512}; DupOrder<(DUP_MASK >> 6) & 1> S; S.S.init(M, 512, G, bx);
        EpiGluNorm E{lds};
        pg8::gemm_phase<EpiGluNorm, DupOrder<(DUP_MASK >> 6) & 1>, true, true>(lds + RING_OFF, g, S, E);
#ifndef P6_PROBE
#define P6_PROBE 0
#endif
        for (int p6r = 0; p6r < 1 + (P6_PROBE & 1); ++p6r)
        for (int t0 = 2 * gw; t0 < M; t0 += 2 * NGW) {
            const int hh = lane >> 3;
            float l0[2], l1[2], l2[2]; v4u a[2], bb[2], c[2];
#pragma unroll
            for (int k = 0; k < 2; ++k) { const size_t t = t0 + k;
                l0[k] = Lse[t * 8 + hh]; l1[k] = Lse[((size_t)M + t) * 8 + hh]; l2[k] = Lse[((size_t)2 * M + t) * 8 + hh];
                a[k] = *(const v4u*)(Ob + t * 512 + 8 * lane); bb[k] = *(const v4u*)(Ob + ((size_t)M + t) * 512 + 8 * lane); c[k] = *(const v4u*)(Ob + ((size_t)2 * M + t) * 512 + 8 * lane); }
            const f32x4 g0 = *(const f32x4*)(args.in[18] + 8 * lane), g1 = *(const f32x4*)(args.in[18] + 8 * lane + 4);
#pragma unroll
            for (int k = 0; k < 2; ++k) {
                const float lm = fmaxf(l0[k], fmaxf(l1[k], l2[k]));
                float w0 = fexp2((l0[k] - lm) * LOG2E), w1 = fexp2((l1[k] - lm) * LOG2E), w2 = fexp2((l2[k] - lm) * LOG2E);
                const float wi = frcp(w0 + w1 + w2); w0 *= wi; w1 *= wi; w2 *= wi;
                float v[8];
                v[0] = w0 * bflo(a[k].x) + w1 * bflo(bb[k].x) + w2 * bflo(c[k].x); v[1] = w0 * bfhi(a[k].x) + w1 * bfhi(bb[k].x) + w2 * bfhi(c[k].x);
                v[2] = w0 * bflo(a[k].y) + w1 * bflo(bb[k].y) + w2 * bflo(c[k].y); v[3] = w0 * bfhi(a[k].y) + w1 * bfhi(bb[k].y) + w2 * bfhi(c[k].y);
                v[4] = w0 * bflo(a[k].z) + w1 * bflo(bb[k].z) + w2 * bflo(c[k].z); v[5] = w0 * bfhi(a[k].z) + w1 * bfhi(bb[k].z) + w2 * bfhi(c[k].z);
                v[6] = w0 * bflo(a[k].w) + w1 * bflo(bb[k].w) + w2 * bflo(c[k].w); v[7] = w0 * bfhi(a[k].w) + w1 * bfhi(bb[k].w) + w2 * bfhi(c[k].w);
                float sq = 0.f;
#pragma unroll
                for (int j = 0; j < 8; ++j) sq += v[j] * v[j];
                const float rs = __builtin_amdgcn_rsqf(wave_sum(sq) * (1.f / 512.f) + EPS);
                v4u o; o.x = pk2(v[0] * rs * g0[0], v[1] * rs * g0[1]); o.y = pk2(v[2] * rs * g0[2], v[3] * rs * g0[3]); o.z = pk2(v[4] * rs * g1[0], v[5] * rs * g1[1]); o.w = pk2(v[6] * rs * g1[2], v[7] * rs * g1[3]);
                *(v4u*)(MixA + (size_t)(t0 + k) * D + 8 * lane) = o;
            }
        }
    }
    SEAM(6);


    if (IN(8)) {
        pg8::Gemm g{MixA, WoT, M, D, D, D, D, H2, W13T}; EpiWoUp E{lds};
        if (G == 256) {
#pragma unroll 1
            for (int part = 0; part < 2; ++part) { SchedWoUp S{bx, (const unsigned*)(ctl + CW_READY), part == 0 ? 0 : 1, part == 0 ? 1 : 12};
                pg8::gemm_phase<EpiWoUp, SchedWoUp, true, true>(lds + RING_OFF, g, S, E); }
        }
    }
    SEAM(8);

    if (IN(11)) for (int rep_ = 0; rep_ < REPS(11); ++rep_) {
        for (int it = gw; it < 44 * 32; it += NGW) transpose_item(args.in[24], FF, D, W2T, scr, it, lane, MapId{});
    }
    SEAM(11);
#ifdef EXTRA_BARS
    for (int xb_ = 0; xb_ < EXTRA_BARS; ++xb_) xcd_barrier(bar);
#endif

    if (IN(12)) {
        pg8::Gemm g{Act, W2T, M, D, FF, FF, FF}; DupOrder<((DUP_MASK >> 12) & 1) + 2 * ((DUP_MASK >> 13) & 1)> S; S.S.init(M, D, G, bx);
        EpiDownFinal E{lds};
        pg8::gemm_phase<EpiDownFinal, DupOrder<((DUP_MASK >> 12) & 1) + 2 * ((DUP_MASK >> 13) & 1)>, true, true>(lds + RING_OFF, g, S, E);
    }
    if (TIME_PHASE == 12 && bx == 0) { __syncthreads(); if (tid == 0) { const unsigned long long t1 = __builtin_amdgcn_s_memrealtime(); const unsigned long long dt = t1 - tp0; while (__builtin_amdgcn_s_memrealtime() - t1 < 9ull * dt) __builtin_amdgcn_s_sleep(8); } }
#undef IN
#undef SEAM
}

extern "C" void kernel_launch(void* const* d_in, const int* in_sizes, int n_in, void* d_out, int out_size, void* d_ws, size_t ws_size, hipStream_t stream) {
    static int grid = 0;
    if (grid == 0) {
        if (n_in != 26 || in_sizes[0] != MP * D || out_size != M * D || ws_size < WS_END) { fprintf(stderr, "kernel_launch: unexpected shapes (n_in %d, in0 %d, out %d, ws %zu); nothing launched\n", n_in, n_in > 0 ? in_sizes[0] : -1, out_size, ws_size); grid = -1; return; }
        int dev = 0, cus = 0, per_cu = 0;
        if (hipGetDevice(&dev) != hipSuccess || hipDeviceGetAttribute(&cus, hipDeviceAttributeMultiprocessorCount, dev) != hipSuccess) { grid = -1; return; }
        if (hipFuncSetAttribute((const void*)mk_fwd, hipFuncAttributeMaxDynamicSharedMemorySize, LDS_BYTES) != hipSuccess) { fprintf(stderr, "kernel_launch: hipFuncSetAttribute failed\n"); grid = -1; return; }
        if (hipOccupancyMaxActiveBlocksPerMultiprocessor(&per_cu, (const void*)mk_fwd, NWAVES * 64, LDS_BYTES) != hipSuccess || per_cu < 1) fprintf(stderr, "kernel_launch: occupancy query says %d\n", per_cu);
        (void)hipGetLastError();
        grid = cus;
    }
    if (grid < 0) return;
    if (hipMemsetAsync((char*)d_ws + WS_CTL, 0, CTL_ZERO_BYTES, stream) != hipSuccess) return;
    Args a{};
    for (int i = 0; i < 26; ++i) a.in[i] = (const float*)d_in[i];
    a.out = (float*)d_out; a.ws = (unsigned char*)d_ws;
    if (MK_N_LAUNCHES == 1) { a.ph_lo = 0; a.ph_hi = N_PHASES; hipLaunchKernelGGL(mk_fwd, dim3(grid), dim3(NWAVES * 64), LDS_BYTES, stream, a); }
    else for (int p = 0; p < N_PHASES; ++p) { a.ph_lo = p; a.ph_hi = p + 1; hipLaunchKernelGGL(mk_fwd, dim3(grid), dim3(NWAVES * 64), LDS_BYTES, stream, a); }
}
```

```cpp
#include <hip/hip_runtime.h>
#include <cstdio>
#include <cstdint>
#include <cmath>
namespace pg8 {
#define PG8_LAS __attribute__((address_space(3)))
typedef unsigned short bf16_t;
typedef short bf16x8 __attribute__((ext_vector_type(8)));
typedef float f32x4 __attribute__((ext_vector_type(4)));
typedef unsigned u32x4 __attribute__((ext_vector_type(4)));
constexpr int BM = 256, BK = 64, HALF = 128, HTB = HALF * BK * 2  , STAGE_BYTES = 8 * HTB, NXCD = 8, WGM = 8;

__host__ __device__ __forceinline__ int lds_byte(int r, int c) { const int st = (r >> 4) * 2 + (c >> 5), rr = r & 15, cc = c & 31, ob = rr * 64 + cc * 2; return st * 1024 + (ob ^ (((ob >> 9) & 1) << 5)); }
__host__ __device__ __forceinline__ void stage_rc(int b, int& R, int& C) { const int st = b / 1024, sb = b % 1024, swz = sb ^ (((sb >> 9) & 1) << 5); R = (st >> 1) * 16 + swz / 64; C = (st & 1) * 32 + (swz % 64) / 2; }
__host__ __device__ __forceinline__ int perm32(int rho) { const int n = rho >> 4, i = rho & 15; return 8 * (i >> 2) + 4 * n + (i & 3); }

struct Unit { int pm, pn; int ty = 0; };
struct Gemm { const bf16_t* A; const bf16_t* Bt; int M, N, K, lda, ldb; const bf16_t* A2 = nullptr; const bf16_t* Bt2 = nullptr; };

struct StaticOrder {
    int nM, nN, nwg, G, c;
    __host__ __device__ void init(int M, int N, int G_, int c_) { nM = M / BM; nN = N / BM; nwg = nM * nN; G = G_; c = c_; }
    __host__ __device__ bool next(int i, Unit& u) const {
        const long L = (long)i * G + c; if (L >= nwg) return false;
        int wgid = (int)L; { const int q = nwg / NXCD, r = nwg % NXCD, xcd = wgid % NXCD, off = wgid / NXCD; wgid = (xcd < r ? xcd * (q + 1) : r * (q + 1) + (xcd - r) * q) + off; }
        const int nig = WGM * nN, gid = wgid / nig, fm = gid * WGM, gsz = (nM - fm) < WGM ? (nM - fm) : WGM;
        u.pm = fm + ((wgid % nig) % gsz); u.pn = (wgid % nig) / gsz; return true;
    }
    __device__ __forceinline__ void a_ready(const Unit&) const {}
    __device__ __forceinline__ void done(const Unit&) const {}
};

__device__ __forceinline__ unsigned cvt_pk_bf16(float lo, float hi) { unsigned r; asm volatile("v_cvt_pk_bf16_f32 %0, %1, %2" : "=v"(r) : "v"(lo), "v"(hi)); return r; }
template <class Epi, class Sched, bool ALIGN_EPI = false, bool SP2 = false>
__device__ __forceinline__ void gemm_phase(PG8_LAS unsigned char* lds, const Gemm g, const Sched& S, const Epi& E) {
    const int tid = threadIdx.x, wid = __builtin_amdgcn_readfirstlane(tid >> 6), lane = tid & 63, wr = wid >> 2, wc = wid & 3, fr = lane & 15, fq = lane >> 4;
    const int K = g.K, nt = K / BK;
    unsigned voffA[2], voffB[2];
#pragma unroll
    for (int i = 0; i < 2; ++i) { int R, C; stage_rc(tid * 16 + i * 8192, R, C); const int Rb = Epi::PERM ? ((R & ~31) + perm32(R & 31)) : R;
        voffA[i] = (unsigned)(R * g.lda + C) * 2u; voffB[i] = (unsigned)(Rb * g.ldb + C) * 2u; }
    const size_t kstep = (size_t)(BK * 2);
    const size_t hstepA = (size_t)HALF * g.lda * 2, hstepB = (size_t)HALF * g.ldb * 2;
    const size_t tstepA = 2 * hstepA, tstepB = 2 * hstepB;
    const unsigned ldsw = (unsigned)wid * 1024u;
    const int aoff = lds_byte(wr * 64 + fr, fq * 8), boff = lds_byte(wc * 32 + fr, fq * 8);
#define PG8_SA(b, h) (((b) * 2 + (h)) * HTB)
#define PG8_SB(b, h) ((4 + (b) * 2 + (h)) * HTB)
#define PG8_STAGE(bufoff, gbase, voff) do { _Pragma("unroll") for (int _i = 0; _i < 2; ++_i) \
        __builtin_amdgcn_global_load_lds((const unsigned*)((const char*)(gbase) + (voff)[_i]), (PG8_LAS unsigned*)(lds + (bufoff) + ldsw + _i * 8192), 16, 0, 0); } while (0)
#define PG8_LDA(dst, b, h) do { _Pragma("unroll") for (int m = 0; m < 4; ++m) _Pragma("unroll") for (int k = 0; k < 2; ++k) dst[m][k] = *(const PG8_LAS bf16x8*)(lds + PG8_SA(b, h) + aoff + m * 2048 + k * 1024); } while (0)
#define PG8_LDB(dst, b, h) do { _Pragma("unroll") for (int n = 0; n < 2; ++n) _Pragma("unroll") for (int k = 0; k < 2; ++k) dst[n][k] = *(const PG8_LAS bf16x8*)(lds + PG8_SB(b, h) + boff + n * 2048 + k * 1024); } while (0)
#define PG8_MMA(ai, bj, At, Bt) do { __builtin_amdgcn_s_setprio(1); _Pragma("unroll") for (int m = 0; m < 4; ++m) _Pragma("unroll") for (int n = 0; n < 2; ++n) _Pragma("unroll") for (int k = 0; k < 2; ++k) \
        acc[ai][bj][m][n] = __builtin_amdgcn_mfma_f32_16x16x32_bf16(Bt[n][k], At[m][k], acc[ai][bj][m][n], 0, 0, 0); __builtin_amdgcn_s_setprio(0); } while (0)
#define PG8_WAIT_V(n) asm volatile("s_waitcnt vmcnt(" #n ")" ::: "memory")
#define PG8_WAIT_L(n) asm volatile("s_waitcnt lgkmcnt(" #n ")" ::: "memory")
#define PG8_BAR __builtin_amdgcn_s_barrier()
#define PG8_SCHED __builtin_amdgcn_sched_barrier(0)
    Unit cur, nxt; int ui = 0;
    if (!S.next(0, cur)) return;
    f32x4 acc[2][2][4][2];
#pragma unroll
    for (int a = 0; a < 2; ++a)
#pragma unroll
        for (int b = 0; b < 2; ++b)
#pragma unroll
            for (int m = 0; m < 4; ++m)
#pragma unroll
                for (int n = 0; n < 2; ++n) acc[a][b][m][n] = (f32x4){0.f, 0.f, 0.f, 0.f};
    bf16x8 At[4][2], B0[2][2], B1[2][2];
    const char* cA = (const char*)(cur.ty ? g.A2 : g.A) + (size_t)cur.pm * tstepA; const char* cB = (const char*)(cur.ty ? g.Bt2 : g.Bt) + (size_t)cur.pn * tstepB;
    S.a_ready(cur);
    if constexpr (SP2) {
        PG8_STAGE(PG8_SB(0, 0), cB, voffB); PG8_STAGE(PG8_SB(0, 1), cB + hstepB, voffB); PG8_STAGE(PG8_SA(0, 0), cA, voffA); PG8_STAGE(PG8_SA(0, 1), cA + hstepA, voffA);
        if (wr == 1) PG8_BAR;
        PG8_WAIT_V(2); PG8_BAR;
        PG8_STAGE(PG8_SB(1, 0), cB + kstep, voffB); PG8_STAGE(PG8_SA(1, 0), cA + kstep, voffA); PG8_STAGE(PG8_SB(1, 1), cB + hstepB + kstep, voffB);
        PG8_WAIT_V(6); PG8_BAR;
    } else {
        PG8_STAGE(PG8_SB(0, 0), cB, voffB); PG8_STAGE(PG8_SA(0, 0), cA, voffA); PG8_STAGE(PG8_SB(0, 1), cB + hstepB, voffB); PG8_STAGE(PG8_SA(0, 1), cA + hstepA, voffA);
        if (wr == 1) PG8_BAR;
        PG8_WAIT_V(4); PG8_BAR;
        PG8_STAGE(PG8_SB(1, 0), cB + kstep, voffB); PG8_STAGE(PG8_SA(1, 0), cA + kstep, voffA); PG8_STAGE(PG8_SB(1, 1), cB + hstepB + kstep, voffB);
        PG8_WAIT_V(6); PG8_BAR;
    }
    for (;;) {
        const bool has_next = S.next(ui + 1, nxt);
        const char* nA = has_next ? (const char*)(nxt.ty ? g.A2 : g.A) + (size_t)nxt.pm * tstepA : cA; const char* nB = has_next ? (const char*)(nxt.ty ? g.Bt2 : g.Bt) + (size_t)nxt.pn * tstepB : cB;
        for (int t = 0; t < nt; t += 2) {
            const bool last = (t == nt - 2);
            const char* a1 = cA + (size_t)(t + 1) * kstep;
            const char* a2 = last ? nA : cA + (size_t)(t + 2) * kstep; const char* b2 = last ? nB : cB + (size_t)(t + 2) * kstep;
            const char* a3 = a2 + kstep; const char* b3 = b2 + kstep;
            if (last && has_next) S.a_ready(nxt);
            if constexpr (SP2) {
            PG8_LDB(B0, 0, 0); PG8_LDB(B1, 0, 1); PG8_SCHED; PG8_LDA(At, 0, 0); PG8_STAGE(PG8_SA(1, 1), a1 + hstepA, voffA);
            PG8_WAIT_V(8); PG8_WAIT_L(0); PG8_BAR; PG8_MMA(0, 0, At, B0); PG8_MMA(0, 1, At, B1); PG8_BAR; PG8_SCHED;
            PG8_LDA(At, 0, 1); PG8_STAGE(PG8_SB(0, 0), b2, voffB); PG8_STAGE(PG8_SB(0, 1), b2 + hstepB, voffB); PG8_STAGE(PG8_SA(0, 0), a2, voffA);
            PG8_WAIT_V(8); PG8_WAIT_L(0); PG8_BAR; PG8_MMA(1, 0, At, B0); PG8_MMA(1, 1, At, B1); PG8_BAR; PG8_SCHED;
            PG8_LDB(B0, 1, 0); PG8_LDB(B1, 1, 1); PG8_SCHED; PG8_LDA(At, 1, 0); PG8_STAGE(PG8_SA(0, 1), a2 + hstepA, voffA);
            PG8_WAIT_V(8); PG8_WAIT_L(0); PG8_BAR; PG8_MMA(0, 0, At, B0); PG8_MMA(0, 1, At, B1); PG8_BAR; PG8_SCHED;
            PG8_LDA(At, 1, 1); PG8_STAGE(PG8_SB(1, 0), b3, voffB); PG8_STAGE(PG8_SB(1, 1), b3 + hstepB, voffB); PG8_STAGE(PG8_SA(1, 0), a3, voffA);
            PG8_WAIT_V(8); PG8_WAIT_L(0); PG8_BAR; PG8_MMA(1, 0, At, B0); PG8_MMA(1, 1, At, B1); PG8_BAR; PG8_SCHED;
            } else {
            PG8_LDB(B0, 0, 0); PG8_SCHED; PG8_LDA(At, 0, 0); PG8_STAGE(PG8_SA(1, 1), a1 + hstepA, voffA);
            PG8_WAIT_L(8); PG8_BAR; PG8_WAIT_L(0); PG8_MMA(0, 0, At, B0); PG8_BAR; PG8_SCHED;
            PG8_LDB(B1, 0, 1); PG8_STAGE(PG8_SB(0, 0), b2, voffB);
            PG8_BAR; PG8_WAIT_L(0); PG8_MMA(0, 1, At, B1); PG8_BAR;
            PG8_LDA(At, 0, 1); PG8_STAGE(PG8_SA(0, 0), a2, voffA);
            PG8_BAR; PG8_WAIT_L(0); PG8_MMA(1, 0, At, B0); PG8_BAR; PG8_SCHED;
            PG8_STAGE(PG8_SB(0, 1), b2 + hstepB, voffB);
            PG8_WAIT_V(6); PG8_BAR; PG8_MMA(1, 1, At, B1); PG8_BAR;
            PG8_LDB(B0, 1, 0); PG8_SCHED; PG8_LDA(At, 1, 0); PG8_STAGE(PG8_SA(0, 1), a2 + hstepA, voffA);
            PG8_WAIT_L(8); PG8_BAR; PG8_WAIT_L(0); PG8_MMA(0, 0, At, B0); PG8_BAR; PG8_SCHED;
            PG8_LDB(B1, 1, 1); PG8_STAGE(PG8_SB(1, 0), b3, voffB);
            PG8_BAR; PG8_WAIT_L(0); PG8_MMA(0, 1, At, B1); PG8_BAR;
            PG8_LDA(At, 1, 1); PG8_STAGE(PG8_SA(1, 0), a3, voffA);
            PG8_BAR; PG8_WAIT_L(0); PG8_MMA(1, 0, At, B0); PG8_BAR; PG8_SCHED;
            PG8_STAGE(PG8_SB(1, 1), b3 + hstepB, voffB);
            PG8_WAIT_V(6); PG8_BAR; PG8_MMA(1, 1, At, B1); PG8_BAR;
            }
        }
        if constexpr (ALIGN_EPI) { if (wr == 0) PG8_BAR; }
        if constexpr (!Epi::AFTER_DRAIN) { E(acc, cur, wr, wc, fr, fq); S.done(cur); }
        if (!has_next) break;
#pragma unroll
        for (int a = 0; a < 2; ++a)
#pragma unroll
            for (int b = 0; b < 2; ++b)
#pragma unroll
                for (int m = 0; m < 4; ++m)
#pragma unroll
                    for (int n = 0; n < 2; ++n) acc[a][b][m][n] = (f32x4){0.f, 0.f, 0.f, 0.f};
        cur = nxt; cA = nA; cB = nB; ++ui;
        if constexpr (ALIGN_EPI) { if (wr == 1) PG8_BAR; }
    }
    PG8_WAIT_V(0);
    if constexpr (!ALIGN_EPI) { if (wr == 0) PG8_BAR; }
    PG8_BAR;
    if constexpr (Epi::AFTER_DRAIN) { E.fused(acc, cur, wr, wc, fr, fq, lds, wid, lane); S.done(cur); }
#undef PG8_SA
#undef PG8_SB
#undef PG8_STAGE
#undef PG8_LDA
#undef PG8_LDB
#undef PG8_MMA
#undef PG8_WAIT_V
#undef PG8_WAIT_L
#undef PG8_BAR
#undef PG8_SCHED
}
}
#define GAS __attribute__((address_space(1)))
#define LAS __attribute__((address_space(3)))
typedef unsigned short bf16;
typedef unsigned v4u __attribute__((ext_vector_type(4)));
typedef float f32x4 __attribute__((ext_vector_type(4)));
typedef short bf16x8 __attribute__((ext_vector_type(8)));
typedef GAS unsigned gu32;
typedef GAS unsigned long long gu64;
#define RLX_AGENT __ATOMIC_RELAXED, __HIP_MEMORY_SCOPE_AGENT
#define LDS_WAIT() asm volatile("s_waitcnt lgkmcnt(0)" ::: "memory")
#define VM_WAIT() asm volatile("s_waitcnt vmcnt(0)" ::: "memory")
__device__ __forceinline__ unsigned long long rt() { return __builtin_amdgcn_s_memrealtime(); }
__device__ __forceinline__ unsigned f2bf(float f) { unsigned u = __builtin_bit_cast(unsigned, f); return (u + 0x7fffu + ((u >> 16) & 1u)) >> 16; }
__device__ __forceinline__ unsigned pk2(float lo, float hi) { return f2bf(lo) | (f2bf(hi) << 16); }

#define XB_TMO      128
#define XB_XCNT(j)  (256  + 64 * (j))
#define XB_XSUB(j)  (1280 + 64 * (j))
#define XB_XGEN(j)  (2304 + 64 * (j))
#define XB_TOP      3328
#define XB_TOPGEN   3392
#define XCD_BAR_WORDS 3456
#define XB_SPIN_CAP (1u << 18)

__device__ __forceinline__ unsigned xb_ld(unsigned* p)              { return __hip_atomic_load(p, __ATOMIC_RELAXED, __HIP_MEMORY_SCOPE_AGENT); }
__device__ __forceinline__ unsigned xb_add(unsigned* p, unsigned v) { return __hip_atomic_fetch_add(p, v, __ATOMIC_RELAXED, __HIP_MEMORY_SCOPE_AGENT); }
__device__ __forceinline__ unsigned xb_xcc_id() { return (unsigned)__builtin_amdgcn_s_getreg((3 << 11) | 20) & 0xFu; }
#define XB_SPIN(cond, bar) do { unsigned _sp = 0; while (cond) { __builtin_amdgcn_s_sleep(1); \
    if ((++_sp & 255u) == 0u) { if (xb_ld(&(bar)[XB_TMO])) break; if (_sp > XB_SPIN_CAP) { atomicAdd(&(bar)[XB_TMO], 1u); break; } } } } while (0)

struct XcdBarrier {
    unsigned* bar; unsigned x;
    volatile LAS unsigned* st;
};

__device__ __forceinline__ XcdBarrier xcd_barrier_post(unsigned* bar, volatile LAS unsigned* st) {
    XcdBarrier b; b.bar = bar; b.x = xb_xcc_id(); b.st = st;
    if (threadIdx.x == 0) (void)xb_add(&bar[XB_XCNT(b.x)], 1u);
    return b;
}
__device__ __forceinline__ void xcd_barrier_complete(unsigned* bar, unsigned x, unsigned& nloc, unsigned& nx) {
    const unsigned G = gridDim.x * gridDim.y * gridDim.z;
    unsigned sum, cnt, mine, sp = 0u;
    for (;;) {
        sum = 0u; cnt = 0u; mine = 0u;
#pragma unroll
        for (unsigned j = 0; j < 16; ++j) { const unsigned c = xb_ld(&bar[XB_XCNT(j)]); sum += c; cnt += (c > 0u) ? 1u : 0u; mine = (j == x) ? c : mine; }
        if (sum == G) break;
        __builtin_amdgcn_s_sleep(1);
        if ((++sp & 255u) == 0u) { if (xb_ld(&bar[XB_TMO])) break; if (sp > XB_SPIN_CAP) { atomicAdd(&bar[XB_TMO], 1u); break; } }
    }
    nloc = mine > 0u ? mine : 1u; nx = cnt > 0u ? cnt : 1u;
}

__device__ __forceinline__ void xcd_barrier(const XcdBarrier& b) {
    asm volatile("s_waitcnt vmcnt(0)" ::: "memory");
    __syncthreads();
    if (threadIdx.x == 0) {
        unsigned* bar = b.bar;
        __builtin_amdgcn_s_waitcnt(0);
        unsigned nloc = b.st[0], nx = b.st[1];
        if (nloc == 0u) { xcd_barrier_complete(bar, b.x, nloc, nx); b.st[0] = nloc; b.st[1] = nx; }
        const unsigned old = xb_add(&bar[XB_XSUB(b.x)], 1u);
        const unsigned gen = old / nloc;
        if (old + 1u == (gen + 1u) * nloc) {
            __builtin_amdgcn_fence(__ATOMIC_RELEASE, "agent");
            asm volatile("s_waitcnt vmcnt(0)" ::: "memory");
            const unsigned og = xb_add(&bar[XB_TOP], 1u);
            const unsigned tg = og / nx;
            if (og + 1u == (tg + 1u) * nx) xb_add(&bar[XB_TOPGEN], 1u);
            else XB_SPIN(xb_ld(&bar[XB_TOPGEN]) == tg, bar);
            __builtin_amdgcn_fence(__ATOMIC_ACQUIRE, "agent");
            xb_add(&bar[XB_XGEN(b.x)], 1u);
            asm volatile("s_waitcnt vmcnt(0)" ::: "memory");
        } else {
            XB_SPIN(xb_ld(&bar[XB_XGEN(b.x)]) == gen, bar);
            __builtin_amdgcn_fence(__ATOMIC_ACQUIRE, "agent");
            asm volatile("s_waitcnt vmcnt(0)" ::: "memory");
        }
    }
    __syncthreads();
}

constexpr int NWAVES = 8;
#ifndef MK_N_LAUNCHES
#define MK_N_LAUNCHES 1
#endif
constexpr int N_PHASES = 14;
constexpr int D = 1024, M = 32768, MP = 16384, SS = 4096;
constexpr int NG = 32, TCH = 32, NCG = 1024  , FF = 2816, NPROJ = 2048, NMOD = 6144, UP = 768  ;
constexpr float EPS = 1e-6f;
constexpr float LOG2E = 1.4426950408889634f, LN2F = 0.6931471805599453f;
constexpr float QSCALE = 0.125f * LOG2E;
constexpr double INV_2PI = 0.15915494309189533577;

constexpr size_t MiB = 1u << 20;
constexpr size_t WS_CTL = 0, CTL_ZERO_BYTES = 262144;
constexpr size_t WS_MODF = 262144;
constexpr size_t WS_XBUF = 524288;
constexpr size_t WS_LDRE = 393216, WS_ZRE = 409600, WS_ZIM = 425984, WS_ATRE = 442368, WS_ATIM = 458752, WS_THETA = 475136;
constexpr size_t WS_W13 = 1 * MiB;
constexpr size_t WS_PTAB = 12 * MiB, WS_SBUF = 20 * MiB, WS_WIN = 52 * MiB, WS_ROPE = 56 * MiB, WS_MODP = 60 * MiB, WS_WGLU = 254 * MiB, WS_WO = 252 * MiB, WS_KLAG = 63 * MiB;
constexpr size_t WS_SSMRAW = 12 * MiB, WS_H2 = 12 * MiB, WS_W2 = 12 * MiB;
constexpr size_t WS_U = 76 * MiB, WS_Q = 124 * MiB, WS_K = 156 * MiB, WS_V = 188 * MiB, WS_TOEP = 124 * MiB, WS_G = 196 * MiB, WS_MIXA = 12 * MiB  , WS_ACT = 76 * MiB, WS_END = 255 * MiB;
constexpr size_t DO_H1 = 0, DO_OB = 0, DO_LSE = 96 * MiB;
constexpr int CW_ATTQ = 2048;
constexpr int CW_BAR = 4096, CW_SEAM = 16384, SEAM_BANK = 8192;
constexpr int PARAM_OFF = 131520;
constexpr int CW_READY = CW_SEAM + 3 * SEAM_BANK;
constexpr int XLDS_OFF = 131584;

constexpr int RING_OFF = 0, RING_BYTES = 131072;
constexpr int LDSCTL_OFF = RING_BYTES, MISC_OFF = LDSCTL_OFF + 320;
constexpr int LDS_BYTES = 147456;

typedef short v4i16_t __attribute__((ext_vector_type(4)));
typedef unsigned v2u __attribute__((ext_vector_type(2)));
typedef float f32x2v __attribute__((ext_vector_type(2)));

struct Args { const float* in[26]; float* out; unsigned char* ws; int ph_lo, ph_hi; };

__device__ __forceinline__ float wave_sum(float v) {
#pragma unroll
    for (int o = 1; o < 64; o <<= 1) v += __shfl_xor(v, o);
    return v;
}
__device__ __forceinline__ float fexp2(float x) { return __builtin_amdgcn_exp2f(x); }
__device__ __forceinline__ float frcp(float x) { return __builtin_amdgcn_rcpf(x); }
__device__ __forceinline__ float sigm(float x) { return frcp(1.f + fexp2(-x * LOG2E)); }
__device__ __forceinline__ float gelu_tanh(float x) { const float u = 1.5957691216057308f * (x + 0.044715f * x * x * x); return x * sigm(u); }
__device__ __forceinline__ void sincos_rev(double revs, float& s, float& c) { const double fr = revs - __builtin_rint(revs); const float f = (float)fr; s = __builtin_amdgcn_sinf(f); c = __builtin_amdgcn_cosf(f); }
__device__ __forceinline__ float bf2f(unsigned short h) { return __builtin_bit_cast(float, (unsigned)h << 16); }
__device__ __forceinline__ float bflo(unsigned w) { return __builtin_bit_cast(float, w << 16); }
__device__ __forceinline__ float bfhi(unsigned w) { return __builtin_bit_cast(float, w & 0xffff0000u); }
__device__ __forceinline__ int batch_of(int row) { return row < MP ? 0 : 1 + ((row - MP) >> 12); }
__device__ __forceinline__ const float* xrow_ptr(const Args& a, int row) { return row < MP ? a.in[0] + (size_t)row * D : a.in[1] + (size_t)(row - MP) * D; }

struct SchedState {
    int c;
    __device__ bool next(int i, pg8::Unit& u) const { if (i > 0 || c >= 128) return false; u.pm = c; u.pn = c >> 2; return true; }
    __device__ __forceinline__ void a_ready(const pg8::Unit&) const {}
    __device__ __forceinline__ void done(const pg8::Unit&) const {}
};
struct SchedSsmOut {
    int c;
    __device__ bool next(int i, pg8::Unit& u) const { if (i > 0 || c >= 256) return false; const int g = c >> 3; u.pm = 4 * g + ((c >> 1) & 3); u.pn = 2 * g + (c & 1); return true; }
    __device__ __forceinline__ void a_ready(const pg8::Unit&) const {}
    __device__ __forceinline__ void done(const pg8::Unit&) const {}
};

#ifndef DUP_MASK
#define DUP_MASK 0
#endif
template <int DUP> struct DupOrder {
    pg8::StaticOrder S;
    __device__ bool next(int i, pg8::Unit& u) const { if (DUP == 2) { pg8::Unit t; int n = 0; while (S.next(n, t)) ++n; return i < 2 * n ? S.next(i % n, u) : false; } return S.next(DUP ? (i >> 1) : i, u); }
    __device__ __forceinline__ void a_ready(const pg8::Unit&) const {}
    __device__ __forceinline__ void done(const pg8::Unit&) const {}
};
struct SchedWoUp {
    int c; const unsigned* ready; int base, count;
    mutable int seen = -1;
    __device__ bool next(int i0, pg8::Unit& u) const {
        if (i0 >= count) return false;
        const int i = base + i0;
        const int x = c & 7, j = c >> 3, t = 1 + (x % 5), P0 = 16 * x;
        if (i == 0) { u.ty = 0; u.pm = P0 + (j & 7); u.pn = j >> 3; return true; }
        if (i == t) { u.ty = 0; u.pm = P0 + 8 + (j & 7); u.pn = j >> 3; return true; }
        u.ty = 1;
        if (i == 12) { if (j < 16) { u.pm = P0 + (j & 7); u.pn = 20 + (j >> 3); } else { u.pm = P0 + 8 + (j & 7); u.pn = 20 + ((j - 16) >> 3); } return true; }
        const int k = i - 1 - (i > t ? 1 : 0), half = k / 5, b = k % 5;
        u.pm = P0 + 8 * half + (j & 7); u.pn = 4 * b + (j >> 3); return true;
    }
    __device__ __forceinline__ void a_ready(const pg8::Unit& u) const {
        if (u.ty != 1 || u.pm == seen) return;
        seen = u.pm;
        if (threadIdx.x < 64) {
            unsigned sp = 0;
            while ((unsigned)__builtin_amdgcn_readfirstlane(__hip_atomic_load(ready + 64 * u.pm, __ATOMIC_RELAXED, __HIP_MEMORY_SCOPE_AGENT)) < 32u) { __builtin_amdgcn_s_sleep(2); if (++sp > (1u << 22)) break; }
            __builtin_amdgcn_fence(__ATOMIC_ACQUIRE, "agent");
            asm volatile("s_waitcnt vmcnt(0)" ::: "memory");
        }
        asm volatile("" ::: "memory"); __builtin_amdgcn_s_barrier(); asm volatile("" ::: "memory");
    }
    __device__ __forceinline__ void done(const pg8::Unit&) const {}
};
using pg8::f32x4; using pg8::u32x4; using pg8::cvt_pk_bf16;
#define EPI_ROWS(u, ai, m) ((u).pm * 256 + (ai) * 128 + wr * 64 + (m) * 16 + fr)
__device__ __forceinline__ u32x4 pack8(const f32x4& a, const f32x4& b) { u32x4 w; w.x = cvt_pk_bf16(a[0], a[1]); w.y = cvt_pk_bf16(a[2], a[3]); w.z = cvt_pk_bf16(b[0], b[1]); w.w = cvt_pk_bf16(b[2], b[3]); return w; }

struct EpiQKV {
    static constexpr bool PERM = true, AFTER_DRAIN = false;
    bf16 *Q, *K, *V, *U; const float *cosT, *sinT;
    __device__ __forceinline__ void operator()(const f32x4 (&acc)[2][2][4][2], const pg8::Unit& u, int wr, int wc, int fr, int fq) const {
        const int kind = u.pn >> 1, ph = u.pn & 1;
        if (kind < 2) {
            bf16* dst0 = kind == 0 ? Q : K; const float sc = kind == 0 ? QSCALE : 1.f;
            const int i0 = 16 * (wc & 1) + 4 * fq;
#pragma unroll
            for (int ai = 0; ai < 2; ++ai)
#pragma unroll
                for (int m = 0; m < 4; ++m) {
                    const int row = EPI_ROWS(u, ai, m); const int pos = row < MP ? row : ((row - MP) & (SS - 1));
                    const f32x4 cs = *(const f32x4*)(cosT + pos * 32 + i0), sn = *(const f32x4*)(sinT + pos * 32 + i0);
#pragma unroll
                    for (int bj = 0; bj < 2; ++bj) {
                        const int head = ph * 4 + bj * 2 + (wc >> 1);
                        const f32x4 x1 = acc[ai][bj][m][0], x2 = acc[ai][bj][m][1];
                        const f32x4 o1 = (x1 * cs - x2 * sn) * sc, o2 = (x2 * cs + x1 * sn) * sc;
                        bf16* d = dst0 + (size_t)row * 512 + head * 64 + i0;
                        v2u w1; w1.x = cvt_pk_bf16(o1[0], o1[1]); w1.y = cvt_pk_bf16(o1[2], o1[3]);
                        v2u w2; w2.x = cvt_pk_bf16(o2[0], o2[1]); w2.y = cvt_pk_bf16(o2[2], o2[3]);
                        *(v2u*)d = w1; *(v2u*)(d + 32) = w2;
                    }
                }
        } else {
#pragma unroll
            for (int ai = 0; ai < 2; ++ai)
#pragma unroll
                for (int m = 0; m < 4; ++m) {
                    const int row = EPI_ROWS(u, ai, m);
#pragma unroll
                    for (int bj = 0; bj < 2; ++bj) {
                        const int col = ph * 256 + bj * 128 + wc * 32 + 8 * fq;
                        const u32x4 w = pack8(acc[ai][bj][m][0], acc[ai][bj][m][1]);
                        if (kind == 2) *(u32x4*)(V + (size_t)row * 512 + col) = w;
                        else { const int g = col >> 4, c = col & 15; *(u32x4*)(U + ((size_t)(g * NCG + (row >> 5)) * UP + (row & 31) * 16 + c)) = w; }
                    }
                }
        }
    }
};
struct EpiState {
    static constexpr bool PERM = true, AFTER_DRAIN = false;
    float* S;
    __device__ __forceinline__ void operator()(const f32x4 (&acc)[2][2][4][2], const pg8::Unit& u, int wr, int wc, int fr, int fq) const {
        const int g = u.pn, mt = u.pm & 3;
#pragma unroll
        for (int ai = 0; ai < 2; ++ai)
#pragma unroll
            for (int m = 0; m < 4; ++m) {
                const int chunk = mt * 256 + ai * 128 + wr * 64 + m * 16 + fr;
#pragma unroll
                for (int bj = 0; bj < 2; ++bj) { float* p = S + ((size_t)(g * NCG + chunk) * 256 + bj * 128 + wc * 32 + 8 * fq); *(f32x4*)p = acc[ai][bj][m][0]; *(f32x4*)(p + 4) = acc[ai][bj][m][1]; }
            }
    }
};
struct EpiSsmOut {
    static constexpr bool PERM = true, AFTER_DRAIN = false;
    bf16* G;
    __device__ __forceinline__ void operator()(const f32x4 (&acc)[2][2][4][2], const pg8::Unit& u, int wr, int wc, int fr, int fq) const {
        const int g = u.pn >> 1, nt = u.pn & 1, mt = u.pm & 3;
#pragma unroll
        for (int ai = 0; ai < 2; ++ai)
#pragma unroll
            for (int m = 0; m < 4; ++m) {
                const int chunk = mt * 256 + ai * 128 + wr * 64 + m * 16 + fr;
#pragma unroll
                for (int bj = 0; bj < 2; ++bj) {
                    const int ncol = nt * 256 + bj * 128 + wc * 32 + 8 * fq, t = ncol >> 4, c0 = ncol & 15;
                    f32x4 a = acc[ai][bj][m][0], b = acc[ai][bj][m][1];
#pragma unroll
                    for (int e = 0; e < 4; ++e) { a[e] = gelu_tanh(a[e]); b[e] = gelu_tanh(b[e]); }
                    *(u32x4*)(G + (size_t)(chunk * TCH + t) * 512 + g * 16 + c0) = pack8(a, b);
                }
            }
    }
};
struct EpiGlu {
    static constexpr bool PERM = true, AFTER_DRAIN = false;
    const bf16* G; const float* bglu; bf16* O;
    __device__ __forceinline__ void operator()(const f32x4 (&acc)[2][2][4][2], const pg8::Unit& u, int wr, int wc, int fr, int fq) const {
#pragma unroll
        for (int bj = 0; bj < 2; ++bj) {
            const int col = u.pn * 256 + bj * 128 + wc * 32 + 8 * fq;
            const f32x4 b0 = *(const f32x4*)(bglu + col), b1 = *(const f32x4*)(bglu + col + 4);
#pragma unroll
            for (int ai = 0; ai < 2; ++ai)
#pragma unroll
                for (int m = 0; m < 4; ++m) {
                    const int row = EPI_ROWS(u, ai, m);
                    const u32x4 gv = *(const u32x4*)(G + (size_t)row * 512 + col);
                    const f32x4 z0 = acc[ai][bj][m][0] + b0, z1 = acc[ai][bj][m][1] + b1;
                    f32x4 o0, o1;
                    o0[0] = bflo(gv.x) * sigm(z0[0]); o0[1] = bfhi(gv.x) * sigm(z0[1]); o0[2] = bflo(gv.y) * sigm(z0[2]); o0[3] = bfhi(gv.y) * sigm(z0[3]);
                    o1[0] = bflo(gv.z) * sigm(z1[0]); o1[1] = bfhi(gv.z) * sigm(z1[1]); o1[2] = bflo(gv.w) * sigm(z1[2]); o1[3] = bfhi(gv.w) * sigm(z1[3]);
                    *(u32x4*)(O + (size_t)row * 512 + col) = pack8(o0, o1);
                }
        }
    }
};
struct EpiResid {
    static constexpr bool PERM = true, AFTER_DRAIN = false;
    const float* xp; const float* xs; float* out; const float* gate;
    int inplace;
    __device__ __forceinline__ void operator()(const f32x4 (&acc)[2][2][4][2], const pg8::Unit& u, int wr, int wc, int fr, int fq) const {
#pragma unroll
        for (int ai = 0; ai < 2; ++ai)
#pragma unroll
            for (int m = 0; m < 4; ++m) {
                const int row = EPI_ROWS(u, ai, m); const int b = batch_of(row);
                const float* base = inplace ? out + (size_t)row * D : (row < MP ? xp + (size_t)row * D : xs + (size_t)(row - MP) * D);
#pragma unroll
                for (int bj = 0; bj < 2; ++bj) {
                    const int col = u.pn * 256 + bj * 128 + wc * 32 + 8 * fq;
                    const f32x4 g0 = *(const f32x4*)(gate + b * NMOD + col), g1 = *(const f32x4*)(gate + b * NMOD + col + 4);
                    const f32x4 x0 = *(const f32x4*)(base + col), x1 = *(const f32x4*)(base + col + 4);
                    *(f32x4*)(out + (size_t)row * D + col) = x0 + g0 * acc[ai][bj][m][0];
                    *(f32x4*)(out + (size_t)row * D + col + 4) = x1 + g1 * acc[ai][bj][m][1];
                }
            }
    }
};
struct PB { const float* xp; const float* xs; float* out; unsigned char* ws; const float* p17; const float* p19; const float* p21; const float* p25; };
__device__ __forceinline__ PB load_pb(LAS unsigned char* lds) { asm volatile("" ::: "memory"); const LAS unsigned long long* p = (const LAS unsigned long long*)(lds + PARAM_OFF); PB r;
    r.xp = (const float*)p[0]; r.xs = (const float*)p[1]; r.out = (float*)p[2]; r.ws = (unsigned char*)p[3]; r.p17 = (const float*)p[4]; r.p19 = (const float*)p[5]; r.p21 = (const float*)p[6]; r.p25 = (const float*)p[7]; return r; }
template <int NTN, int BANK>
__device__ __forceinline__ void row_ssq_exchange(const f32x4 (&v)[2][2][4][2], const pg8::Unit& u, int wr, int wc, int fr, int fq, LAS unsigned char* ldsx, unsigned char* ws) {
    unsigned* xbuf = (unsigned*)(ws + WS_XBUF); unsigned* cnt = (unsigned*)(ws + WS_CTL) + CW_SEAM + BANK * SEAM_BANK + 64 * u.pm;
    int lane = threadIdx.x & 63; asm volatile("" : "+v"(lane)); const int wid = __builtin_amdgcn_readfirstlane(threadIdx.x >> 6);
    LAS float* P = (LAS float*)ldsx; LAS float* S = (LAS float*)(ldsx + 4096);
#pragma unroll
    for (int ai = 0; ai < 2; ++ai)
#pragma unroll
        for (int m = 0; m < 4; ++m) {
            float q = 0.f;
#pragma unroll
            for (int bj = 0; bj < 2; ++bj)
#pragma unroll
                for (int n = 0; n < 2; ++n) { const f32x4 x = v[ai][bj][m][n]; q += (x[0] * x[0] + x[1] * x[1]) + (x[2] * x[2] + x[3] * x[3]); }
            q += __shfl_xor(q, 16); q += __shfl_xor(q, 32);
            if (fq == 0) P[(ai * 128 + wr * 64 + m * 16 + fr) * 4 + wc] = q;
        }
    asm volatile("s_waitcnt lgkmcnt(0)" ::: "memory"); __builtin_amdgcn_s_barrier(); asm volatile("" ::: "memory");
    const int row = wid * 32 + (lane & 31);
    if (lane < 32) { const float t = (P[row * 4 + 0] + P[row * 4 + 1]) + (P[row * 4 + 2] + P[row * 4 + 3]);
        __hip_atomic_store(xbuf + ((size_t)(u.pm * 256 + row) * 4 + (u.pn & 3)), __float_as_uint(t), __ATOMIC_RELAXED, __HIP_MEMORY_SCOPE_AGENT); }
    asm volatile("s_waitcnt vmcnt(0)" ::: "memory");
    if (lane == 0) __hip_atomic_fetch_add(cnt, 1u, __ATOMIC_RELAXED, __HIP_MEMORY_SCOPE_AGENT);
    if (wid == 0) {
        unsigned sp = 0;
        while ((unsigned)__builtin_amdgcn_readfirstlane(__hip_atomic_load(cnt, __ATOMIC_RELAXED, __HIP_MEMORY_SCOPE_AGENT)) < 8u * NTN) { __builtin_amdgcn_s_sleep(2); if (++sp > (1u << 22)) break; }
        __builtin_amdgcn_fence(__ATOMIC_ACQUIRE, "agent");
    }
    asm volatile("s_waitcnt vmcnt(0) lgkmcnt(0)" ::: "memory"); __builtin_amdgcn_s_barrier(); asm volatile("" ::: "memory");
    if (lane < 32) { float t = 0.f;
#pragma unroll
        for (int k = 0; k < NTN; ++k) t += __uint_as_float(__hip_atomic_load(xbuf + ((size_t)(u.pm * 256 + row) * 4 + k), __ATOMIC_RELAXED, __HIP_MEMORY_SCOPE_AGENT));
        S[row] = __builtin_amdgcn_rsqf(t * (1.f / (256.f * NTN)) + EPS); }
    asm volatile("s_waitcnt lgkmcnt(0)" ::: "memory"); __builtin_amdgcn_s_barrier(); asm volatile("" ::: "memory");
}
struct EpiGluNorm {
    static constexpr bool PERM = true, AFTER_DRAIN = false;
    LAS unsigned char* lds;
    __device__ __forceinline__ void operator()(f32x4 (&acc)[2][2][4][2], const pg8::Unit& u, int wr, int wc, int fr, int fq) const {
        asm volatile("" : "+v"(fr), "+v"(fq));
        const PB pb = load_pb(lds); const bf16* G = (const bf16*)(pb.ws + WS_G); bf16* O = (bf16*)(pb.ws + WS_MIXA);
#pragma unroll
        for (int bj = 0; bj < 2; ++bj) {
            const int col = u.pn * 256 + bj * 128 + wc * 32 + 8 * fq;
            const f32x4 b0 = *(const f32x4*)(pb.p17 + col), b1 = *(const f32x4*)(pb.p17 + col + 4);
#pragma unroll
            for (int ai = 0; ai < 2; ++ai)
#pragma unroll
                for (int m = 0; m < 4; ++m) {
                    const int row = EPI_ROWS(u, ai, m);
                    const u32x4 gv = *(const u32x4*)(G + (size_t)row * 512 + col);
                    const f32x4 z0 = acc[ai][bj][m][0] + b0, z1 = acc[ai][bj][m][1] + b1;
                    f32x4 o0, o1;
                    o0[0] = bflo(gv.x) * sigm(z0[0]); o0[1] = bfhi(gv.x) * sigm(z0[1]); o0[2] = bflo(gv.y) * sigm(z0[2]); o0[3] = bfhi(gv.y) * sigm(z0[3]);
                    o1[0] = bflo(gv.z) * sigm(z1[0]); o1[1] = bfhi(gv.z) * sigm(z1[1]); o1[2] = bflo(gv.w) * sigm(z1[2]); o1[3] = bfhi(gv.w) * sigm(z1[3]);
                    acc[ai][bj][m][0] = o0; acc[ai][bj][m][1] = o1;
                    asm volatile("" : "+v"(acc[ai][bj][m][0]), "+v"(acc[ai][bj][m][1]));
                    if (m & 1) asm volatile("" ::: "memory");
                }
        }
        row_ssq_exchange<2, 0>(acc, u, wr, wc, fr, fq, lds + XLDS_OFF, pb.ws);
        const LAS float* S = (const LAS float*)(lds + XLDS_OFF + 4096);
#pragma unroll
        for (int bj = 0; bj < 2; ++bj) {
            const int col = u.pn * 256 + bj * 128 + wc * 32 + 8 * fq;
            const f32x4 g0 = *(const f32x4*)(pb.p19 + col), g1 = *(const f32x4*)(pb.p19 + col + 4);
#pragma unroll
            for (int ai = 0; ai < 2; ++ai)
#pragma unroll
                for (int m = 0; m < 4; ++m) {
                    const int rl = ai * 128 + wr * 64 + m * 16 + fr; const float rs = S[rl];
                    *(u32x4*)(O + (size_t)(u.pm * 256 + rl) * D + 512 + col) = pack8(acc[ai][bj][m][0] * rs * g0, acc[ai][bj][m][1] * rs * g1);
                }
        }
    }
};
struct EpiWoH2 {
    static constexpr bool PERM = true, AFTER_DRAIN = false;
    LAS unsigned char* lds;
    __device__ __forceinline__ void operator()(f32x4 (&acc)[2][2][4][2], const pg8::Unit& u, int wr, int wc, int fr, int fq) const {
        asm volatile("" : "+v"(fr), "+v"(fq));
        const PB pb = load_pb(lds);
        unsigned char* wsu = (unsigned char*)(((unsigned long long)(unsigned)__builtin_amdgcn_readfirstlane((int)((unsigned long long)pb.ws >> 32)) << 32) | (unsigned)__builtin_amdgcn_readfirstlane((int)(unsigned long long)pb.ws));
        const __amdgpu_buffer_rsrc_t h2r = __builtin_amdgcn_make_buffer_rsrc((void*)(wsu + WS_H2), (short)0, (int)((size_t)M * D * 2), 0x00020000);
        const int b = batch_of(u.pm * 256); const float* mb = (const float*)(pb.ws + WS_MODF) + b * NMOD;
#pragma unroll
        for (int bj = 0; bj < 2; ++bj) {
            const int col = u.pn * 256 + bj * 128 + wc * 32 + 8 * fq;
            const f32x4 g0 = *(const f32x4*)(mb + 2048 + col), g1 = *(const f32x4*)(mb + 2048 + col + 4);
#pragma unroll
            for (int ai = 0; ai < 2; ++ai)
#pragma unroll
                for (int m = 0; m < 4; ++m) {
                    const int row = EPI_ROWS(u, ai, m);
                    const float* base = (row < MP ? pb.xp + (size_t)row * D : pb.xs + (size_t)(row - MP) * D) + col;
                    const f32x4 x0 = *(const f32x4*)base, x1 = *(const f32x4*)(base + 4);
                    const f32x4 r0 = x0 + g0 * acc[ai][bj][m][0], r1 = x1 + g1 * acc[ai][bj][m][1];
                    acc[ai][bj][m][0] = r0; acc[ai][bj][m][1] = r1;
                    *(u32x4*)((unsigned char*)pb.out + (size_t)row * (D * 4) + 2048 + col * 2) = pack8(r0, r1);
                    if (ai == 1 && m == 3) asm volatile("" ::: "memory");
                }
        }
        row_ssq_exchange<4, 1>(acc, u, wr, wc, fr, fq, lds + XLDS_OFF, pb.ws);
        const LAS float* S = (const LAS float*)(lds + XLDS_OFF + 4096);
#pragma unroll
        for (int bj = 0; bj < 2; ++bj) {
            const int col = u.pn * 256 + bj * 128 + wc * 32 + 8 * fq;
            const f32x4 gm0 = *(const f32x4*)(pb.p21 + col) * (*(const f32x4*)(mb + 4096 + col) + 1.f), gm1 = *(const f32x4*)(pb.p21 + col + 4) * (*(const f32x4*)(mb + 4096 + col + 4) + 1.f);
            const f32x4 sh0 = *(const f32x4*)(mb + 3072 + col), sh1 = *(const f32x4*)(mb + 3072 + col + 4);
#pragma unroll
            for (int ai = 0; ai < 2; ++ai)
#pragma unroll
                for (int m = 0; m < 4; ++m) {
                    const int rl = ai * 128 + wr * 64 + m * 16 + fr; const float rs = S[rl];
                    __builtin_amdgcn_raw_buffer_store_b128(pack8(acc[ai][bj][m][0] * rs * gm0 + sh0, acc[ai][bj][m][1] * rs * gm1 + sh1), h2r, (int)(((size_t)(u.pm * 256 + rl) * D + col) * 2), 0, 16);
                }
        }
        asm volatile("s_waitcnt vmcnt(0)" ::: "memory");
        if ((threadIdx.x & 63) == 0) __hip_atomic_fetch_add((unsigned*)(pb.ws + WS_CTL) + CW_READY + 64 * u.pm, 1u, __ATOMIC_RELAXED, __HIP_MEMORY_SCOPE_AGENT);
    }
};
struct EpiDownFinal {
    static constexpr bool PERM = true, AFTER_DRAIN = false;
    LAS unsigned char* lds;
    __device__ __forceinline__ void operator()(f32x4 (&acc)[2][2][4][2], const pg8::Unit& u, int wr, int wc, int fr, int fq) const {
        asm volatile("" : "+v"(fr), "+v"(fq));
        const PB pb = load_pb(lds);
        const int b = batch_of(u.pm * 256); const float* mb = (const float*)(pb.ws + WS_MODF) + b * NMOD;
#if (DUP_MASK >> 12) & 3
        LAS int* vc = (LAS int*)(lds + XLDS_OFF + 5120); const int visit = *vc; const bool keep = ((DUP_MASK >> 13) & 1) ? (visit < 2) : ((visit & 1) == 0);
#else
        const bool keep = false;
#endif
#pragma unroll
        for (int bj = 0; bj < 2; ++bj) {
            const int col = u.pn * 256 + bj * 128 + wc * 32 + 8 * fq;
            const f32x4 g0 = *(const f32x4*)(mb + 5120 + col), g1 = *(const f32x4*)(mb + 5120 + col + 4);
#pragma unroll
            for (int ai = 0; ai < 2; ++ai)
#pragma unroll
                for (int m = 0; m < 4; ++m) {
                    const u32x4 xw = *(const u32x4*)((const unsigned char*)pb.out + (size_t)EPI_ROWS(u, ai, m) * (D * 4) + 2048 + col * 2);
                    const f32x4 x0 = {bflo(xw.x), bfhi(xw.x), bflo(xw.y), bfhi(xw.y)}, x1 = {bflo(xw.z), bfhi(xw.z), bflo(xw.w), bfhi(xw.w)};
                    acc[ai][bj][m][0] = x0 + g0 * acc[ai][bj][m][0]; acc[ai][bj][m][1] = x1 + g1 * acc[ai][bj][m][1];
                    asm volatile("" : "+v"(acc[ai][bj][m][0]), "+v"(acc[ai][bj][m][1]));
                    if (ai == 1 && m == 3) asm volatile("" ::: "memory");
                }
        }
        row_ssq_exchange<4, 2>(acc, u, wr, wc, fr, fq, lds + XLDS_OFF, pb.ws);
#if (DUP_MASK >> 12) & 3
        if (threadIdx.x == 0) *vc = visit + 1;
#endif
        const LAS float* S = (const LAS float*)(lds + XLDS_OFF + 4096);
        asm volatile("" : "+v"(fr), "+v"(fq));
        if (!keep) {
#pragma unroll
        for (int bj = 0; bj < 2; ++bj) {
            const int col = u.pn * 256 + bj * 128 + wc * 32 + 8 * fq;
            const f32x4 f0 = *(const f32x4*)(pb.p25 + col), f1 = *(const f32x4*)(pb.p25 + col + 4);
#pragma unroll
            for (int ai = 0; ai < 2; ++ai)
#pragma unroll
                for (int m = 0; m < 4; ++m) {
                    const int rl = ai * 128 + wr * 64 + m * 16 + fr; const float rs = S[rl];
                    float* o = pb.out + (size_t)(u.pm * 256 + rl) * D + col;
                    *(f32x4*)o = acc[ai][bj][m][0] * rs * f0; *(f32x4*)(o + 4) = acc[ai][bj][m][1] * rs * f1;
                }
        }
        }
    }
};

struct EpiWoUp {
    static constexpr bool PERM = true, AFTER_DRAIN = false;
    LAS unsigned char* lds;
    __device__ __forceinline__ void operator()(f32x4 (&acc)[2][2][4][2], const pg8::Unit& u, int wr, int wc, int fr, int fq) const {
        if (u.ty == 0) { EpiWoH2 E{lds}; E(acc, u, wr, wc, fr, fq); return; }
        asm volatile("" : "+v"(fr), "+v"(fq));
        const PB pb = load_pb(lds); bf16* O = (bf16*)(pb.ws + WS_ACT);
        const int j0 = u.pn * 128 + wc * 32 + 8 * fq;
#pragma unroll
        for (int ai = 0; ai < 2; ++ai)
#pragma unroll
            for (int m = 0; m < 4; ++m) {
                const int row = EPI_ROWS(u, ai, m);
                f32x4 o0, o1;
#pragma unroll
                for (int e = 0; e < 4; ++e) { const float a0 = acc[ai][0][m][0][e], a1 = acc[ai][0][m][1][e]; o0[e] = a0 * sigm(a0) * acc[ai][1][m][0][e]; o1[e] = a1 * sigm(a1) * acc[ai][1][m][1][e]; }
                *(u32x4*)(O + (size_t)row * FF + j0) = pack8(o0, o1);
            }
    }
};

template <class Map>
__device__ __forceinline__ void transpose_item(const float* W, int K, int N, bf16* WT, LAS float* scr, int item, int lane, Map map) {
    const int nblk = N / 32, kb = item / nblk, nb = item % nblk, k0 = 64 * kb, n0 = 32 * nb;
#pragma unroll 8
    for (int i = 0; i < 32; ++i) { const int kk = 2 * i + (lane >> 5); scr[kk * 33 + (lane & 31)] = W[(size_t)(k0 + kk) * N + n0 + (lane & 31)]; }
    LDS_WAIT(); asm volatile("" ::: "memory");
    const int c = lane & 7;
#pragma unroll
    for (int j = 0; j < 4; ++j) { const int n = (lane >> 3) + 8 * j; const LAS float* s = scr + (8 * c) * 33 + n;
        v4u o; o.x = pk2(s[0 * 33], s[1 * 33]); o.y = pk2(s[2 * 33], s[3 * 33]); o.z = pk2(s[4 * 33], s[5 * 33]); o.w = pk2(s[6 * 33], s[7 * 33]);
        *(GAS v4u*)(WT + (size_t)map(n0 + n) * K + k0 + 8 * c) = o; }
    LDS_WAIT(); asm volatile("" ::: "memory");
}
struct MapId { __device__ __forceinline__ int operator()(int n) const { return n; } };
struct MapWin { __device__ __forceinline__ int operator()(int n) const { if (n >= 1024) return n; const int d = n & 63; return (n & ~63) + ((d >> 2) & 7) * 8 + (d >> 5) * 4 + (d & 3); } };
struct MapW13 { int off; __device__ __forceinline__ int operator()(int j) const { return 256 * (j >> 7) + off + (j & 127); } };

template <int R>
__device__ __forceinline__ void norm_rows_lds(const float* const (&xrow)[R], bf16* const (&orow)[R], const LAS float* Gm, const LAS float* Sh, int lane) {
    f32x4 v[R][4];
#pragma unroll
    for (int r = 0; r < R; ++r)
#pragma unroll
        for (int j = 0; j < 4; ++j) v[r][j] = ((const GAS f32x4*)xrow[r] + lane)[64 * j];
#pragma unroll
    for (int r = 0; r < R; ++r) {
        float s = 0.f;
#pragma unroll
        for (int j = 0; j < 4; ++j) s += (v[r][j].x * v[r][j].x + v[r][j].y * v[r][j].y) + (v[r][j].z * v[r][j].z + v[r][j].w * v[r][j].w);
        const float rstd = __builtin_amdgcn_rsqf(wave_sum(s) * (1.f / D) + EPS);
        GAS v2u* o8 = (GAS v2u*)orow[r] + lane;
#pragma unroll
        for (int j = 0; j < 4; ++j) { const f32x4 gm = *(const LAS f32x4*)(Gm + 256 * j + 4 * lane), sh = *(const LAS f32x4*)(Sh + 256 * j + 4 * lane);
            const f32x4 h = v[r][j] * rstd * gm + sh; v2u w; w.x = pk2(h.x, h.y); w.y = pk2(h.z, h.w); o8[64 * j] = w; }
    }
}

__device__ __forceinline__ void cpow_tab(const float* ldre, const double* theta, int bi, int e, float& pre, float& pim) {
    const float mag = fexp2((float)e * ldre[bi] * LOG2E); float s, c; sincos_rev((double)e * theta[bi], s, c); pre = mag * c; pim = mag * s;
}

__device__ __forceinline__ float xmax16_32(float m) {
    auto r = __builtin_amdgcn_permlane16_swap(__float_as_uint(m), __float_as_uint(m), false, false); m = fmaxf(__uint_as_float(r[0]), __uint_as_float(r[1]));
    auto q = __builtin_amdgcn_permlane32_swap(__float_as_uint(m), __float_as_uint(m), false, false); return fmaxf(__uint_as_float(q[0]), __uint_as_float(q[1])); }
__device__ __forceinline__ float xsum16_32(float m) {
    auto r = __builtin_amdgcn_permlane16_swap(__float_as_uint(m), __float_as_uint(m), false, false); m = __uint_as_float(r[0]) + __uint_as_float(r[1]);
    auto q = __builtin_amdgcn_permlane32_swap(__float_as_uint(m), __float_as_uint(m), false, false); return __uint_as_float(q[0]) + __uint_as_float(q[1]); }
namespace att {
constexpr int NITEMS = 3 * 8 * 256, VOFF = 32768, BUFB = 65536;
struct Item { int br, h, seq_base, ldil, r, kblk, nidx, cont; };
__device__ __forceinline__ Item decode(int hs, int pos) {
    Item I; const int bh = hs >> 6, L = (hs & 63) * 4 + pos; I.br = bh >> 3; I.h = bh & 7; I.ldil = 2 * I.br;
    int S, li;
    if (L < 128) { I.seq_base = 0; S = MP; li = L; } else { const int si = (L - 128) >> 5; I.seq_base = MP + SS * si; S = SS; li = (L - 128) & 31; }
    const int lnb = (S == MP ? 7 : 5) - I.ldil;
    I.r = li >> lnb; I.kblk = li & ((1 << lnb) - 1); I.nidx = S >> I.ldil; I.cont = (pos > 0 && I.kblk > 0) ? 1 : 0; return I;
}
__device__ __forceinline__ void glds16(const void* gsrc, unsigned lds_dst) { unsigned keep;
    asm volatile("s_mov_b32 %0, m0\n\ts_mov_b32 m0, %2\n\ts_nop 0\n\tglobal_load_lds_dwordx4 %1, off\n\ts_mov_b32 m0, %0" : "=&s"(keep) : "v"(gsrc), "s"(lds_dst) : "memory"); }
template <bool HALF>
__device__ __forceinline__ void stage(LAS unsigned char* buf, const bf16* K, const bf16* V, const Item& I, int wave, int lane) {
    const unsigned lbase = (unsigned)__builtin_amdgcn_readfirstlane((int)(unsigned)(uintptr_t)buf);
    const int rsub = lane >> 3, c16 = lane & 7, kbase = 128 * I.kblk - 64;
    if (kbase >= 0 && kbase + 256 <= I.nidx) {
        const size_t tok0 = (size_t)I.seq_base + I.r + ((size_t)(kbase + 8 * wave + rsub) << I.ldil);
        const bf16* k0 = K + tok0 * 512 + I.h * 64 + ((c16 ^ rsub) << 3);
        const bf16* v0 = V + tok0 * 512 + I.h * 64 + ((c16 ^ (((rsub >> 1) & 3) << 1)) << 3);
        const size_t st = (size_t)65536 << I.ldil;
        const char* k1 = (const char*)k0 + st; const char* k2 = k1 + st; const char* k3 = k2 + st;
        const char* v1 = (const char*)v0 + st; const char* v2 = v1 + st; const char* v3 = v2 + st;
        unsigned keep;
        if (HALF)
            asm volatile("s_mov_b32 %0, m0\n\ts_mov_b32 m0, %5\n\ts_nop 0\n\tglobal_load_lds_dwordx4 %1, off\n\t"
                         "s_add_u32 m0, m0, 0x8000\n\ts_nop 0\n\tglobal_load_lds_dwordx4 %3, off\n\t"
                         "s_sub_u32 m0, m0, 0x6000\n\ts_nop 0\n\tglobal_load_lds_dwordx4 %2, off\n\t"
                         "s_add_u32 m0, m0, 0x8000\n\ts_nop 0\n\tglobal_load_lds_dwordx4 %4, off\n\t"
                         "s_mov_b32 m0, %0"
                         : "=&s"(keep) : "v"(k2), "v"(k3), "v"(v2), "v"(v3), "s"(lbase + wave * 1024 + 16384) : "memory", "scc");
        else
            asm volatile("s_mov_b32 %0, m0\n\ts_mov_b32 m0, %9\n\ts_nop 0\n\tglobal_load_lds_dwordx4 %1, off\n\t"
                         "s_add_u32 m0, m0, 0x8000\n\ts_nop 0\n\tglobal_load_lds_dwordx4 %5, off\n\t"
                         "s_sub_u32 m0, m0, 0x6000\n\ts_nop 0\n\tglobal_load_lds_dwordx4 %2, off\n\t"
                         "s_add_u32 m0, m0, 0x8000\n\ts_nop 0\n\tglobal_load_lds_dwordx4 %6, off\n\t"
                         "s_sub_u32 m0, m0, 0x6000\n\ts_nop 0\n\tglobal_load_lds_dwordx4 %3, off\n\t"
                         "s_add_u32 m0, m0, 0x8000\n\ts_nop 0\n\tglobal_load_lds_dwordx4 %7, off\n\t"
                         "s_sub_u32 m0, m0, 0x6000\n\ts_nop 0\n\tglobal_load_lds_dwordx4 %4, off\n\t"
                         "s_add_u32 m0, m0, 0x8000\n\ts_nop 0\n\tglobal_load_lds_dwordx4 %8, off\n\t"
                         "s_mov_b32 m0, %0"
                         : "=&s"(keep) : "v"(k0), "v"(k1), "v"(k2), "v"(k3), "v"(v0), "v"(v1), "v"(v2), "v"(v3), "s"(lbase + wave * 1024) : "memory", "scc");
        return;
    }
#pragma unroll
    for (int i = (HALF ? 2 : 0); i < 4; ++i) {
        const int p = wave + 8 * i, row = 8 * p + rsub; int kidx = kbase + row; kidx = kidx < 0 ? 0 : (kidx >= I.nidx ? I.nidx - 1 : kidx);
        const size_t tok = (size_t)I.seq_base + I.r + ((size_t)kidx << I.ldil);
        glds16(K + tok * 512 + I.h * 64 + ((c16 ^ (row & 7)) << 3), lbase + p * 1024);
        glds16(V + tok * 512 + I.h * 64 + ((c16 ^ (((row >> 1) & 3) << 1)) << 3), lbase + VOFF + p * 1024);
    }
}
__device__ __forceinline__ void slide(LAS unsigned char* dst, const LAS unsigned char* src, int wave, int lane) {
#pragma unroll
    for (int i = 0; i < 2; ++i) { const int o = (wave + 8 * i) * 1024 + lane * 16;
        const u32x4 a = *(const LAS u32x4*)(src + 16384 + o), b = *(const LAS u32x4*)(src + VOFF + 16384 + o);
        *(LAS u32x4*)(dst + o) = a; *(LAS u32x4*)(dst + VOFF + o) = b; }
}
__device__ __forceinline__ size_t q_token(const Item& I, int wave, int lane) { return (size_t)I.seq_base + I.r + ((size_t)(128 * I.kblk + 16 * wave + (lane & 15)) << I.ldil); }
struct Out { v2u w[4]; float lse; bf16* od; float* lp; };
__device__ __forceinline__ void store_out(const Out& o, int lane) {
#pragma unroll
    for (int dt = 0; dt < 4; ++dt) *(v2u*)(o.od + 16 * dt) = o.w[dt];
    if ((lane >> 4) == 0) *o.lp = o.lse;
}
__device__ __forceinline__ void compute(LAS unsigned char* buf, const Item& I, const bf16x8 (&qf)[2], size_t qtok, bf16* Ob, float* Lse, int wave, int lane, Out& out) {
    const int qi = lane & 15, g4 = lane >> 4, kbase = 128 * I.kblk - 64;
    const LAS unsigned char* kp0 = buf + (16 * wave + qi) * 128 + ((g4 ^ (qi & 7)) << 4);
    const LAS unsigned char* kp1 = buf + (16 * wave + qi) * 128 + (((4 + g4) ^ (qi & 7)) << 4);
    bf16x8 kf0[9], kf1[9];
#pragma unroll
    for (int kt = 0; kt < 9; ++kt) { kf0[kt] = *(const LAS bf16x8*)(kp0 + kt * 2048); kf1[kt] = *(const LAS bf16x8*)(kp1 + kt * 2048); }
    __builtin_amdgcn_sched_barrier(0);
    f32x4 sc[9];
    __builtin_amdgcn_s_setprio(1);
#pragma unroll
    for (int kt = 0; kt < 9; ++kt) sc[kt] = __builtin_amdgcn_mfma_f32_16x16x32_bf16(kf0[kt], qf[0], (f32x4){0.f, 0.f, 0.f, 0.f}, 0, 0, 0);
#pragma unroll
    for (int kt = 0; kt < 9; ++kt) sc[kt] = __builtin_amdgcn_mfma_f32_16x16x32_bf16(kf1[kt], qf[1], sc[kt], 0, 0, 0);
    __builtin_amdgcn_s_setprio(0);
    __builtin_amdgcn_sched_barrier(0);
    const int il = lane & 15, q_ = il >> 2, p_ = il & 3, rr = 4 * g4 + q_, sw = (rr >> 1) & 3;
    const LAS unsigned char* vb = buf + VOFF + (16 * wave + rr) * 128 + p_ * 8;
    v4i16_t vlo[5][4], vhi[5][4];
#pragma unroll
    for (int ks = 0; ks < 5; ++ks) {
        const int hioff = (ks == 4 && wave == 7) ? 0 : 2048;
        if (ks > 0) asm volatile("s_waitcnt lgkmcnt(7)" ::: "memory");
#pragma unroll
        for (int dt = 0; dt < 4; ++dt) {
            vlo[ks][dt] = __builtin_amdgcn_ds_read_tr16_b64_v4i16((LAS v4i16_t*)(vb + ks * 4096 + ((dt ^ sw) << 5)));
            vhi[ks][dt] = __builtin_amdgcn_ds_read_tr16_b64_v4i16((LAS v4i16_t*)(vb + ks * 4096 + hioff + ((dt ^ sw) << 5)));
        }
    }
    __builtin_amdgcn_sched_barrier(0);
#pragma unroll
    for (int e = 0; e < 4; ++e) { const int jj = 4 * g4 + e; if (jj < qi) sc[0][e] = -INFINITY; if (jj > qi) sc[8][e] = -INFINITY; }
    if (kbase < 0 || kbase + 256 > I.nidx) {
#pragma unroll
        for (int kt = 0; kt < 9; ++kt)
#pragma unroll
            for (int e = 0; e < 4; ++e) { const int kidx = kbase + 16 * (wave + kt) + 4 * g4 + e; if ((unsigned)kidx >= (unsigned)I.nidx) sc[kt][e] = -INFINITY; }
    }
    float mx = sc[0][0];
#pragma unroll
    for (int kt = 0; kt < 9; ++kt)
#pragma unroll
        for (int e = 0; e < 4; ++e) mx = fmaxf(mx, sc[kt][e]);
    mx = xmax16_32(mx);
    bf16x8 pf[5]; float lsv = 0.f;
#pragma unroll
    for (int ks = 0; ks < 5; ++ks) {
        f32x4 pa, pb;
#pragma unroll
        for (int e = 0; e < 4; ++e) { pa[e] = fexp2(sc[2 * ks][e] - mx); pb[e] = (ks < 4) ? fexp2(sc[2 * ks + 1][e] - mx) : 0.f; }
#pragma unroll
        for (int e = 0; e < 4; ++e) lsv += pa[e] + pb[e];
        pf[ks] = __builtin_bit_cast(bf16x8, pack8(pa, pb));
    }
    __builtin_amdgcn_sched_barrier(0);
    f32x4 o[4];
#pragma unroll
    for (int dt = 0; dt < 4; ++dt) o[dt] = (f32x4){0.f, 0.f, 0.f, 0.f};
    __builtin_amdgcn_s_setprio(1);
#pragma unroll
    for (int ks = 0; ks < 5; ++ks) {
#pragma unroll
        for (int dt = 0; dt < 4; ++dt) {
            const bf16x8 vf = (bf16x8){vlo[ks][dt][0], vlo[ks][dt][1], vlo[ks][dt][2], vlo[ks][dt][3], vhi[ks][dt][0], vhi[ks][dt][1], vhi[ks][dt][2], vhi[ks][dt][3]};
            o[dt] = __builtin_amdgcn_mfma_f32_16x16x32_bf16(vf, pf[ks], o[dt], 0, 0, 0);
        }
    }
    __builtin_amdgcn_s_setprio(0);
    const float ls = xsum16_32(lsv);
    const float inv = frcp(ls);
    out.od = Ob + ((size_t)I.br * M + qtok) * 512 + I.h * 64 + 4 * g4; out.lp = Lse + ((size_t)I.br * M + qtok) * 8 + I.h;
#pragma unroll
    for (int dt = 0; dt < 4; ++dt) { out.w[dt].x = cvt_pk_bf16(o[dt][0] * inv, o[dt][1] * inv); out.w[dt].y = cvt_pk_bf16(o[dt][2] * inv, o[dt][3] * inv); }
    out.lse = (mx + __builtin_amdgcn_logf(ls)) * LN2F;
}
__device__ __forceinline__ int run_of(int bx, int G, int k) {
    if (G != 256) { const int hs = bx + k * G; return hs < 1536 ? hs : 1536; }
    if (bx < 128) return k < 5 ? bx + 128 * k : 1536;
    return k < 7 ? 640 + (bx - 128) + 128 * k : 1536;
}
__device__ __forceinline__ void phase(LAS unsigned char* ring, const bf16* Q, const bf16* K, const bf16* V, bf16* Ob, float* Lse, int bx, int G, int wave, int lane) {
    int i = 0, hsc = run_of(bx, G, 0), hsn = hsc;
    bf16x8 qc[2], qn[2]; size_t tokc = 0, tokn = 0;
    qc[0] = qc[1] = qn[0] = qn[1] = (bf16x8){0, 0, 0, 0, 0, 0, 0, 0};
    if (hsc < 1536) { const Item I = decode(hsc, 0); stage<false>(ring, K, V, I, wave, lane); tokc = q_token(I, wave, lane);
        qc[0] = *(const bf16x8*)(Q + tokc * 512 + I.h * 64 + 8 * (lane >> 4)); qc[1] = *(const bf16x8*)(Q + tokc * 512 + I.h * 64 + 32 + 8 * (lane >> 4)); }
    asm volatile("s_waitcnt vmcnt(0)" : "+v"(qc[0]), "+v"(qc[1]) :: "memory"); __builtin_amdgcn_s_barrier(); asm volatile("" ::: "memory");
    int b = 0; Out po; bool have = false;
    po.od = nullptr; po.lp = nullptr; po.lse = 0.f; po.w[0] = po.w[1] = po.w[2] = po.w[3] = (v2u){0u, 0u};
    while (hsc < 1536) {
        if (have) store_out(po, lane);
        const int in = i + 1; hsn = run_of(bx, G, in >> 2);
        if (hsn < 1536) { const Item In = decode(hsn, in & 3);
            if (In.cont) { slide(ring + (b ^ 1) * BUFB, ring + b * BUFB, wave, lane); stage<true>(ring + (b ^ 1) * BUFB, K, V, In, wave, lane); }
            else stage<false>(ring + (b ^ 1) * BUFB, K, V, In, wave, lane);
            tokn = q_token(In, wave, lane);
            qn[0] = *(const bf16x8*)(Q + tokn * 512 + In.h * 64 + 8 * (lane >> 4)); qn[1] = *(const bf16x8*)(Q + tokn * 512 + In.h * 64 + 32 + 8 * (lane >> 4)); }
        { const Item I = decode(hsc, i & 3); compute(ring + b * BUFB, I, qc, tokc, Ob, Lse, wave, lane, po); have = true; }
        asm volatile("s_waitcnt vmcnt(0) lgkmcnt(0)" : "+v"(qn[0]), "+v"(qn[1]) :: "memory"); __builtin_amdgcn_s_barrier(); asm volatile("" ::: "memory");
        i = in; hsc = hsn; qc[0] = qn[0]; qc[1] = qn[1]; tokc = tokn; b ^= 1;
    }
    if (have) store_out(po, lane);
    __syncthreads();
}
}

__global__ void __launch_bounds__(NWAVES * 64, 2) mk_fwd(Args args) {
    extern __shared__ __attribute__((aligned(16))) unsigned char lds_raw[];
    LAS unsigned char* lds = (LAS unsigned char*)lds_raw;
    volatile LAS unsigned* MISC = (volatile LAS unsigned*)(lds + MISC_OFF);
    const int tid = threadIdx.x, lane = tid & 63, wave = __builtin_amdgcn_readfirstlane(tid >> 6);
    const int G = gridDim.x, bx = blockIdx.x;
    const int vcu = (G % 8 == 0) ? (bx % 8) * (G / 8) + bx / 8 : bx;
    const int gw = vcu * NWAVES + wave, NGW = G * NWAVES;
    const int gtid = gw * 64 + lane, NT = NGW * 64;
    unsigned char* ws = args.ws;
    gu32* ctl = (gu32*)(ws + WS_CTL);
    for (int u = tid; u < (LDS_BYTES - LDSCTL_OFF) / 4; u += NWAVES * 64) ((LAS unsigned*)(lds + LDSCTL_OFF))[u] = 0u;
    __syncthreads();
    if (tid == 0) { LAS unsigned long long* p = (LAS unsigned long long*)(lds + PARAM_OFF); p[0] = (unsigned long long)args.in[0]; p[1] = (unsigned long long)args.in[1]; p[2] = (unsigned long long)args.out; p[3] = (unsigned long long)args.ws;
        p[4] = (unsigned long long)args.in[17]; p[5] = (unsigned long long)args.in[19]; p[6] = (unsigned long long)args.in[21]; p[7] = (unsigned long long)args.in[25]; }
    __syncthreads();
    XcdBarrier bar; bar.bar = (unsigned*)(ctl + CW_BAR); bar.x = 0; bar.st = nullptr;
    if (MK_N_LAUNCHES == 1) bar = xcd_barrier_post((unsigned*)(ctl + CW_BAR), MISC + 8);
    const int lo = args.ph_lo, hi = args.ph_hi;
#ifndef REP_MASK
#define REP_MASK 0
#endif
#define IN(k) (lo <= (k) && (k) < hi)
#define REPS(k) (1 + ((REP_MASK >> (k)) & 1))
#ifndef TIME_PHASE
#define TIME_PHASE -1
#endif
    unsigned long long tp0 = (TIME_PHASE >= 0) ? __builtin_amdgcn_s_memrealtime() : 0ull;
#define SEAM(k) do { if (IN(k) && IN((k) + 1)) { \
        xcd_barrier(bar); \
        if (TIME_PHASE >= 0 && bx == 0 && tid == 0) { unsigned long long t1 = __builtin_amdgcn_s_memrealtime(); \
            if ((k) == TIME_PHASE) { const unsigned long long dt = t1 - tp0; while (__builtin_amdgcn_s_memrealtime() - t1 < 9ull * dt) __builtin_amdgcn_s_sleep(8); t1 = __builtin_amdgcn_s_memrealtime(); } \
            tp0 = t1; } } } while (0)

    float* modf = (float*)(ws + WS_MODF); float* modp = (float*)(ws + WS_MODP);
    float* t_ldre = (float*)(ws + WS_LDRE); float* t_zre = (float*)(ws + WS_ZRE); float* t_zim = (float*)(ws + WS_ZIM); float* t_atre = (float*)(ws + WS_ATRE); float* t_atim = (float*)(ws + WS_ATIM); double* t_theta = (double*)(ws + WS_THETA);
    bf16* W13T = (bf16*)(ws + WS_W13); bf16* WinT = (bf16*)(ws + WS_WIN); bf16* WgluT = (bf16*)(ws + WS_WGLU); bf16* WoT = (bf16*)(ws + WS_WO); bf16* W2T = (bf16*)(ws + WS_W2);
    bf16* Ptab = (bf16*)(ws + WS_PTAB); float* Sbuf = (float*)(ws + WS_SBUF); bf16* Klag = (bf16*)(ws + WS_KLAG); bf16* Toep = (bf16*)(ws + WS_TOEP);
    float* cosT = (float*)(ws + WS_ROPE); float* sinT = cosT + 16384 * 32;
    bf16* Ub = (bf16*)(ws + WS_U); bf16* Qb = (bf16*)(ws + WS_Q); bf16* Kb = (bf16*)(ws + WS_K); bf16* Vb = (bf16*)(ws + WS_V);
    bf16* Gb = (bf16*)(ws + WS_G); bf16* SsmRaw = (bf16*)(ws + WS_SSMRAW); bf16* MixA = (bf16*)(ws + WS_MIXA); bf16* H2 = (bf16*)(ws + WS_H2); bf16* Act = (bf16*)(ws + WS_ACT);
    bf16* H1 = (bf16*)((unsigned char*)args.out + DO_H1); bf16* Ob = (bf16*)((unsigned char*)args.out + DO_OB); float* Lse = (float*)((unsigned char*)args.out + DO_LSE);
    LAS float* scr = (LAS float*)(lds + RING_OFF + wave * 16384);

    if (IN(0)) for (int rep_ = 0; rep_ < REPS(0); ++rep_) {
        constexpr int I_IN = 16 * 64, I_GLU = 8 * 16, I_O = 16 * 32, I_1 = 16 * 88;
        constexpr int NITEMS = I_IN + I_GLU + I_O + 2 * I_1;
#ifndef P0_PROBE
#define P0_PROBE 0
#endif
        for (int p0r = 0; p0r < 1 + (P0_PROBE & 1); ++p0r)
        for (int it = gw; it < NITEMS; it += NGW) {
            int r = it;
            if (r < I_IN) { transpose_item(args.in[7], D, NPROJ, WinT, scr, r, lane, MapWin{}); continue; } r -= I_IN;
            if (r < I_GLU) { transpose_item(args.in[16], 512, 512, WgluT, scr, r, lane, MapId{}); continue; } r -= I_GLU;
            if (r < I_O) { transpose_item(args.in[20], D, D, WoT, scr, r, lane, MapId{}); continue; } r -= I_O;
            if (r < I_1) { transpose_item(args.in[22], D, FF, W13T, scr, r, lane, MapW13{0}); continue; } r -= I_1;
            transpose_item(args.in[23], D, FF, W13T, scr, r, lane, MapW13{128});
        }
        {
            LAS float* sl = (LAS float*)(lds + RING_OFF);
            LAS f32x2v* red2 = (LAS f32x2v*)(lds + RING_OFF + 20480);
            __syncthreads();
            for (int i = tid; i < 5 * 1024; i += NWAVES * 64) { const float cv = i < 1024 ? args.in[2][i] : args.in[3][i - 1024]; sl[i] = cv * sigm(cv); }
            __syncthreads();
            for (int p0r = 0; p0r < 1 + ((P0_PROBE >> 1) & 1); ++p0r)
            for (int task = vcu; task < 48 * 16; task += G) {
                const int cb = task % 48, ks = task / 48, n = 128 * cb + 2 * lane, k0 = 64 * ks + 8 * wave;
                const float* W = args.in[4] + (size_t)k0 * NMOD + n;
                f32x2v w[8];
#pragma unroll
                for (int i = 0; i < 8; ++i) w[i] = *(const f32x2v*)(W + (size_t)i * NMOD);
                f32x2v a0 = {0.f, 0.f}, a1 = a0, a2 = a0, a3 = a0, a4 = a0;
#pragma unroll
                for (int i = 0; i < 8; ++i) { const int k = k0 + i; a0 += w[i] * sl[k]; a1 += w[i] * sl[1024 + k]; a2 += w[i] * sl[2048 + k]; a3 += w[i] * sl[3072 + k]; a4 += w[i] * sl[4096 + k]; }
                __syncthreads();
                red2[(wave * 5 + 0) * 64 + lane] = a0; red2[(wave * 5 + 1) * 64 + lane] = a1; red2[(wave * 5 + 2) * 64 + lane] = a2; red2[(wave * 5 + 3) * 64 + lane] = a3; red2[(wave * 5 + 4) * 64 + lane] = a4;
                __syncthreads();
                if (wave < 5) { f32x2v t = red2[(0 * 5 + wave) * 64 + lane];
#pragma unroll
                    for (int v = 1; v < 8; ++v) t += red2[(v * 5 + wave) * 64 + lane];
                    *(f32x2v*)(modp + (size_t)(ks * 5 + wave) * NMOD + n) = t; }
            }
            __syncthreads();
        }
        for (int p0r = 0; p0r < 1 + ((P0_PROBE >> 2) & 1); ++p0r)
        for (int idx = gtid; idx < 16384 * 32; idx += NT) { const int pos = idx >> 5, i = idx & 31;
            const float inv = fexp2(-(float)i * 0.41524101186092033f); const float ang = (float)pos * inv; float s, c; sincos_rev((double)ang * INV_2PI, s, c); cosT[idx] = c; sinT[idx] = s; }
        for (int idx = gtid; idx < 4096; idx += NT) {
            const float dt = fexp2(args.in[10][idx >> 6] * LOG2E), lr = args.in[8][idx], li = args.in[9][idx];
            const float ldre = lr * dt; const double th = (double)li * (double)dt * INV_2PI;
            float s, c; sincos_rev(th, s, c); const float mag = fexp2(ldre * LOG2E), are = mag * c, aim = mag * s;
            const float nr = are - 1.f, den = lr * lr + li * li;
            t_ldre[idx] = ldre; t_theta[idx] = th; t_zre[idx] = (nr * lr + aim * li) / den; t_zim[idx] = (aim * lr - nr * li) / den;
            float sT, cT; sincos_rev((double)TCH * th, sT, cT); const float mT = fexp2((float)TCH * ldre * LOG2E); t_atre[idx] = mT * cT; t_atim[idx] = mT * sT;
        }
    }
    SEAM(0);

    if (IN(1)) for (int rep_ = 0; rep_ < REPS(1); ++rep_) {
        for (int e = gtid; e < 5 * NMOD; e += NT) { const int b = e / NMOD, n = e % NMOD; float v = args.in[5][n];
#pragma unroll
            for (int ks = 0; ks < 16; ++ks) v += modp[(size_t)(ks * 5 + b) * NMOD + n];
            modf[e] = v; }
#pragma unroll 1
        for (int step = 0; step < 2; ++step) {
        if ((step == 0) == ((bx & 1) == 0)) {
        LAS float* Gm = (LAS float*)(lds + RING_OFF + 65536); LAS float* Sh = Gm + 1024;
        for (int rb = vcu; rb < M / 128; rb += G) {
            const int row0 = rb * 128, b = batch_of(row0);
            __syncthreads();
            for (int k = tid; k < 1024; k += NWAVES * 64) { float sc = args.in[5][1024 + k], sh = args.in[5][k];
#pragma unroll
                for (int ks = 0; ks < 16; ++ks) { sc += modp[(size_t)(ks * 5 + b) * NMOD + 1024 + k]; sh += modp[(size_t)(ks * 5 + b) * NMOD + k]; }
                Gm[k] = args.in[6][k] * (1.f + sc); Sh[k] = sh; }
            __syncthreads();
            for (int i = 0; i < 16; i += 8) { const int row = row0 + wave * 16 + i; const float* xb = xrow_ptr(args, row); bf16* ob = H1 + (size_t)row * D;
                const float* xr[8] = {xb, xb + D, xb + 2 * D, xb + 3 * D, xb + 4 * D, xb + 5 * D, xb + 6 * D, xb + 7 * D};
                bf16* orw[8] = {ob, ob + D, ob + 2 * D, ob + 3 * D, ob + 4 * D, ob + 5 * D, ob + 6 * D, ob + 7 * D}; norm_rows_lds<8>(xr, orw, Gm, Sh, lane); }
        }
        } else {
        for (int task = vcu; task < 256; task += G) {
            const int g = task >> 3, lb = task & 7;
            LAS float* Bre = (LAS float*)(lds + RING_OFF);
            LAS float* Bim = Bre + 2048;
            LAS float* CZr = Bim + 2048;
            LAS float* CZi = CZr + 2080;
            LAS float* PWr = CZi + 2080;
            LAS float* PWi = PWr + 520;
            LAS float* X0 = PWi + 520;
            __syncthreads();
            for (int i = tid; i < 2048; i += NWAVES * 64) {
                const int dir = i >> 10, rem = i & 1023, gd = dir * 32 + g;
                Bre[i] = args.in[11][(size_t)gd * 1024 + rem]; Bim[i] = args.in[12][(size_t)gd * 1024 + rem];
                const int c = rem >> 6, n = rem & 63, bi = gd * 64 + n;
                const float cr = args.in[13][(size_t)gd * 1024 + rem], ci = args.in[14][(size_t)gd * 1024 + rem], zr = t_zre[bi], zi = t_zim[bi];
                CZr[(dir * 16 + c) * 65 + n] = cr * zr - ci * zi; CZi[(dir * 16 + c) * 65 + n] = cr * zi + ci * zr;
            }
            { const int i = tid; const int dir = i >> 8, l = (i >> 6) & 3, n = i & 63; float pre, pim; cpow_tab(t_ldre, t_theta, (dir * 32 + g) * 64 + n, 4 * lb + l, pre, pim);
                PWr[(dir * 4 + l) * 65 + n] = pre; PWi[(dir * 4 + l) * 65 + n] = pim; }
            __syncthreads();
            const int dir = tid >> 8, l = (tid >> 6) & 3, c = (tid >> 2) & 15, cq = tid & 3, tau = 4 * lb + l;
            f32x4 acc = {0.f, 0.f, 0.f, 0.f};
            const LAS float* czr = CZr + (dir * 16 + c) * 65; const LAS float* czi = CZi + (dir * 16 + c) * 65;
            const LAS float* pwr = PWr + (dir * 4 + l) * 65; const LAS float* pwi = PWi + (dir * 4 + l) * 65;
#pragma unroll 8
            for (int n = 0; n < 64; ++n) {
                const float a = czr[n], b = czi[n], pr = pwr[n], pi = pwi[n], wr_ = a * pr - b * pi, wi_ = a * pi + b * pr;
                const f32x4 r0 = *(const LAS f32x4*)(Bre + dir * 1024 + n * 16 + 4 * cq), m0 = *(const LAS f32x4*)(Bim + dir * 1024 + n * 16 + 4 * cq);
                acc += r0 * wr_ - m0 * wi_;
            }
            if (tau == 0 && dir == 1) *(LAS f32x4*)(X0 + c * 16 + 4 * cq) = acc;
            __syncthreads();
            if (tau == 0 && dir == 0) { const float dsk = args.in[15][16 * g + c]; const f32x4 xo = *(const LAS f32x4*)(X0 + c * 16 + 4 * cq);
#pragma unroll
                for (int j = 0; j < 4; ++j) acc[j] += xo[j] + ((4 * cq + j == c) ? dsk : 0.f); }
            if (!(tau == 0 && dir == 1)) {
                const int ti = dir == 0 ? (TCH - 1) + tau : (TCH - 1) - tau;
                v2u o; o.x = pk2(acc[0], acc[1]); o.y = pk2(acc[2], acc[3]);
                *(v2u*)(Klag + ((size_t)((g * (2 * TCH - 1) + ti) * 16 + c) * 16 + 4 * cq)) = o;
            }
        }
        for (int e = gtid; e < 32 * 2 * 64 * TCH; e += NT) {
            const int s = e & 31, n = (e >> 5) & 63, dir = (e >> 11) & 1, g = e >> 12, bi = (dir * 32 + g) * 64 + n;
            float pre, pim; cpow_tab(t_ldre, t_theta, bi, dir == 0 ? (TCH - 1) - s : s, pre, pim);
            const float zr = t_zre[bi], zi = t_zim[bi], wr_ = pre * zr - pim * zi, wi_ = pre * zi + pim * zr;
            const f32x4* br = (const f32x4*)(args.in[11] + (size_t)bi * 16); const f32x4* bm = (const f32x4*)(args.in[12] + (size_t)bi * 16);
            float re[16], im[16];
#pragma unroll
            for (int j4 = 0; j4 < 4; ++j4) { const f32x4 b1 = br[j4], b2 = bm[j4];
#pragma unroll
                for (int e2 = 0; e2 < 4; ++e2) { re[4 * j4 + e2] = wr_ * b1[e2] - wi_ * b2[e2]; im[4 * j4 + e2] = wr_ * b2[e2] + wi_ * b1[e2]; } }
            bf16* d0 = Ptab + ((size_t)(g * 256 + dir * 128 + 2 * n) * (16 * TCH) + s * 16);
            v4u o; o.x = pk2(re[0], re[1]); o.y = pk2(re[2], re[3]); o.z = pk2(re[4], re[5]); o.w = pk2(re[6], re[7]); *(v4u*)d0 = o;
            o.x = pk2(re[8], re[9]); o.y = pk2(re[10], re[11]); o.z = pk2(re[12], re[13]); o.w = pk2(re[14], re[15]); *(v4u*)(d0 + 8) = o;
            o.x = pk2(im[0], im[1]); o.y = pk2(im[2], im[3]); o.z = pk2(im[4], im[5]); o.w = pk2(im[6], im[7]); *(v4u*)(d0 + 16 * TCH) = o;
            o.x = pk2(im[8], im[9]); o.y = pk2(im[10], im[11]); o.z = pk2(im[12], im[13]); o.w = pk2(im[14], im[15]); *(v4u*)(d0 + 16 * TCH + 8) = o;
        }
        }
        }
    }
    SEAM(1);

    if (IN(2)) for (int rep_ = 0; rep_ < REPS(2); ++rep_) {
        pg8::Gemm g{H1, WinT, M, NPROJ, D, D, D}; DupOrder<(DUP_MASK >> 2) & 1> S; S.S.init(M, NPROJ, G, bx);
        EpiQKV E{Qb, Kb, Vb, Ub, cosT, sinT};
        pg8::gemm_phase<EpiQKV, DupOrder<(DUP_MASK >> 2) & 1>, true, true>(lds + RING_OFF, g, S, E);
    }
    SEAM(2);

    if (IN(3)) {
        { pg8::Gemm g{Ub, Ptab, NG * NCG, NG * 256, 16 * TCH, UP, 16 * TCH}; SchedState S{bx}; EpiState E{Sbuf};
          pg8::gemm_phase<EpiState, SchedState, true, true>(lds + RING_OFF, g, S, E); }
        for (int rep_ = 0; rep_ < REPS(3); ++rep_) att::phase(lds + RING_OFF, Qb, Kb, Vb, Ob, Lse, bx, G, wave, lane);
    }
    SEAM(3);

    if (IN(4)) for (int rep_ = 0; rep_ < REPS(4); ++rep_) {
        if (bx < 128) {
            int seq, g, dir, nc, chunk0, sgi;
            if (bx < 64) { seq = 0; g = bx >> 1; dir = bx & 1; nc = 512; chunk0 = 0; sgi = wave; }
            else { const int q = (bx - 64) * 4 + (wave >> 1); seq = 1 + (q >> 6); g = (q >> 1) & 31; dir = q & 1; nc = 128; chunk0 = 512 + 128 * (seq - 1); sgi = wave & 1; }
            const int i_lo = 64 * sgi;
            const int bi = (dir * 32 + g) * 64 + lane; const float ar = t_atre[bi], ai = t_atim[bi];
            float hr = 0.f, hi_ = 0.f;
            LAS float* T = (LAS float*)(lds + RING_OFF);
#pragma unroll 1
            for (int i0 = i_lo; i0 < i_lo + 64; i0 += 32) {
                f32x2v sv[32];
#pragma unroll
                for (int j = 0; j < 32; ++j) { const int c = dir == 0 ? i0 + j : nc - 1 - (i0 + j); sv[j] = *(const f32x2v*)(Sbuf + ((size_t)(g * NCG + chunk0 + c) * 256 + dir * 128 + 2 * lane)); }
#pragma unroll
                for (int j = 0; j < 32; ++j) { const float nr = ar * hr - ai * hi_ + sv[j].x, ni = ar * hi_ + ai * hr + sv[j].y; hr = nr; hi_ = ni; }
            }
            __syncthreads();
            T[(wave * 64 + lane) * 2] = hr; T[(wave * 64 + lane) * 2 + 1] = hi_;
            __syncthreads();
            float pr = ar, pi = ai;
#pragma unroll
            for (int k = 0; k < 6; ++k) { const float nr = pr * pr - pi * pi, ni = 2.f * pr * pi; pr = nr; pi = ni; }
            hr = 0.f; hi_ = 0.f;
            for (int v = wave - sgi; v < wave; ++v) { const float tr = T[(v * 64 + lane) * 2], ti2 = T[(v * 64 + lane) * 2 + 1]; const float nr = pr * hr - pi * hi_ + tr, ni = pr * hi_ + pi * hr + ti2; hr = nr; hi_ = ni; }
#pragma unroll 1
            for (int i0 = i_lo; i0 < i_lo + 64; i0 += 32) {
                f32x2v sv[32];
#pragma unroll
                for (int j = 0; j < 32; ++j) { const int c = dir == 0 ? i0 + j : nc - 1 - (i0 + j); sv[j] = *(const f32x2v*)(Sbuf + ((size_t)(g * NCG + chunk0 + c) * 256 + dir * 128 + 2 * lane)); }
#pragma unroll
                for (int j = 0; j < 32; ++j) { const int c = dir == 0 ? i0 + j : nc - 1 - (i0 + j);
                    *(unsigned*)(Ub + ((size_t)(g * NCG + chunk0 + c) * UP + 16 * TCH + dir * 128 + 2 * lane)) = pk2(hr, hi_);
                    const float nr = ar * hr - ai * hi_ + sv[j].x, ni = ar * hi_ + ai * hr + sv[j].y; hr = nr; hi_ = ni; }
            }
        }
        for (int e = gtid; e < 32 * TCH * 16 * TCH; e += NT) {
            const int s = e & 31, c = (e >> 5) & 15, t = (e >> 9) & 31, g = e >> 14;
            const v4u* src = (const v4u*)(Klag + ((size_t)((g * (2 * TCH - 1) + (t - s + TCH - 1)) * 16 + c) * 16));
            v4u* dst = (v4u*)(Toep + ((size_t)(g * 16 * TCH + t * 16 + c) * UP + s * 16));
            const v4u a = src[0], b = src[1]; dst[0] = a; dst[1] = b;
        }
        for (int e = gtid; e < 32 * TCH * 2 * 64; e += NT) {
            const int n = e & 63, dir = (e >> 6) & 1, t = (e >> 7) & 31, g = e >> 12, bi = (dir * 32 + g) * 64 + n;
            float pre, pim; cpow_tab(t_ldre, t_theta, bi, dir == 0 ? t + 1 : TCH - t, pre, pim);
#pragma unroll 4
            for (int c = 0; c < 16; ++c) {
                const float cr = args.in[13][(size_t)((dir * 32 + g) * 16 + c) * 64 + n], ci = args.in[14][(size_t)((dir * 32 + g) * 16 + c) * 64 + n];
                *(unsigned*)(Toep + ((size_t)(g * 16 * TCH + t * 16 + c) * UP + 16 * TCH + dir * 128 + 2 * n)) = pk2(cr * pre - ci * pim, -(cr * pim + ci * pre));
            }
        }
    }
    SEAM(4);

    if (IN(5)) for (int rep_ = 0; rep_ < REPS(5); ++rep_) {
        pg8::Gemm g{Ub, Toep, NG * NCG, NG * 16 * TCH, UP, UP, UP}; SchedSsmOut S{vcu}; EpiSsmOut E{Gb};
        pg8::gemm_phase<EpiSsmOut, SchedSsmOut, true, true>(lds + RING_OFF, g, S, E);
    }
    SEAM(5);

    if (IN(6)) for (int rep_ = 0; rep_ < REPS(6); ++rep_) {
        pg8::Gemm g{Gb, WgluT, M, 512, 512, 512, 512}; DupOrder<(DUP_MASK >> 6) & 1> S; S.S.init(M, 512, G, bx);
        EpiGluNorm E{lds};
        pg8::gemm_phase<EpiGluNorm, DupOrder<(DUP_MASK >> 6) & 1>, true, true>(lds + RING_OFF, g, S, E);
#ifndef P6_PROBE
#define P6_PROBE 0
#endif
        for (int p6r = 0; p6r < 1 + (P6_PROBE & 1); ++p6r)
        for (int t0 = 2 * gw; t0 < M; t0 += 2 * NGW) {
            const int hh = lane >> 3;
            float l0[2], l1[2], l2[2]; v4u a[2], bb[2], c[2];
#pragma unroll
            for (int k = 0; k < 2; ++k) { const size_t t = t0 + k;
                l0[k] = Lse[t * 8 + hh]; l1[k] = Lse[((size_t)M + t) * 8 + hh]; l2[k] = Lse[((size_t)2 * M + t) * 8 + hh];
                a[k] = *(const v4u*)(Ob + t * 512 + 8 * lane); bb[k] = *(const v4u*)(Ob + ((size_t)M + t) * 512 + 8 * lane); c[k] = *(const v4u*)(Ob + ((size_t)2 * M + t) * 512 + 8 * lane); }
            const f32x4 g0 = *(const f32x4*)(args.in[18] + 8 * lane), g1 = *(const f32x4*)(args.in[18] + 8 * lane + 4);
#pragma unroll
            for (int k = 0; k < 2; ++k) {
                const float lm = fmaxf(l0[k], fmaxf(l1[k], l2[k]));
                float w0 = fexp2((l0[k] - lm) * LOG2E), w1 = fexp2((l1[k] - lm) * LOG2E), w2 = fexp2((l2[k] - lm) * LOG2E);
                const float wi = frcp(w0 + w1 + w2); w0 *= wi; w1 *= wi; w2 *= wi;
                float v[8];
                v[0] = w0 * bflo(a[k].x) + w1 * bflo(bb[k].x) + w2 * bflo(c[k].x); v[1] = w0 * bfhi(a[k].x) + w1 * bfhi(bb[k].x) + w2 * bfhi(c[k].x);
                v[2] = w0 * bflo(a[k].y) + w1 * bflo(bb[k].y) + w2 * bflo(c[k].y); v[3] = w0 * bfhi(a[k].y) + w1 * bfhi(bb[k].y) + w2 * bfhi(c[k].y);
                v[4] = w0 * bflo(a[k].z) + w1 * bflo(bb[k].z) + w2 * bflo(c[k].z); v[5] = w0 * bfhi(a[k].z) + w1 * bfhi(bb[k].z) + w2 * bfhi(c[k].z);
                v[6] = w0 * bflo(a[k].w) + w1 * bflo(bb[k].w) + w2 * bflo(c[k].w); v[7] = w0 * bfhi(a[k].w) + w1 * bfhi(bb[k].w) + w2 * bfhi(c[k].w);
                float sq = 0.f;
#pragma unroll
                for (int j = 0; j < 8; ++j) sq += v[j] * v[j];
                const float rs = __builtin_amdgcn_rsqf(wave_sum(sq) * (1.f / 512.f) + EPS);
                v4u o; o.x = pk2(v[0] * rs * g0[0], v[1] * rs * g0[1]); o.y = pk2(v[2] * rs * g0[2], v[3] * rs * g0[3]); o.z = pk2(v[4] * rs * g1[0], v[5] * rs * g1[1]); o.w = pk2(v[6] * rs * g1[2], v[7] * rs * g1[3]);
                *(v4u*)(MixA + (size_t)(t0 + k) * D + 8 * lane) = o;
            }
        }
    }
    SEAM(6);


    if (IN(8)) {
        pg8::Gemm g{MixA, WoT, M, D, D, D, D, H2, W13T}; EpiWoUp E{lds};
        if (G == 256) {
#pragma unroll 1
            for (int part = 0; part < 2; ++part) { SchedWoUp S{bx, (const unsigned*)(ctl + CW_READY), part == 0 ? 0 : 1, part == 0 ? 1 : 12};
                pg8::gemm_phase<EpiWoUp, SchedWoUp, true, true>(lds + RING_OFF, g, S, E); }
        }
    }
    SEAM(8);

    if (IN(11)) for (int rep_ = 0; rep_ < REPS(11); ++rep_) {
        for (int it = gw; it < 44 * 32; it += NGW) transpose_item(args.in[24], FF, D, W2T, scr, it, lane, MapId{});
    }
    SEAM(11);
#ifdef EXTRA_BARS
    for (int xb_ = 0; xb_ < EXTRA_BARS; ++xb_) xcd_barrier(bar);
#endif

    if (IN(12)) {
        pg8::Gemm g{Act, W2T, M, D, FF, FF, FF}; DupOrder<((DUP_MASK >> 12) & 1) + 2 * ((DUP_MASK >> 13) & 1)> S; S.S.init(M, D, G, bx);
        EpiDownFinal E{lds};
        pg8::gemm_phase<EpiDownFinal, DupOrder<((DUP_MASK >> 12) & 1) + 2 * ((DUP_MASK >> 13) & 1)>, true, true>(lds + RING_OFF, g, S, E);
    }
    if (TIME_PHASE == 12 && bx == 0) { __syncthreads(); if (tid == 0) { const unsigned long long t1 = __builtin_amdgcn_s_memrealtime(); const unsigned long long dt = t1 - tp0; while (__builtin_amdgcn_s_memrealtime() - t1 < 9ull * dt) __builtin_amdgcn_s_sleep(8); } }
#undef IN
#undef SEAM
}

extern "C" void kernel_launch(void* const* d_in, const int* in_sizes, int n_in, void* d_out, int out_size, void* d_ws, size_t ws_size, hipStream_t stream) {
    static int grid = 0;
    if (grid == 0) {
        if (n_in != 26 || in_sizes[0] != MP * D || out_size != M * D || ws_size < WS_END) { fprintf(stderr, "kernel_launch: unexpected shapes (n_in %d, in0 %d, out %d, ws %zu); nothing launched\n", n_in, n_in > 0 ? in_sizes[0] : -1, out_size, ws_size); grid = -1; return; }
        int dev = 0, cus = 0, per_cu = 0;
        if (hipGetDevice(&dev) != hipSuccess || hipDeviceGetAttribute(&cus, hipDeviceAttributeMultiprocessorCount, dev) != hipSuccess) { grid = -1; return; }
        if (hipFuncSetAttribute((const void*)mk_fwd, hipFuncAttributeMaxDynamicSharedMemorySize, LDS_BYTES) != hipSuccess) { fprintf(stderr, "kernel_launch: hipFuncSetAttribute failed\n"); grid = -1; return; }
        if (hipOccupancyMaxActiveBlocksPerMultiprocessor(&per_cu, (const void*)mk_fwd, NWAVES * 64, LDS_BYTES) != hipSuccess || per_cu < 1) fprintf(stderr, "kernel_launch: occupancy query says %d\n", per_cu);
        (void)hipGetLastError();
        grid = cus;
    }
    if (grid < 0) return;
    if (hipMemsetAsync((char*)d_ws + WS_CTL, 0, CTL_ZERO_BYTES, stream) != hipSuccess) return;
    Args a{};
    for (int i = 0; i < 26; ++i) a.in[i] = (const float*)d_in[i];
    a.out = (float*)d_out; a.ws = (unsigned char*)d_ws;
    if (MK_N_LAUNCHES == 1) { a.ph_lo = 0; a.ph_hi = N_PHASES; hipLaunchKernelGGL(mk_fwd, dim3(grid), dim3(NWAVES * 64), LDS_BYTES, stream, a); }
    else for (int p = 0; p < N_PHASES; ++p) { a.ph_lo = p; a.ph_hi = p + 1; hipLaunchKernelGGL(mk_fwd, dim3(grid), dim3(NWAVES * 64), LDS_BYTES, stream, a); }
}
```

```cpp
#include <hip/hip_runtime.h>
#include <cstdio>
#include <cstdint>
#include <cmath>
namespace pg8 {
#define PG8_LAS __attribute__((address_space(3)))
typedef unsigned short bf16_t;
typedef short bf16x8 __attribute__((ext_vector_type(8)));
typedef float f32x4 __attribute__((ext_vector_type(4)));
typedef unsigned u32x4 __attribute__((ext_vector_type(4)));
constexpr int BM = 256, BK = 64, HALF = 128, HTB = HALF * BK * 2  , STAGE_BYTES = 8 * HTB, NXCD = 8, WGM = 8;

__host__ __device__ __forceinline__ int lds_byte(int r, int c) { const int st = (r >> 4) * 2 + (c >> 5), rr = r & 15, cc = c & 31, ob = rr * 64 + cc * 2; return st * 1024 + (ob ^ (((ob >> 9) & 1) << 5)); }
__host__ __device__ __forceinline__ void stage_rc(int b, int& R, int& C) { const int st = b / 1024, sb = b % 1024, swz = sb ^ (((sb >> 9) & 1) << 5); R = (st >> 1) * 16 + swz / 64; C = (st & 1) * 32 + (swz % 64) / 2; }
__host__ __device__ __forceinline__ int perm32(int rho) { const int n = rho >> 4, i = rho & 15; return 8 * (i >> 2) + 4 * n + (i & 3); }

struct Unit { int pm, pn; int ty = 0; };
struct Gemm { const bf16_t* A; const bf16_t* Bt; int M, N, K, lda, ldb; const bf16_t* A2 = nullptr; const bf16_t* Bt2 = nullptr; };

struct StaticOrder {
    int nM, nN, nwg, G, c;
    __host__ __device__ void init(int M, int N, int G_, int c_) { nM = M / BM; nN = N / BM; nwg = nM * nN; G = G_; c = c_; }
    __host__ __device__ bool next(int i, Unit& u) const {
        const long L = (long)i * G + c; if (L >= nwg) return false;
        int wgid = (int)L; { const int q = nwg / NXCD, r = nwg % NXCD, xcd = wgid % NXCD, off = wgid / NXCD; wgid = (xcd < r ? xcd * (q + 1) : r * (q + 1) + (xcd - r) * q) + off; }
        const int nig = WGM * nN, gid = wgid / nig, fm = gid * WGM, gsz = (nM - fm) < WGM ? (nM - fm) : WGM;
        u.pm = fm + ((wgid % nig) % gsz); u.pn = (wgid % nig) / gsz; return true;
    }
    __device__ __forceinline__ void a_ready(const Unit&) const {}
    __device__ __forceinline__ void done(const Unit&) const {}
};

__device__ __forceinline__ unsigned cvt_pk_bf16(float lo, float hi) { unsigned r; asm volatile("v_cvt_pk_bf16_f32 %0, %1, %2" : "=v"(r) : "v"(lo), "v"(hi)); return r; }
template <class Epi, class Sched, bool ALIGN_EPI = false, bool SP2 = false>
__device__ __forceinline__ void gemm_phase(PG8_LAS unsigned char* lds, const Gemm g, const Sched& S, const Epi& E) {
    const int tid = threadIdx.x, wid = __builtin_amdgcn_readfirstlane(tid >> 6), lane = tid & 63, wr = wid >> 2, wc = wid & 3, fr = lane & 15, fq = lane >> 4;
    const int K = g.K, nt = K / BK;
    unsigned voffA[2], voffB[2];
#pragma unroll
    for (int i = 0; i < 2; ++i) { int R, C; stage_rc(tid * 16 + i * 8192, R, C); const int Rb = Epi::PERM ? ((R & ~31) + perm32(R & 31)) : R;
        voffA[i] = (unsigned)(R * g.lda + C) * 2u; voffB[i] = (unsigned)(Rb * g.ldb + C) * 2u; }
    const size_t kstep = (size_t)(BK * 2);
    const size_t hstepA = (size_t)HALF * g.lda * 2, hstepB = (size_t)HALF * g.ldb * 2;
    const size_t tstepA = 2 * hstepA, tstepB = 2 * hstepB;
    const unsigned ldsw = (unsigned)wid * 1024u;
    const int aoff = lds_byte(wr * 64 + fr, fq * 8), boff = lds_byte(wc * 32 + fr, fq * 8);
#define PG8_SA(b, h) (((b) * 2 + (h)) * HTB)
#define PG8_SB(b, h) ((4 + (b) * 2 + (h)) * HTB)
#define PG8_STAGE(bufoff, gbase, voff) do { _Pragma("unroll") for (int _i = 0; _i < 2; ++_i) \
        __builtin_amdgcn_global_load_lds((const unsigned*)((const char*)(gbase) + (voff)[_i]), (PG8_LAS unsigned*)(lds + (bufoff) + ldsw + _i * 8192), 16, 0, 0); } while (0)
#define PG8_LDA(dst, b, h) do { _Pragma("unroll") for (int m = 0; m < 4; ++m) _Pragma("unroll") for (int k = 0; k < 2; ++k) dst[m][k] = *(const PG8_LAS bf16x8*)(lds + PG8_SA(b, h) + aoff + m * 2048 + k * 1024); } while (0)
#define PG8_LDB(dst, b, h) do { _Pragma("unroll") for (int n = 0; n < 2; ++n) _Pragma("unroll") for (int k = 0; k < 2; ++k) dst[n][k] = *(const PG8_LAS bf16x8*)(lds + PG8_SB(b, h) + boff + n * 2048 + k * 1024); } while (0)
#define PG8_MMA(ai, bj, At, Bt) do { __builtin_amdgcn_s_setprio(1); _Pragma("unroll") for (int m = 0; m < 4; ++m) _Pragma("unroll") for (int n = 0; n < 2; ++n) _Pragma("unroll") for (int k = 0; k < 2; ++k) \
        acc[ai][bj][m][n] = __builtin_amdgcn_mfma_f32_16x16x32_bf16(Bt[n][k], At[m][k], acc[ai][bj][m][n], 0, 0, 0); __builtin_amdgcn_s_setprio(0); } while (0)
#define PG8_WAIT_V(n) asm volatile("s_waitcnt vmcnt(" #n ")" ::: "memory")
#define PG8_WAIT_L(n) asm volatile("s_waitcnt lgkmcnt(" #n ")" ::: "memory")
#define PG8_BAR __builtin_amdgcn_s_barrier()
#define PG8_SCHED __builtin_amdgcn_sched_barrier(0)
    Unit cur, nxt; int ui = 0;
    if (!S.next(0, cur)) return;
    f32x4 acc[2][2][4][2];
#pragma unroll
    for (int a = 0; a < 2; ++a)
#pragma unroll
        for (int b = 0; b < 2; ++b)
#pragma unroll
            for (int m = 0; m < 4; ++m)
#pragma unroll
                for (int n = 0; n < 2; ++n) acc[a][b][m][n] = (f32x4){0.f, 0.f, 0.f, 0.f};
    bf16x8 At[4][2], B0[2][2], B1[2][2];
    const char* cA = (const char*)(cur.ty ? g.A2 : g.A) + (size_t)cur.pm * tstepA; const char* cB = (const char*)(cur.ty ? g.Bt2 : g.Bt) + (size_t)cur.pn * tstepB;
    S.a_ready(cur);
    if constexpr (SP2) {
        PG8_STAGE(PG8_SB(0, 0), cB, voffB); PG8_STAGE(PG8_SB(0, 1), cB + hstepB, voffB); PG8_STAGE(PG8_SA(0, 0), cA, voffA); PG8_STAGE(PG8_SA(0, 1), cA + hstepA, voffA);
        if (wr == 1) PG8_BAR;
        PG8_WAIT_V(2); PG8_BAR;
        PG8_STAGE(PG8_SB(1, 0), cB + kstep, voffB); PG8_STAGE(PG8_SA(1, 0), cA + kstep, voffA); PG8_STAGE(PG8_SB(1, 1), cB + hstepB + kstep, voffB);
        PG8_WAIT_V(6); PG8_BAR;
    } else {
        PG8_STAGE(PG8_SB(0, 0), cB, voffB); PG8_STAGE(PG8_SA(0, 0), cA, voffA); PG8_STAGE(PG8_SB(0, 1), cB + hstepB, voffB); PG8_STAGE(PG8_SA(0, 1), cA + hstepA, voffA);
        if (wr == 1) PG8_BAR;
        PG8_WAIT_V(4); PG8_BAR;
        PG8_STAGE(PG8_SB(1, 0), cB + kstep, voffB); PG8_STAGE(PG8_SA(1, 0), cA + kstep, voffA); PG8_STAGE(PG8_SB(1, 1), cB + hstepB + kstep, voffB);
        PG8_WAIT_V(6); PG8_BAR;
    }
    for (;;) {
        const bool has_next = S.next(ui + 1, nxt);
        const char* nA = has_next ? (const char*)(nxt.ty ? g.A2 : g.A) + (size_t)nxt.pm * tstepA : cA; const char* nB = has_next ? (const char*)(nxt.ty ? g.Bt2 : g.Bt) + (size_t)nxt.pn * tstepB : cB;
        for (int t = 0; t < nt; t += 2) {
            const bool last = (t == nt - 2);
            const char* a1 = cA + (size_t)(t + 1) * kstep;
            const char* a2 = last ? nA : cA + (size_t)(t + 2) * kstep; const char* b2 = last ? nB : cB + (size_t)(t + 2) * kstep;
            const char* a3 = a2 + kstep; const char* b3 = b2 + kstep;
            if (last && has_next) S.a_ready(nxt);
            if constexpr (SP2) {
            PG8_LDB(B0, 0, 0); PG8_LDB(B1, 0, 1); PG8_SCHED; PG8_LDA(At, 0, 0); PG8_STAGE(PG8_SA(1, 1), a1 + hstepA, voffA);
            PG8_WAIT_V(8); PG8_WAIT_L(0); PG8_BAR; PG8_MMA(0, 0, At, B0); PG8_MMA(0, 1, At, B1); PG8_BAR; PG8_SCHED;
            PG8_LDA(At, 0, 1); PG8_STAGE(PG8_SB(0, 0), b2, voffB); PG8_STAGE(PG8_SB(0, 1), b2 + hstepB, voffB); PG8_STAGE(PG8_SA(0, 0), a2, voffA);
            PG8_WAIT_V(8); PG8_WAIT_L(0); PG8_BAR; PG8_MMA(1, 0, At, B0); PG8_MMA(1, 1, At, B1); PG8_BAR; PG8_SCHED;
            PG8_LDB(B0, 1, 0); PG8_LDB(B1, 1, 1); PG8_SCHED; PG8_LDA(At, 1, 0); PG8_STAGE(PG8_SA(0, 1), a2 + hstepA, voffA);
            PG8_WAIT_V(8); PG8_WAIT_L(0); PG8_BAR; PG8_MMA(0, 0, At, B0); PG8_MMA(0, 1, At, B1); PG8_BAR; PG8_SCHED;
            PG8_LDA(At, 1, 1); PG8_STAGE(PG8_SB(1, 0), b3, voffB); PG8_STAGE(PG8_SB(1, 1), b3 + hstepB, voffB); PG8_STAGE(PG8_SA(1, 0), a3, voffA);
            PG8_WAIT_V(8); PG8_WAIT_L(0); PG8_BAR; PG8_MMA(1, 0, At, B0); PG8_MMA(1, 1, At, B1); PG8_BAR; PG8_SCHED;
            } else {
            PG8_LDB(B0, 0, 0); PG8_SCHED; PG8_LDA(At, 0, 0); PG8_STAGE(PG8_SA(1, 1), a1 + hstepA, voffA);
            PG8_WAIT_L(8); PG8_BAR; PG8_WAIT_L(0); PG8_MMA(0, 0, At, B0); PG8_BAR; PG8_SCHED;
            PG8_LDB(B1, 0, 1); PG8_STAGE(PG8_SB(0, 0), b2, voffB);
            PG8_BAR; PG8_WAIT_L(0); PG8_MMA(0, 1, At, B1); PG8_BAR;
            PG8_LDA(At, 0, 1); PG8_STAGE(PG8_SA(0, 0), a2, voffA);
            PG8_BAR; PG8_WAIT_L(0); PG8_MMA(1, 0, At, B0); PG8_BAR; PG8_SCHED;
            PG8_STAGE(PG8_SB(0, 1), b2 + hstepB, voffB);
            PG8_WAIT_V(6); PG8_BAR; PG8_MMA(1, 1, At, B1); PG8_BAR;
            PG8_LDB(B0, 1, 0); PG8_SCHED; PG8_LDA(At, 1, 0); PG8_STAGE(PG8_SA(0, 1), a2 + hstepA, voffA);
            PG8_WAIT_L(8); PG8_BAR; PG8_WAIT_L(0); PG8_MMA(0, 0, At, B0); PG8_BAR; PG8_SCHED;
            PG8_LDB(B1, 1, 1); PG8_STAGE(PG8_SB(1, 0), b3, voffB);
            PG8_BAR; PG8_WAIT_L(0); PG8_MMA(0, 1, At, B1); PG8_BAR;
            PG8_LDA(At, 1, 1); PG8_STAGE(PG8_SA(1, 0), a3, voffA);
            PG8_BAR; PG8_WAIT_L(0); PG8_MMA(1, 0, At, B0); PG8_BAR; PG8_SCHED;
            PG8_STAGE(PG8_SB(1, 1), b3 + hstepB, voffB);
            PG8_WAIT_V(6); PG8_BAR; PG8_MMA(1, 1, At, B1); PG8_BAR;
            }
        }
        if constexpr (ALIGN_EPI) { if (wr == 0) PG8_BAR; }
        if constexpr (!Epi::AFTER_DRAIN) { E(acc, cur, wr, wc, fr, fq); S.done(cur); }
        if (!has_next) break;
#pragma unroll
        for (int a = 0; a < 2; ++a)
#pragma unroll
            for (int b = 0; b < 2; ++b)
#pragma unroll
                for (int m = 0; m < 4; ++m)
#pragma unroll
                    for (int n = 0; n < 2; ++n) acc[a][b][m][n] = (f32x4){0.f, 0.f, 0.f, 0.f};
        cur = nxt; cA = nA; cB = nB; ++ui;
        if constexpr (ALIGN_EPI) { if (wr == 1) PG8_BAR; }
    }
    PG8_WAIT_V(0);
    if constexpr (!ALIGN_EPI) { if (wr == 0) PG8_BAR; }
    PG8_BAR;
    if constexpr (Epi::AFTER_DRAIN) { E.fused(acc, cur, wr, wc, fr, fq, lds, wid, lane); S.done(cur); }
#undef PG8_SA
#undef PG8_SB
#undef PG8_STAGE
#undef PG8_LDA
#undef PG8_LDB
#undef PG8_MMA
#undef PG8_WAIT_V
#undef PG8_WAIT_L
#undef PG8_BAR
#undef PG8_SCHED
}
}
#define GAS __attribute__((address_space(1)))
#define LAS __attribute__((address_space(3)))
typedef unsigned short bf16;
typedef unsigned v4u __attribute__((ext_vector_type(4)));
typedef float f32x4 __attribute__((ext_vector_type(4)));
typedef short bf16x8 __attribute__((ext_vector_type(8)));
typedef GAS unsigned gu32;
typedef GAS unsigned long long gu64;
#define RLX_AGENT __ATOMIC_RELAXED, __HIP_MEMORY_SCOPE_AGENT
#define LDS_WAIT() asm volatile("s_waitcnt lgkmcnt(0)" ::: "memory")
#define VM_WAIT() asm volatile("s_waitcnt vmcnt(0)" ::: "memory")
__device__ __forceinline__ unsigned long long rt() { return __builtin_amdgcn_s_memrealtime(); }
__device__ __forceinline__ unsigned f2bf(float f) { unsigned u = __builtin_bit_cast(unsigned, f); return (u + 0x7fffu + ((u >> 16) & 1u)) >> 16; }
__device__ __forceinline__ unsigned pk2(float lo, float hi) { return f2bf(lo) | (f2bf(hi) << 16); }

#define XB_TMO      128
#define XB_XCNT(j)  (256  + 64 * (j))
#define XB_XSUB(j)  (1280 + 64 * (j))
#define XB_XGEN(j)  (2304 + 64 * (j))
#define XB_TOP      3328
#define XB_TOPGEN   3392
#define XCD_BAR_WORDS 3456
#define XB_SPIN_CAP (1u << 18)

__device__ __forceinline__ unsigned xb_ld(unsigned* p)              { return __hip_atomic_load(p, __ATOMIC_RELAXED, __HIP_MEMORY_SCOPE_AGENT); }
__device__ __forceinline__ unsigned xb_add(unsigned* p, unsigned v) { return __hip_atomic_fetch_add(p, v, __ATOMIC_RELAXED, __HIP_MEMORY_SCOPE_AGENT); }
__device__ __forceinline__ unsigned xb_xcc_id() { return (unsigned)__builtin_amdgcn_s_getreg((3 << 11) | 20) & 0xFu; }
#define XB_SPIN(cond, bar) do { unsigned _sp = 0; while (cond) { __builtin_amdgcn_s_sleep(1); \
    if ((++_sp & 255u) == 0u) { if (xb_ld(&(bar)[XB_TMO])) break; if (_sp > XB_SPIN_CAP) { atomicAdd(&(bar)[XB_TMO], 1u); break; } } } } while (0)

struct XcdBarrier {
    unsigned* bar; unsigned x;
    volatile LAS unsigned* st;
};

__device__ __forceinline__ XcdBarrier xcd_barrier_post(unsigned* bar, volatile LAS unsigned* st) {
    XcdBarrier b; b.bar = bar; b.x = xb_xcc_id(); b.st = st;
    if (threadIdx.x == 0) (void)xb_add(&bar[XB_XCNT(b.x)], 1u);
    return b;
}
__device__ __forceinline__ void xcd_barrier_complete(unsigned* bar, unsigned x, unsigned& nloc, unsigned& nx) {
    const unsigned G = gridDim.x * gridDim.y * gridDim.z;
    unsigned sum, cnt, mine, sp = 0u;
    for (;;) {
        sum = 0u; cnt = 0u; mine = 0u;
#pragma unroll
        for (unsigned j = 0; j < 16; ++j) { const unsigned c = xb_ld(&bar[XB_XCNT(j)]); sum += c; cnt += (c > 0u) ? 1u : 0u; mine = (j == x) ? c : mine; }
        if (sum == G) break;
        __builtin_amdgcn_s_sleep(1);
        if ((++sp & 255u) == 0u) { if (xb_ld(&bar[XB_TMO])) break; if (sp > XB_SPIN_CAP) { atomicAdd(&bar[XB_TMO], 1u); break; } }
    }
    nloc = mine > 0u ? mine : 1u; nx = cnt > 0u ? cnt : 1u;
}

__device__ __forceinline__ void xcd_barrier(const XcdBarrier& b) {
    asm volatile("s_waitcnt vmcnt(0)" ::: "memory");
    __syncthreads();
    if (threadIdx.x == 0) {
        unsigned* bar = b.bar;
        __builtin_amdgcn_s_waitcnt(0);
        unsigned nloc = b.st[0], nx = b.st[1];
        if (nloc == 0u) { xcd_barrier_complete(bar, b.x, nloc, nx); b.st[0] = nloc; b.st[1] = nx; }
        const unsigned old = xb_add(&bar[XB_XSUB(b.x)], 1u);
        const unsigned gen = old / nloc;
        if (old + 1u == (gen + 1u) * nloc) {
            __builtin_amdgcn_fence(__ATOMIC_RELEASE, "agent");
            asm volatile("s_waitcnt vmcnt(0)" ::: "memory");
            const unsigned og = xb_add(&bar[XB_TOP], 1u);
            const unsigned tg = og / nx;
            if (og + 1u == (tg + 1u) * nx) xb_add(&bar[XB_TOPGEN], 1u);
            else XB_SPIN(xb_ld(&bar[XB_TOPGEN]) == tg, bar);
            __builtin_amdgcn_fence(__ATOMIC_ACQUIRE, "agent");
            xb_add(&bar[XB_XGEN(b.x)], 1u);
            asm volatile("s_waitcnt vmcnt(0)" ::: "memory");
        } else {
            XB_SPIN(xb_ld(&bar[XB_XGEN(b.x)]) == gen, bar);
            __builtin_amdgcn_fence(__ATOMIC_ACQUIRE, "agent");
            asm volatile("s_waitcnt vmcnt(0)" ::: "memory");
        }
    }
    __syncthreads();
}

constexpr int NWAVES = 8;
#ifndef MK_N_LAUNCHES
#define MK_N_LAUNCHES 1
#endif
constexpr int N_PHASES = 14;
constexpr int D = 1024, M = 32768, MP = 16384, SS = 4096;
constexpr int NG = 32, TCH = 32, NCG = 1024  , FF = 2816, NPROJ = 2048, NMOD = 6144, UP = 768  ;
constexpr float EPS = 1e-6f;
constexpr float LOG2E = 1.4426950408889634f, LN2F = 0.6931471805599453f;
constexpr float QSCALE = 0.125f * LOG2E;
constexpr double INV_2PI = 0.15915494309189533577;

constexpr size_t MiB = 1u << 20;
constexpr size_t WS_CTL = 0, CTL_ZERO_BYTES = 262144;
constexpr size_t WS_MODF = 262144;
constexpr size_t WS_XBUF = 524288;
constexpr size_t WS_LDRE = 393216, WS_ZRE = 409600, WS_ZIM = 425984, WS_ATRE = 442368, WS_ATIM = 458752, WS_THETA = 475136;
constexpr size_t WS_W13 = 1 * MiB;
constexpr size_t WS_PTAB = 12 * MiB, WS_SBUF = 20 * MiB, WS_WIN = 52 * MiB, WS_ROPE = 56 * MiB, WS_MODP = 60 * MiB, WS_WGLU = 254 * MiB, WS_WO = 252 * MiB, WS_KLAG = 63 * MiB;
constexpr size_t WS_SSMRAW = 12 * MiB, WS_H2 = 12 * MiB, WS_W2 = 12 * MiB;
constexpr size_t WS_U = 76 * MiB, WS_Q = 124 * MiB, WS_K = 156 * MiB, WS_V = 188 * MiB, WS_TOEP = 124 * MiB, WS_G = 196 * MiB, WS_MIXA = 12 * MiB  , WS_ACT = 76 * MiB, WS_END = 255 * MiB;
constexpr size_t DO_H1 = 0, DO_OB = 0, DO_LSE = 96 * MiB;
constexpr int CW_ATTQ = 2048;
constexpr int CW_BAR = 4096, CW_SEAM = 16384, SEAM_BANK = 8192;
constexpr int PARAM_OFF = 131520;
constexpr int CW_READY = CW_SEAM + 3 * SEAM_BANK;
constexpr int XLDS_OFF = 131584;

constexpr int RING_OFF = 0, RING_BYTES = 131072;
constexpr int LDSCTL_OFF = RING_BYTES, MISC_OFF = LDSCTL_OFF + 320;
constexpr int LDS_BYTES = 147456;

typedef short v4i16_t __attribute__((ext_vector_type(4)));
typedef unsigned v2u __attribute__((ext_vector_type(2)));
typedef float f32x2v __attribute__((ext_vector_type(2)));

struct Args { const float* in[26]; float* out; unsigned char* ws; int ph_lo, ph_hi; };

__device__ __forceinline__ float wave_sum(float v) {
#pragma unroll
    for (int o = 1; o < 64; o <<= 1) v += __shfl_xor(v, o);
    return v;
}
__device__ __forceinline__ float fexp2(float x) { return __builtin_amdgcn_exp2f(x); }
__device__ __forceinline__ float frcp(float x) { return __builtin_amdgcn_rcpf(x); }
__device__ __forceinline__ float sigm(float x) { return frcp(1.f + fexp2(-x * LOG2E)); }
__device__ __forceinline__ float gelu_tanh(float x) { const float u = 1.5957691216057308f * (x + 0.044715f * x * x * x); return x * sigm(u); }
__device__ __forceinline__ void sincos_rev(double revs, float& s, float& c) { const double fr = revs - __builtin_rint(revs); const float f = (float)fr; s = __builtin_amdgcn_sinf(f); c = __builtin_amdgcn_cosf(f); }
__device__ __forceinline__ float bf2f(unsigned short h) { return __builtin_bit_cast(float, (unsigned)h << 16); }
__device__ __forceinline__ float bflo(unsigned w) { return __builtin_bit_cast(float, w << 16); }
__device__ __forceinline__ float bfhi(unsigned w) { return __builtin_bit_cast(float, w & 0xffff0000u); }
__device__ __forceinline__ int batch_of(int row) { return row < MP ? 0 : 1 + ((row - MP) >> 12); }
__device__ __forceinline__ const float* xrow_ptr(const Args& a, int row) { return row < MP ? a.in[0] + (size_t)row * D : a.in[1] + (size_t)(row - MP) * D; }

struct SchedState {
    int c;
    __device__ bool next(int i, pg8::Unit& u) const { if (i > 0 || c >= 128) return false; u.pm = c; u.pn = c >> 2; return true; }
    __device__ __forceinline__ void a_ready(const pg8::Unit&) const {}
    __device__ __forceinline__ void done(const pg8::Unit&) const {}
};
struct SchedSsmOut {
    int c;
    __device__ bool next(int i, pg8::Unit& u) const { if (i > 0 || c >= 256) return false; const int g = c >> 3; u.pm = 4 * g + ((c >> 1) & 3); u.pn = 2 * g + (c & 1); return true; }
    __device__ __forceinline__ void a_ready(const pg8::Unit&) const {}
    __device__ __forceinline__ void done(const pg8::Unit&) const {}
};

#ifndef DUP_MASK
#define DUP_MASK 0
#endif
template <int DUP> struct DupOrder {
    pg8::StaticOrder S;
    __device__ bool next(int i, pg8::Unit& u) const { if (DUP == 2) { pg8::Unit t; int n = 0; while (S.next(n, t)) ++n; return i < 2 * n ? S.next(i % n, u) : false; } return S.next(DUP ? (i >> 1) : i, u); }
    __device__ __forceinline__ void a_ready(const pg8::Unit&) const {}
    __device__ __forceinline__ void done(const pg8::Unit&) const {}
};
struct SchedWoUp {
    int c; const unsigned* ready; int base, count;
    mutable int seen = -1;
    __device__ bool next(int i0, pg8::Unit& u) const {
        if (i0 >= count) return false;
        const int i = base + i0;
        const int x = c & 7, j = c >> 3, t = 1 + (x % 5), P0 = 16 * x;
        if (i == 0) { u.ty = 0; u.pm = P0 + (j & 7); u.pn = j >> 3; return true; }
        if (i == t) { u.ty = 0; u.pm = P0 + 8 + (j & 7); u.pn = j >> 3; return true; }
        u.ty = 1;
        if (i == 12) { if (j < 16) { u.pm = P0 + (j & 7); u.pn = 20 + (j >> 3); } else { u.pm = P0 + 8 + (j & 7); u.pn = 20 + ((j - 16) >> 3); } return true; }
        const int k = i - 1 - (i > t ? 1 : 0), half = k / 5, b = k % 5;
        u.pm = P0 + 8 * half + (j & 7); u.pn = 4 * b + (j >> 3); return true;
    }
    __device__ __forceinline__ void a_ready(const pg8::Unit& u) const {
        if (u.ty != 1 || u.pm == seen) return;
        seen = u.pm;
        if (threadIdx.x < 64) {
            unsigned sp = 0;
            while ((unsigned)__builtin_amdgcn_readfirstlane(__hip_atomic_load(ready + 64 * u.pm, __ATOMIC_RELAXED, __HIP_MEMORY_SCOPE_AGENT)) < 32u) { __builtin_amdgcn_s_sleep(2); if (++sp > (1u << 22)) break; }
            __builtin_amdgcn_fence(__ATOMIC_ACQUIRE, "agent");
            asm volatile("s_waitcnt vmcnt(0)" ::: "memory");
        }
        asm volatile("" ::: "memory"); __builtin_amdgcn_s_barrier(); asm volatile("" ::: "memory");
    }
    __device__ __forceinline__ void done(const pg8::Unit&) const {}
};
using pg8::f32x4; using pg8::u32x4; using pg8::cvt_pk_bf16;
#define EPI_ROWS(u, ai, m) ((u).pm * 256 + (ai) * 128 + wr * 64 + (m) * 16 + fr)
__device__ __forceinline__ u32x4 pack8(const f32x4& a, const f32x4& b) { u32x4 w; w.x = cvt_pk_bf16(a[0], a[1]); w.y = cvt_pk_bf16(a[2], a[3]); w.z = cvt_pk_bf16(b[0], b[1]); w.w = cvt_pk_bf16(b[2], b[3]); return w; }

struct EpiQKV {
    static constexpr bool PERM = true, AFTER_DRAIN = false;
    bf16 *Q, *K, *V, *U; const float *cosT, *sinT;
    __device__ __forceinline__ void operator()(const f32x4 (&acc)[2][2][4][2], const pg8::Unit& u, int wr, int wc, int fr, int fq) const {
        const int kind = u.pn >> 1, ph = u.pn & 1;
        if (kind < 2) {
            bf16* dst0 = kind == 0 ? Q : K; const float sc = kind == 0 ? QSCALE : 1.f;
            const int i0 = 16 * (wc & 1) + 4 * fq;
#pragma unroll
            for (int ai = 0; ai < 2; ++ai)
#pragma unroll
                for (int m = 0; m < 4; ++m) {
                    const int row = EPI_ROWS(u, ai, m); const int pos = row < MP ? row : ((row - MP) & (SS - 1));
                    const f32x4 cs = *(const f32x4*)(cosT + pos * 32 + i0), sn = *(const f32x4*)(sinT + pos * 32 + i0);
#pragma unroll
                    for (int bj = 0; bj < 2; ++bj) {
                        const int head = ph * 4 + bj * 2 + (wc >> 1);
                        const f32x4 x1 = acc[ai][bj][m][0], x2 = acc[ai][bj][m][1];
                        const f32x4 o1 = (x1 * cs - x2 * sn) * sc, o2 = (x2 * cs + x1 * sn) * sc;
                        bf16* d = dst0 + (size_t)row * 512 + head * 64 + i0;
                        v2u w1; w1.x = cvt_pk_bf16(o1[0], o1[1]); w1.y = cvt_pk_bf16(o1[2], o1[3]);
                        v2u w2; w2.x = cvt_pk_bf16(o2[0], o2[1]); w2.y = cvt_pk_bf16(o2[2], o2[3]);
                        *(v2u*)d = w1; *(v2u*)(d + 32) = w2;
                    }
                }
        } else {
#pragma unroll
            for (int ai = 0; ai < 2; ++ai)
#pragma unroll
                for (int m = 0; m < 4; ++m) {
                    const int row = EPI_ROWS(u, ai, m);
#pragma unroll
                    for (int bj = 0; bj < 2; ++bj) {
                        const int col = ph * 256 + bj * 128 + wc * 32 + 8 * fq;
                        const u32x4 w = pack8(acc[ai][bj][m][0], acc[ai][bj][m][1]);
                        if (kind == 2) *(u32x4*)(V + (size_t)row * 512 + col) = w;
                        else { const int g = col >> 4, c = col & 15; *(u32x4*)(U + ((size_t)(g * NCG + (row >> 5)) * UP + (row & 31) * 16 + c)) = w; }
                    }
                }
        }
    }
};
struct EpiState {
    static constexpr bool PERM = true, AFTER_DRAIN = false;
    float* S;
    __device__ __forceinline__ void operator()(const f32x4 (&acc)[2][2][4][2], const pg8::Unit& u, int wr, int wc, int fr, int fq) const {
        const int g = u.pn, mt = u.pm & 3;
#pragma unroll
        for (int ai = 0; ai < 2; ++ai)
#pragma unroll
            for (int m = 0; m < 4; ++m) {
                const int chunk = mt * 256 + ai * 128 + wr * 64 + m * 16 + fr;
#pragma unroll
                for (int bj = 0; bj < 2; ++bj) { float* p = S + ((size_t)(g * NCG + chunk) * 256 + bj * 128 + wc * 32 + 8 * fq); *(f32x4*)p = acc[ai][bj][m][0]; *(f32x4*)(p + 4) = acc[ai][bj][m][1]; }
            }
    }
};
struct EpiSsmOut {
    static constexpr bool PERM = true, AFTER_DRAIN = false;
    bf16* G;
    __device__ __forceinline__ void operator()(const f32x4 (&acc)[2][2][4][2], const pg8::Unit& u, int wr, int wc, int fr, int fq) const {
        const int g = u.pn >> 1, nt = u.pn & 1, mt = u.pm & 3;
#pragma unroll
        for (int ai = 0; ai < 2; ++ai)
#pragma unroll
            for (int m = 0; m < 4; ++m) {
                const int chunk = mt * 256 + ai * 128 + wr * 64 + m * 16 + fr;
#pragma unroll
                for (int bj = 0; bj < 2; ++bj) {
                    const int ncol = nt * 256 + bj * 128 + wc * 32 + 8 * fq, t = ncol >> 4, c0 = ncol & 15;
                    f32x4 a = acc[ai][bj][m][0], b = acc[ai][bj][m][1];
#pragma unroll
                    for (int e = 0; e < 4; ++e) { a[e] = gelu_tanh(a[e]); b[e] = gelu_tanh(b[e]); }
                    *(u32x4*)(G + (size_t)(chunk * TCH + t) * 512 + g * 16 + c0) = pack8(a, b);
                }
            }
    }
};
struct EpiGlu {
    static constexpr bool PERM = true, AFTER_DRAIN = false;
    const bf16* G; const float* bglu; bf16* O;
    __device__ __forceinline__ void operator()(const f32x4 (&acc)[2][2][4][2], const pg8::Unit& u, int wr, int wc, int fr, int fq) const {
#pragma unroll
        for (int bj = 0; bj < 2; ++bj) {
            const int col = u.pn * 256 + bj * 128 + wc * 32 + 8 * fq;
            const f32x4 b0 = *(const f32x4*)(bglu + col), b1 = *(const f32x4*)(bglu + col + 4);
#pragma unroll
            for (int ai = 0; ai < 2; ++ai)
#pragma unroll
                for (int m = 0; m < 4; ++m) {
                    const int row = EPI_ROWS(u, ai, m);
                    const u32x4 gv = *(const u32x4*)(G + (size_t)row * 512 + col);
                    const f32x4 z0 = acc[ai][bj][m][0] + b0, z1 = acc[ai][bj][m][1] + b1;
                    f32x4 o0, o1;
                    o0[0] = bflo(gv.x) * sigm(z0[0]); o0[1] = bfhi(gv.x) * sigm(z0[1]); o0[2] = bflo(gv.y) * sigm(z0[2]); o0[3] = bfhi(gv.y) * sigm(z0[3]);
                    o1[0] = bflo(gv.z) * sigm(z1[0]); o1[1] = bfhi(gv.z) * sigm(z1[1]); o1[2] = bflo(gv.w) * sigm(z1[2]); o1[3] = bfhi(gv.w) * sigm(z1[3]);
                    *(u32x4*)(O + (size_t)row * 512 + col) = pack8(o0, o1);
                }
        }
    }
};
struct EpiResid {
    static constexpr bool PERM = true, AFTER_DRAIN = false;
    const float* xp; const float* xs; float* out; const float* gate;
    int inplace;
    __device__ __forceinline__ void operator()(const f32x4 (&acc)[2][2][4][2], const pg8::Unit& u, int wr, int wc, int fr, int fq) const {
#pragma unroll
        for (int ai = 0; ai < 2; ++ai)
#pragma unroll
            for (int m = 0; m < 4; ++m) {
                const int row = EPI_ROWS(u, ai, m); const int b = batch_of(row);
                const float* base = inplace ? out + (size_t)row * D : (row < MP ? xp + (size_t)row * D : xs + (size_t)(row - MP) * D);
#pragma unroll
                for (int bj = 0; bj < 2; ++bj) {
                    const int col = u.pn * 256 + bj * 128 + wc * 32 + 8 * fq;
                    const f32x4 g0 = *(const f32x4*)(gate + b * NMOD + col), g1 = *(const f32x4*)(gate + b * NMOD + col + 4);
                    const f32x4 x0 = *(const f32x4*)(base + col), x1 = *(const f32x4*)(base + col + 4);
                    *(f32x4*)(out + (size_t)row * D + col) = x0 + g0 * acc[ai][bj][m][0];
                    *(f32x4*)(out + (size_t)row * D + col + 4) = x1 + g1 * acc[ai][bj][m][1];
                }
            }
    }
};
struct PB { const float* xp; const float* xs; float* out; unsigned char* ws; const float* p17; const float* p19; const float* p21; const float* p25; };
__device__ __forceinline__ PB load_pb(LAS unsigned char* lds) { asm volatile("" ::: "memory"); const LAS unsigned long long* p = (const LAS unsigned long long*)(lds + PARAM_OFF); PB r;
    r.xp = (const float*)p[0]; r.xs = (const float*)p[1]; r.out = (float*)p[2]; r.ws = (unsigned char*)p[3]; r.p17 = (const float*)p[4]; r.p19 = (const float*)p[5]; r.p21 = (const float*)p[6]; r.p25 = (const float*)p[7]; return r; }
template <int NTN, int BANK>
__device__ __forceinline__ void row_ssq_exchange(const f32x4 (&v)[2][2][4][2], const pg8::Unit& u, int wr, int wc, int fr, int fq, LAS unsigned char* ldsx, unsigned char* ws) {
    unsigned* xbuf = (unsigned*)(ws + WS_XBUF); unsigned* cnt = (unsigned*)(ws + WS_CTL) + CW_SEAM + BANK * SEAM_BANK + 64 * u.pm;
    int lane = threadIdx.x & 63; asm volatile("" : "+v"(lane)); const int wid = __builtin_amdgcn_readfirstlane(threadIdx.x >> 6);
    LAS float* P = (LAS float*)ldsx; LAS float* S = (LAS float*)(ldsx + 4096);
#pragma unroll
    for (int ai = 0; ai < 2; ++ai)
#pragma unroll
        for (int m = 0; m < 4; ++m) {
            float q = 0.f;
#pragma unroll
            for (int bj = 0; bj < 2; ++bj)
#pragma unroll
                for (int n = 0; n < 2; ++n) { const f32x4 x = v[ai][bj][m][n]; q += (x[0] * x[0] + x[1] * x[1]) + (x[2] * x[2] + x[3] * x[3]); }
            q += __shfl_xor(q, 16); q += __shfl_xor(q, 32);
            if (fq == 0) P[(ai * 128 + wr * 64 + m * 16 + fr) * 4 + wc] = q;
        }
    asm volatile("s_waitcnt lgkmcnt(0)" ::: "memory"); __builtin_amdgcn_s_barrier(); asm volatile("" ::: "memory");
    const int row = wid * 32 + (lane & 31);
    if (lane < 32) { const float t = (P[row * 4 + 0] + P[row * 4 + 1]) + (P[row * 4 + 2] + P[row * 4 + 3]);
        __hip_atomic_store(xbuf + ((size_t)(u.pm * 256 + row) * 4 + (u.pn & 3)), __float_as_uint(t), __ATOMIC_RELAXED, __HIP_MEMORY_SCOPE_AGENT); }
    asm volatile("s_waitcnt vmcnt(0)" ::: "memory");
    if (lane == 0) __hip_atomic_fetch_add(cnt, 1u, __ATOMIC_RELAXED, __HIP_MEMORY_SCOPE_AGENT);
    if (wid == 0) {
        unsigned sp = 0;
        while ((unsigned)__builtin_amdgcn_readfirstlane(__hip_atomic_load(cnt, __ATOMIC_RELAXED, __HIP_MEMORY_SCOPE_AGENT)) < 8u * NTN) { __builtin_amdgcn_s_sleep(1); if (++sp > (1u << 22)) break; }
    }
    asm volatile("s_waitcnt vmcnt(0) lgkmcnt(0)" ::: "memory"); __builtin_amdgcn_s_barrier(); asm volatile("" ::: "memory");
    if (lane < 32) { float t = 0.f;
#pragma unroll
        for (int k = 0; k < NTN; ++k) t += __uint_as_float(__hip_atomic_load(xbuf + ((size_t)(u.pm * 256 + row) * 4 + k), __ATOMIC_RELAXED, __HIP_MEMORY_SCOPE_AGENT));
        S[row] = __builtin_amdgcn_rsqf(t * (1.f / (256.f * NTN)) + EPS); }
    asm volatile("s_waitcnt lgkmcnt(0)" ::: "memory"); __builtin_amdgcn_s_barrier(); asm volatile("" ::: "memory");
}
struct EpiGluNorm {
    static constexpr bool PERM = true, AFTER_DRAIN = false;
    LAS unsigned char* lds;
    __device__ __forceinline__ void operator()(f32x4 (&acc)[2][2][4][2], const pg8::Unit& u, int wr, int wc, int fr, int fq) const {
        asm volatile("" : "+v"(fr), "+v"(fq));
        const PB pb = load_pb(lds); const bf16* G = (const bf16*)(pb.ws + WS_G); bf16* O = (bf16*)(pb.ws + WS_MIXA);
#pragma unroll
        for (int bj = 0; bj < 2; ++bj) {
            const int col = u.pn * 256 + bj * 128 + wc * 32 + 8 * fq;
            const f32x4 b0 = *(const f32x4*)(pb.p17 + col), b1 = *(const f32x4*)(pb.p17 + col + 4);
#pragma unroll
            for (int ai = 0; ai < 2; ++ai)
#pragma unroll
                for (int m = 0; m < 4; ++m) {
                    const int row = EPI_ROWS(u, ai, m);
                    const u32x4 gv = *(const u32x4*)(G + (size_t)row * 512 + col);
                    const f32x4 z0 = acc[ai][bj][m][0] + b0, z1 = acc[ai][bj][m][1] + b1;
                    f32x4 o0, o1;
                    o0[0] = bflo(gv.x) * sigm(z0[0]); o0[1] = bfhi(gv.x) * sigm(z0[1]); o0[2] = bflo(gv.y) * sigm(z0[2]); o0[3] = bfhi(gv.y) * sigm(z0[3]);
                    o1[0] = bflo(gv.z) * sigm(z1[0]); o1[1] = bfhi(gv.z) * sigm(z1[1]); o1[2] = bflo(gv.w) * sigm(z1[2]); o1[3] = bfhi(gv.w) * sigm(z1[3]);
                    acc[ai][bj][m][0] = o0; acc[ai][bj][m][1] = o1;
                    asm volatile("" : "+v"(acc[ai][bj][m][0]), "+v"(acc[ai][bj][m][1]));
                    if (m & 1) asm volatile("" ::: "memory");
                }
        }
        row_ssq_exchange<2, 0>(acc, u, wr, wc, fr, fq, lds + XLDS_OFF, pb.ws);
        const LAS float* S = (const LAS float*)(lds + XLDS_OFF + 4096);
#pragma unroll
        for (int bj = 0; bj < 2; ++bj) {
            const int col = u.pn * 256 + bj * 128 + wc * 32 + 8 * fq;
            const f32x4 g0 = *(const f32x4*)(pb.p19 + col), g1 = *(const f32x4*)(pb.p19 + col + 4);
#pragma unroll
            for (int ai = 0; ai < 2; ++ai)
#pragma unroll
                for (int m = 0; m < 4; ++m) {
                    const int rl = ai * 128 + wr * 64 + m * 16 + fr; const float rs = S[rl];
                    *(u32x4*)(O + (size_t)(u.pm * 256 + rl) * D + 512 + col) = pack8(acc[ai][bj][m][0] * rs * g0, acc[ai][bj][m][1] * rs * g1);
                }
        }
    }
};
struct EpiWoH2 {
    static constexpr bool PERM = true, AFTER_DRAIN = false;
    LAS unsigned char* lds;
    __device__ __forceinline__ void operator()(f32x4 (&acc)[2][2][4][2], const pg8::Unit& u, int wr, int wc, int fr, int fq) const {
        asm volatile("" : "+v"(fr), "+v"(fq));
        const PB pb = load_pb(lds);
        unsigned char* wsu = (unsigned char*)(((unsigned long long)(unsigned)__builtin_amdgcn_readfirstlane((int)((unsigned long long)pb.ws >> 32)) << 32) | (unsigned)__builtin_amdgcn_readfirstlane((int)(unsigned long long)pb.ws));
        const __amdgpu_buffer_rsrc_t h2r = __builtin_amdgcn_make_buffer_rsrc((void*)(wsu + WS_H2), (short)0, (int)((size_t)M * D * 2), 0x00020000);
        const int b = batch_of(u.pm * 256); const float* mb = (const float*)(pb.ws + WS_MODF) + b * NMOD;
#pragma unroll
        for (int bj = 0; bj < 2; ++bj) {
            const int col = u.pn * 256 + bj * 128 + wc * 32 + 8 * fq;
            const f32x4 g0 = *(const f32x4*)(mb + 2048 + col), g1 = *(const f32x4*)(mb + 2048 + col + 4);
#pragma unroll
            for (int ai = 0; ai < 2; ++ai)
#pragma unroll
                for (int m = 0; m < 4; ++m) {
                    const int row = EPI_ROWS(u, ai, m);
                    const float* base = (row < MP ? pb.xp + (size_t)row * D : pb.xs + (size_t)(row - MP) * D) + col;
                    const f32x4 x0 = *(const f32x4*)base, x1 = *(const f32x4*)(base + 4);
                    const f32x4 r0 = x0 + g0 * acc[ai][bj][m][0], r1 = x1 + g1 * acc[ai][bj][m][1];
                    acc[ai][bj][m][0] = r0; acc[ai][bj][m][1] = r1;
                    *(u32x4*)((unsigned char*)pb.out + (size_t)row * (D * 4) + 2048 + col * 2) = pack8(r0, r1);
                    if (ai == 1 && m == 3) asm volatile("" ::: "memory");
                }
        }
        row_ssq_exchange<4, 1>(acc, u, wr, wc, fr, fq, lds + XLDS_OFF, pb.ws);
        const LAS float* S = (const LAS float*)(lds + XLDS_OFF + 4096);
#pragma unroll
        for (int bj = 0; bj < 2; ++bj) {
            const int col = u.pn * 256 + bj * 128 + wc * 32 + 8 * fq;
            const f32x4 gm0 = *(const f32x4*)(pb.p21 + col) * (*(const f32x4*)(mb + 4096 + col) + 1.f), gm1 = *(const f32x4*)(pb.p21 + col + 4) * (*(const f32x4*)(mb + 4096 + col + 4) + 1.f);
            const f32x4 sh0 = *(const f32x4*)(mb + 3072 + col), sh1 = *(const f32x4*)(mb + 3072 + col + 4);
#pragma unroll
            for (int ai = 0; ai < 2; ++ai)
#pragma unroll
                for (int m = 0; m < 4; ++m) {
                    const int rl = ai * 128 + wr * 64 + m * 16 + fr; const float rs = S[rl];
                    __builtin_amdgcn_raw_buffer_store_b128(pack8(acc[ai][bj][m][0] * rs * gm0 + sh0, acc[ai][bj][m][1] * rs * gm1 + sh1), h2r, (int)(((size_t)(u.pm * 256 + rl) * D + col) * 2), 0, 16);
                }
        }
        asm volatile("s_waitcnt vmcnt(0)" ::: "memory");
        if ((threadIdx.x & 63) == 0) __hip_atomic_fetch_add((unsigned*)(pb.ws + WS_CTL) + CW_READY + 64 * u.pm, 1u, __ATOMIC_RELAXED, __HIP_MEMORY_SCOPE_AGENT);
    }
};
struct EpiDownFinal {
    static constexpr bool PERM = true, AFTER_DRAIN = false;
    LAS unsigned char* lds;
    __device__ __forceinline__ void operator()(f32x4 (&acc)[2][2][4][2], const pg8::Unit& u, int wr, int wc, int fr, int fq) const {
        asm volatile("" : "+v"(fr), "+v"(fq));
        const PB pb = load_pb(lds);
        const int b = batch_of(u.pm * 256); const float* mb = (const float*)(pb.ws + WS_MODF) + b * NMOD;
#if (DUP_MASK >> 12) & 3
        LAS int* vc = (LAS int*)(lds + XLDS_OFF + 5120); const int visit = *vc; const bool keep = ((DUP_MASK >> 13) & 1) ? (visit < 2) : ((visit & 1) == 0);
#else
        const bool keep = false;
#endif
#pragma unroll
        for (int bj = 0; bj < 2; ++bj) {
            const int col = u.pn * 256 + bj * 128 + wc * 32 + 8 * fq;
            const f32x4 g0 = *(const f32x4*)(mb + 5120 + col), g1 = *(const f32x4*)(mb + 5120 + col + 4);
#pragma unroll
            for (int ai = 0; ai < 2; ++ai)
#pragma unroll
                for (int m = 0; m < 4; ++m) {
                    const u32x4 xw = *(const u32x4*)((const unsigned char*)pb.out + (size_t)EPI_ROWS(u, ai, m) * (D * 4) + 2048 + col * 2);
                    const f32x4 x0 = {bflo(xw.x), bfhi(xw.x), bflo(xw.y), bfhi(xw.y)}, x1 = {bflo(xw.z), bfhi(xw.z), bflo(xw.w), bfhi(xw.w)};
                    acc[ai][bj][m][0] = x0 + g0 * acc[ai][bj][m][0]; acc[ai][bj][m][1] = x1 + g1 * acc[ai][bj][m][1];
                    asm volatile("" : "+v"(acc[ai][bj][m][0]), "+v"(acc[ai][bj][m][1]));
                    if (ai == 1 && m == 3) asm volatile("" ::: "memory");
                }
        }
        row_ssq_exchange<4, 2>(acc, u, wr, wc, fr, fq, lds + XLDS_OFF, pb.ws);
#if (DUP_MASK >> 12) & 3
        if (threadIdx.x == 0) *vc = visit + 1;
#endif
        const LAS float* S = (const LAS float*)(lds + XLDS_OFF + 4096);
        asm volatile("" : "+v"(fr), "+v"(fq));
        if (!keep) {
#pragma unroll
        for (int bj = 0; bj < 2; ++bj) {
            const int col = u.pn * 256 + bj * 128 + wc * 32 + 8 * fq;
            const f32x4 f0 = *(const f32x4*)(pb.p25 + col), f1 = *(const f32x4*)(pb.p25 + col + 4);
#pragma unroll
            for (int ai = 0; ai < 2; ++ai)
#pragma unroll
                for (int m = 0; m < 4; ++m) {
                    const int rl = ai * 128 + wr * 64 + m * 16 + fr; const float rs = S[rl];
                    float* o = pb.out + (size_t)(u.pm * 256 + rl) * D + col;
                    *(f32x4*)o = acc[ai][bj][m][0] * rs * f0; *(f32x4*)(o + 4) = acc[ai][bj][m][1] * rs * f1;
                }
        }
        }
    }
};

struct EpiWoUp {
    static constexpr bool PERM = true, AFTER_DRAIN = false;
    LAS unsigned char* lds;
    __device__ __forceinline__ void operator()(f32x4 (&acc)[2][2][4][2], const pg8::Unit& u, int wr, int wc, int fr, int fq) const {
        if (u.ty == 0) { EpiWoH2 E{lds}; E(acc, u, wr, wc, fr, fq); return; }
        asm volatile("" : "+v"(fr), "+v"(fq));
        const PB pb = load_pb(lds); bf16* O = (bf16*)(pb.ws + WS_ACT);
        const int j0 = u.pn * 128 + wc * 32 + 8 * fq;
#pragma unroll
        for (int ai = 0; ai < 2; ++ai)
#pragma unroll
            for (int m = 0; m < 4; ++m) {
                const int row = EPI_ROWS(u, ai, m);
                f32x4 o0, o1;
#pragma unroll
                for (int e = 0; e < 4; ++e) { const float a0 = acc[ai][0][m][0][e], a1 = acc[ai][0][m][1][e]; o0[e] = a0 * sigm(a0) * acc[ai][1][m][0][e]; o1[e] = a1 * sigm(a1) * acc[ai][1][m][1][e]; }
                *(u32x4*)(O + (size_t)row * FF + j0) = pack8(o0, o1);
            }
    }
};

template <class Map>
__device__ __forceinline__ void transpose_item(const float* W, int K, int N, bf16* WT, LAS float* scr, int item, int lane, Map map) {
    const int nblk = N / 32, kb = item / nblk, nb = item % nblk, k0 = 64 * kb, n0 = 32 * nb;
#pragma unroll 8
    for (int i = 0; i < 32; ++i) { const int kk = 2 * i + (lane >> 5); scr[kk * 33 + (lane & 31)] = W[(size_t)(k0 + kk) * N + n0 + (lane & 31)]; }
    LDS_WAIT(); asm volatile("" ::: "memory");
    const int c = lane & 7;
#pragma unroll
    for (int j = 0; j < 4; ++j) { const int n = (lane >> 3) + 8 * j; const LAS float* s = scr + (8 * c) * 33 + n;
        v4u o; o.x = pk2(s[0 * 33], s[1 * 33]); o.y = pk2(s[2 * 33], s[3 * 33]); o.z = pk2(s[4 * 33], s[5 * 33]); o.w = pk2(s[6 * 33], s[7 * 33]);
        *(GAS v4u*)(WT + (size_t)map(n0 + n) * K + k0 + 8 * c) = o; }
    LDS_WAIT(); asm volatile("" ::: "memory");
}
struct MapId { __device__ __forceinline__ int operator()(int n) const { return n; } };
struct MapWin { __device__ __forceinline__ int operator()(int n) const { if (n >= 1024) return n; const int d = n & 63; return (n & ~63) + ((d >> 2) & 7) * 8 + (d >> 5) * 4 + (d & 3); } };
struct MapW13 { int off; __device__ __forceinline__ int operator()(int j) const { return 256 * (j >> 7) + off + (j & 127); } };

template <int R>
__device__ __forceinline__ void norm_rows_lds(const float* const (&xrow)[R], bf16* const (&orow)[R], const LAS float* Gm, const LAS float* Sh, int lane) {
    f32x4 v[R][4];
#pragma unroll
    for (int r = 0; r < R; ++r)
#pragma unroll
        for (int j = 0; j < 4; ++j) v[r][j] = ((const GAS f32x4*)xrow[r] + lane)[64 * j];
#pragma unroll
    for (int r = 0; r < R; ++r) {
        float s = 0.f;
#pragma unroll
        for (int j = 0; j < 4; ++j) s += (v[r][j].x * v[r][j].x + v[r][j].y * v[r][j].y) + (v[r][j].z * v[r][j].z + v[r][j].w * v[r][j].w);
        const float rstd = __builtin_amdgcn_rsqf(wave_sum(s) * (1.f / D) + EPS);
        GAS v2u* o8 = (GAS v2u*)orow[r] + lane;
#pragma unroll
        for (int j = 0; j < 4; ++j) { const f32x4 gm = *(const LAS f32x4*)(Gm + 256 * j + 4 * lane), sh = *(const LAS f32x4*)(Sh + 256 * j + 4 * lane);
            const f32x4 h = v[r][j] * rstd * gm + sh; v2u w; w.x = pk2(h.x, h.y); w.y = pk2(h.z, h.w); o8[64 * j] = w; }
    }
}

__device__ __forceinline__ void cpow_tab(const float* ldre, const double* theta, int bi, int e, float& pre, float& pim) {
    const float mag = fexp2((float)e * ldre[bi] * LOG2E); float s, c; sincos_rev((double)e * theta[bi], s, c); pre = mag * c; pim = mag * s;
}

__device__ __forceinline__ float xmax16_32(float m) {
    auto r = __builtin_amdgcn_permlane16_swap(__float_as_uint(m), __float_as_uint(m), false, false); m = fmaxf(__uint_as_float(r[0]), __uint_as_float(r[1]));
    auto q = __builtin_amdgcn_permlane32_swap(__float_as_uint(m), __float_as_uint(m), false, false); return fmaxf(__uint_as_float(q[0]), __uint_as_float(q[1])); }
__device__ __forceinline__ float xsum16_32(float m) {
    auto r = __builtin_amdgcn_permlane16_swap(__float_as_uint(m), __float_as_uint(m), false, false); m = __uint_as_float(r[0]) + __uint_as_float(r[1]);
    auto q = __builtin_amdgcn_permlane32_swap(__float_as_uint(m), __float_as_uint(m), false, false); return __uint_as_float(q[0]) + __uint_as_float(q[1]); }
namespace att {
constexpr int NITEMS = 3 * 8 * 256, VOFF = 32768, BUFB = 65536;
struct Item { int br, h, seq_base, ldil, r, kblk, nidx, cont; };
__device__ __forceinline__ Item decode(int hs, int pos) {
    Item I; const int bh = hs >> 6, L = (hs & 63) * 4 + pos; I.br = bh >> 3; I.h = bh & 7; I.ldil = 2 * I.br;
    int S, li;
    if (L < 128) { I.seq_base = 0; S = MP; li = L; } else { const int si = (L - 128) >> 5; I.seq_base = MP + SS * si; S = SS; li = (L - 128) & 31; }
    const int lnb = (S == MP ? 7 : 5) - I.ldil;
    I.r = li >> lnb; I.kblk = li & ((1 << lnb) - 1); I.nidx = S >> I.ldil; I.cont = (pos > 0 && I.kblk > 0) ? 1 : 0; return I;
}
__device__ __forceinline__ void glds16(const void* gsrc, unsigned lds_dst) { unsigned keep;
    asm volatile("s_mov_b32 %0, m0\n\ts_mov_b32 m0, %2\n\ts_nop 0\n\tglobal_load_lds_dwordx4 %1, off\n\ts_mov_b32 m0, %0" : "=&s"(keep) : "v"(gsrc), "s"(lds_dst) : "memory"); }
template <bool HALF>
__device__ __forceinline__ void stage(LAS unsigned char* buf, const bf16* K, const bf16* V, const Item& I, int wave, int lane) {
    const unsigned lbase = (unsigned)__builtin_amdgcn_readfirstlane((int)(unsigned)(uintptr_t)buf);
    const int rsub = lane >> 3, c16 = lane & 7, kbase = 128 * I.kblk - 64;
    if (kbase >= 0 && kbase + 256 <= I.nidx) {
        const size_t tok0 = (size_t)I.seq_base + I.r + ((size_t)(kbase + 8 * wave + rsub) << I.ldil);
        const bf16* k0 = K + tok0 * 512 + I.h * 64 + ((c16 ^ rsub) << 3);
        const bf16* v0 = V + tok0 * 512 + I.h * 64 + ((c16 ^ (((rsub >> 1) & 3) << 1)) << 3);
        const size_t st = (size_t)65536 << I.ldil;
        const char* k1 = (const char*)k0 + st; const char* k2 = k1 + st; const char* k3 = k2 + st;
        const char* v1 = (const char*)v0 + st; const char* v2 = v1 + st; const char* v3 = v2 + st;
        unsigned keep;
        if (HALF)
            asm volatile("s_mov_b32 %0, m0\n\ts_mov_b32 m0, %5\n\ts_nop 0\n\tglobal_load_lds_dwordx4 %1, off\n\t"
                         "s_add_u32 m0, m0, 0x8000\n\ts_nop 0\n\tglobal_load_lds_dwordx4 %3, off\n\t"
                         "s_sub_u32 m0, m0, 0x6000\n\ts_nop 0\n\tglobal_load_lds_dwordx4 %2, off\n\t"
                         "s_add_u32 m0, m0, 0x8000\n\ts_nop 0\n\tglobal_load_lds_dwordx4 %4, off\n\t"
                         "s_mov_b32 m0, %0"
                         : "=&s"(keep) : "v"(k2), "v"(k3), "v"(v2), "v"(v3), "s"(lbase + wave * 1024 + 16384) : "memory", "scc");
        else
            asm volatile("s_mov_b32 %0, m0\n\ts_mov_b32 m0, %9\n\ts_nop 0\n\tglobal_load_lds_dwordx4 %1, off\n\t"
                         "s_add_u32 m0, m0, 0x8000\n\ts_nop 0\n\tglobal_load_lds_dwordx4 %5, off\n\t"
                         "s_sub_u32 m0, m0, 0x6000\n\ts_nop 0\n\tglobal_load_lds_dwordx4 %2, off\n\t"
                         "s_add_u32 m0, m0, 0x8000\n\ts_nop 0\n\tglobal_load_lds_dwordx4 %6, off\n\t"
                         "s_sub_u32 m0, m0, 0x6000\n\ts_nop 0\n\tglobal_load_lds_dwordx4 %3, off\n\t"
                         "s_add_u32 m0, m0, 0x8000\n\ts_nop 0\n\tglobal_load_lds_dwordx4 %7, off\n\t"
                         "s_sub_u32 m0, m0, 0x6000\n\ts_nop 0\n\tglobal_load_lds_dwordx4 %4, off\n\t"
                         "s_add_u32 m0, m0, 0x8000\n\ts_nop 0\n\tglobal_load_lds_dwordx4 %8, off\n\t"
                         "s_mov_b32 m0, %0"
                         : "=&s"(keep) : "v"(k0), "v"(k1), "v"(k2), "v"(k3), "v"(v0), "v"(v1), "v"(v2), "v"(v3), "s"(lbase + wave * 1024) : "memory", "scc");
        return;
    }
#pragma unroll
    for (int i = (HALF ? 2 : 0); i < 4; ++i) {
        const int p = wave + 8 * i, row = 8 * p + rsub; int kidx = kbase + row; kidx = kidx < 0 ? 0 : (kidx >= I.nidx ? I.nidx - 1 : kidx);
        const size_t tok = (size_t)I.seq_base + I.r + ((size_t)kidx << I.ldil);
        glds16(K + tok * 512 + I.h * 64 + ((c16 ^ (row & 7)) << 3), lbase + p * 1024);
        glds16(V + tok * 512 + I.h * 64 + ((c16 ^ (((row >> 1) & 3) << 1)) << 3), lbase + VOFF + p * 1024);
    }
}
__device__ __forceinline__ void slide(LAS unsigned char* dst, const LAS unsigned char* src, int wave, int lane) {
#pragma unroll
    for (int i = 0; i < 2; ++i) { const int o = (wave + 8 * i) * 1024 + lane * 16;
        const u32x4 a = *(const LAS u32x4*)(src + 16384 + o), b = *(const LAS u32x4*)(src + VOFF + 16384 + o);
        *(LAS u32x4*)(dst + o) = a; *(LAS u32x4*)(dst + VOFF + o) = b; }
}
__device__ __forceinline__ size_t q_token(const Item& I, int wave, int lane) { return (size_t)I.seq_base + I.r + ((size_t)(128 * I.kblk + 16 * wave + (lane & 15)) << I.ldil); }
struct Out { v2u w[4]; float lse; bf16* od; float* lp; };
__device__ __forceinline__ void store_out(const Out& o, int lane) {
#pragma unroll
    for (int dt = 0; dt < 4; ++dt) *(v2u*)(o.od + 16 * dt) = o.w[dt];
    if ((lane >> 4) == 0) *o.lp = o.lse;
}
__device__ __forceinline__ void compute(LAS unsigned char* buf, const Item& I, const bf16x8 (&qf)[2], size_t qtok, bf16* Ob, float* Lse, int wave, int lane, Out& out) {
    const int qi = lane & 15, g4 = lane >> 4, kbase = 128 * I.kblk - 64;
    const LAS unsigned char* kp0 = buf + (16 * wave + qi) * 128 + ((g4 ^ (qi & 7)) << 4);
    const LAS unsigned char* kp1 = buf + (16 * wave + qi) * 128 + (((4 + g4) ^ (qi & 7)) << 4);
    bf16x8 kf0[9], kf1[9];
#pragma unroll
    for (int kt = 0; kt < 9; ++kt) { kf0[kt] = *(const LAS bf16x8*)(kp0 + kt * 2048); kf1[kt] = *(const LAS bf16x8*)(kp1 + kt * 2048); }
    __builtin_amdgcn_sched_barrier(0);
    f32x4 sc[9];
#pragma unroll
    for (int kt = 0; kt < 9; ++kt) sc[kt] = __builtin_amdgcn_mfma_f32_16x16x32_bf16(kf0[kt], qf[0], (f32x4){0.f, 0.f, 0.f, 0.f}, 0, 0, 0);
#pragma unroll
    for (int kt = 0; kt < 9; ++kt) sc[kt] = __builtin_amdgcn_mfma_f32_16x16x32_bf16(kf1[kt], qf[1], sc[kt], 0, 0, 0);
    __builtin_amdgcn_sched_barrier(0);
    const int il = lane & 15, q_ = il >> 2, p_ = il & 3, rr = 4 * g4 + q_, sw = (rr >> 1) & 3;
    const LAS unsigned char* vb = buf + VOFF + (16 * wave + rr) * 128 + p_ * 8;
    v4i16_t vlo[5][4], vhi[5][4];
#pragma unroll
    for (int ks = 0; ks < 5; ++ks) {
        const int hioff = (ks == 4 && wave == 7) ? 0 : 2048;
        if (ks > 0) asm volatile("s_waitcnt lgkmcnt(7)" ::: "memory");
#pragma unroll
        for (int dt = 0; dt < 4; ++dt) {
            vlo[ks][dt] = __builtin_amdgcn_ds_read_tr16_b64_v4i16((LAS v4i16_t*)(vb + ks * 4096 + ((dt ^ sw) << 5)));
            vhi[ks][dt] = __builtin_amdgcn_ds_read_tr16_b64_v4i16((LAS v4i16_t*)(vb + ks * 4096 + hioff + ((dt ^ sw) << 5)));
        }
    }
    __builtin_amdgcn_sched_barrier(0);
#pragma unroll
    for (int e = 0; e < 4; ++e) { const int jj = 4 * g4 + e; if (jj < qi) sc[0][e] = -INFINITY; if (jj > qi) sc[8][e] = -INFINITY; }
    if (kbase < 0 || kbase + 256 > I.nidx) {
#pragma unroll
        for (int kt = 0; kt < 9; ++kt)
#pragma unroll
            for (int e = 0; e < 4; ++e) { const int kidx = kbase + 16 * (wave + kt) + 4 * g4 + e; if ((unsigned)kidx >= (unsigned)I.nidx) sc[kt][e] = -INFINITY; }
    }
    float mx = sc[0][0];
#pragma unroll
    for (int kt = 0; kt < 9; ++kt)
#pragma unroll
        for (int e = 0; e < 4; ++e) mx = fmaxf(mx, sc[kt][e]);
    mx = xmax16_32(mx);
    bf16x8 pf[5]; float lsv = 0.f;
#pragma unroll
    for (int ks = 0; ks < 5; ++ks) {
        f32x4 pa, pb;
#pragma unroll
        for (int e = 0; e < 4; ++e) { pa[e] = fexp2(sc[2 * ks][e] - mx); pb[e] = (ks < 4) ? fexp2(sc[2 * ks + 1][e] - mx) : 0.f; }
#pragma unroll
        for (int e = 0; e < 4; ++e) lsv += pa[e] + pb[e];
        pf[ks] = __builtin_bit_cast(bf16x8, pack8(pa, pb));
    }
    __builtin_amdgcn_sched_barrier(0);
    f32x4 o[4];
#pragma unroll
    for (int dt = 0; dt < 4; ++dt) o[dt] = (f32x4){0.f, 0.f, 0.f, 0.f};
#pragma unroll
    for (int ks = 0; ks < 5; ++ks) {
#pragma unroll
        for (int dt = 0; dt < 4; ++dt) {
            const bf16x8 vf = (bf16x8){vlo[ks][dt][0], vlo[ks][dt][1], vlo[ks][dt][2], vlo[ks][dt][3], vhi[ks][dt][0], vhi[ks][dt][1], vhi[ks][dt][2], vhi[ks][dt][3]};
            o[dt] = __builtin_amdgcn_mfma_f32_16x16x32_bf16(vf, pf[ks], o[dt], 0, 0, 0);
        }
    }
    const float ls = xsum16_32(lsv);
    const float inv = frcp(ls);
    out.od = Ob + ((size_t)I.br * M + qtok) * 512 + I.h * 64 + 4 * g4; out.lp = Lse + ((size_t)I.br * M + qtok) * 8 + I.h;
#pragma unroll
    for (int dt = 0; dt < 4; ++dt) { out.w[dt].x = cvt_pk_bf16(o[dt][0] * inv, o[dt][1] * inv); out.w[dt].y = cvt_pk_bf16(o[dt][2] * inv, o[dt][3] * inv); }
    out.lse = (mx + __builtin_amdgcn_logf(ls)) * LN2F;
}
__device__ __forceinline__ int run_of(int bx, int G, int k) {
    if (G != 256) { const int hs = bx + k * G; return hs < 1536 ? hs : 1536; }
    if (bx < 128) return k < 5 ? bx + 128 * k : 1536;
    return k < 7 ? 640 + (bx - 128) + 128 * k : 1536;
}
__device__ __forceinline__ void phase(LAS unsigned char* ring, const bf16* Q, const bf16* K, const bf16* V, bf16* Ob, float* Lse, int bx, int G, int wave, int lane) {
    int i = 0, hsc = run_of(bx, G, 0), hsn = hsc;
    bf16x8 qc[2], qn[2]; size_t tokc = 0, tokn = 0;
    qc[0] = qc[1] = qn[0] = qn[1] = (bf16x8){0, 0, 0, 0, 0, 0, 0, 0};
    if (hsc < 1536) { const Item I = decode(hsc, 0); stage<false>(ring, K, V, I, wave, lane); tokc = q_token(I, wave, lane);
        qc[0] = *(const bf16x8*)(Q + tokc * 512 + I.h * 64 + 8 * (lane >> 4)); qc[1] = *(const bf16x8*)(Q + tokc * 512 + I.h * 64 + 32 + 8 * (lane >> 4)); }
    asm volatile("s_waitcnt vmcnt(0)" : "+v"(qc[0]), "+v"(qc[1]) :: "memory"); __builtin_amdgcn_s_barrier(); asm volatile("" ::: "memory");
    int b = 0; Out po; bool have = false;
    po.od = nullptr; po.lp = nullptr; po.lse = 0.f; po.w[0] = po.w[1] = po.w[2] = po.w[3] = (v2u){0u, 0u};
    while (hsc < 1536) {
        if (have) store_out(po, lane);
        const int in = i + 1; hsn = run_of(bx, G, in >> 2);
        if (hsn < 1536) { const Item In = decode(hsn, in & 3);
            if (In.cont) { slide(ring + (b ^ 1) * BUFB, ring + b * BUFB, wave, lane); stage<true>(ring + (b ^ 1) * BUFB, K, V, In, wave, lane); }
            else stage<false>(ring + (b ^ 1) * BUFB, K, V, In, wave, lane);
            tokn = q_token(In, wave, lane);
            qn[0] = *(const bf16x8*)(Q + tokn * 512 + In.h * 64 + 8 * (lane >> 4)); qn[1] = *(const bf16x8*)(Q + tokn * 512 + In.h * 64 + 32 + 8 * (lane >> 4)); }
        { const Item I = decode(hsc, i & 3); compute(ring + b * BUFB, I, qc, tokc, Ob, Lse, wave, lane, po); have = true; }
        asm volatile("s_waitcnt vmcnt(0) lgkmcnt(0)" : "+v"(qn[0]), "+v"(qn[1]) :: "memory"); __builtin_amdgcn_s_barrier(); asm volatile("" ::: "memory");
        i = in; hsc = hsn; qc[0] = qn[0]; qc[1] = qn[1]; tokc = tokn; b ^= 1;
    }
    if (have) store_out(po, lane);
    __syncthreads();
}
}

__global__ void __launch_bounds__(NWAVES * 64, 2) mk_fwd(Args args) {
    extern __shared__ __attribute__((aligned(16))) unsigned char lds_raw[];
    LAS unsigned char* lds = (LAS unsigned char*)lds_raw;
    volatile LAS unsigned* MISC = (volatile LAS unsigned*)(lds + MISC_OFF);
    const int tid = threadIdx.x, lane = tid & 63, wave = __builtin_amdgcn_readfirstlane(tid >> 6);
    const int G = gridDim.x, bx = blockIdx.x;
    const int vcu = (G % 8 == 0) ? (bx % 8) * (G / 8) + bx / 8 : bx;
    const int gw = vcu * NWAVES + wave, NGW = G * NWAVES;
    const int gtid = gw * 64 + lane, NT = NGW * 64;
    unsigned char* ws = args.ws;
    gu32* ctl = (gu32*)(ws + WS_CTL);
    for (int u = tid; u < (LDS_BYTES - LDSCTL_OFF) / 4; u += NWAVES * 64) ((LAS unsigned*)(lds + LDSCTL_OFF))[u] = 0u;
    __syncthreads();
    if (tid == 0) { LAS unsigned long long* p = (LAS unsigned long long*)(lds + PARAM_OFF); p[0] = (unsigned long long)args.in[0]; p[1] = (unsigned long long)args.in[1]; p[2] = (unsigned long long)args.out; p[3] = (unsigned long long)args.ws;
        p[4] = (unsigned long long)args.in[17]; p[5] = (unsigned long long)args.in[19]; p[6] = (unsigned long long)args.in[21]; p[7] = (unsigned long long)args.in[25]; }
    __syncthreads();
    XcdBarrier bar; bar.bar = (unsigned*)(ctl + CW_BAR); bar.x = 0; bar.st = nullptr;
    if (MK_N_LAUNCHES == 1) bar = xcd_barrier_post((unsigned*)(ctl + CW_BAR), MISC + 8);
    const int lo = args.ph_lo, hi = args.ph_hi;
#ifndef REP_MASK
#define REP_MASK 0
#endif
#define IN(k) (lo <= (k) && (k) < hi)
#define REPS(k) (1 + ((REP_MASK >> (k)) & 1))
#ifndef TIME_PHASE
#define TIME_PHASE -1
#endif
    unsigned long long tp0 = (TIME_PHASE >= 0) ? __builtin_amdgcn_s_memrealtime() : 0ull;
#define SEAM(k) do { if (IN(k) && IN((k) + 1)) { \
        xcd_barrier(bar); \
        if (TIME_PHASE >= 0 && bx == 0 && tid == 0) { unsigned long long t1 = __builtin_amdgcn_s_memrealtime(); \
            if ((k) == TIME_PHASE) { const unsigned long long dt = t1 - tp0; while (__builtin_amdgcn_s_memrealtime() - t1 < 9ull * dt) __builtin_amdgcn_s_sleep(8); t1 = __builtin_amdgcn_s_memrealtime(); } \
            tp0 = t1; } } } while (0)

    float* modf = (float*)(ws + WS_MODF); float* modp = (float*)(ws + WS_MODP);
    float* t_ldre = (float*)(ws + WS_LDRE); float* t_zre = (float*)(ws + WS_ZRE); float* t_zim = (float*)(ws + WS_ZIM); float* t_atre = (float*)(ws + WS_ATRE); float* t_atim = (float*)(ws + WS_ATIM); double* t_theta = (double*)(ws + WS_THETA);
    bf16* W13T = (bf16*)(ws + WS_W13); bf16* WinT = (bf16*)(ws + WS_WIN); bf16* WgluT = (bf16*)(ws + WS_WGLU); bf16* WoT = (bf16*)(ws + WS_WO); bf16* W2T = (bf16*)(ws + WS_W2);
    bf16* Ptab = (bf16*)(ws + WS_PTAB); float* Sbuf = (float*)(ws + WS_SBUF); bf16* Klag = (bf16*)(ws + WS_KLAG); bf16* Toep = (bf16*)(ws + WS_TOEP);
    float* cosT = (float*)(ws + WS_ROPE); float* sinT = cosT + 16384 * 32;
    bf16* Ub = (bf16*)(ws + WS_U); bf16* Qb = (bf16*)(ws + WS_Q); bf16* Kb = (bf16*)(ws + WS_K); bf16* Vb = (bf16*)(ws + WS_V);
    bf16* Gb = (bf16*)(ws + WS_G); bf16* SsmRaw = (bf16*)(ws + WS_SSMRAW); bf16* MixA = (bf16*)(ws + WS_MIXA); bf16* H2 = (bf16*)(ws + WS_H2); bf16* Act = (bf16*)(ws + WS_ACT);
    bf16* H1 = (bf16*)((unsigned char*)args.out + DO_H1); bf16* Ob = (bf16*)((unsigned char*)args.out + DO_OB); float* Lse = (float*)((unsigned char*)args.out + DO_LSE);
    LAS float* scr = (LAS float*)(lds + RING_OFF + wave * 16384);

    if (IN(0)) for (int rep_ = 0; rep_ < REPS(0); ++rep_) {
        constexpr int I_IN = 16 * 64, I_GLU = 8 * 16, I_O = 16 * 32, I_1 = 16 * 88;
        constexpr int NITEMS = I_IN + I_GLU + I_O + 2 * I_1;
#ifndef P0_PROBE
#define P0_PROBE 0
#endif
        for (int p0r = 0; p0r < 1 + (P0_PROBE & 1); ++p0r)
        for (int it = gw; it < NITEMS; it += NGW) {
            int r = it;
            if (r < I_IN) { transpose_item(args.in[7], D, NPROJ, WinT, scr, r, lane, MapWin{}); continue; } r -= I_IN;
            if (r < I_GLU) { transpose_item(args.in[16], 512, 512, WgluT, scr, r, lane, MapId{}); continue; } r -= I_GLU;
            if (r < I_O) { transpose_item(args.in[20], D, D, WoT, scr, r, lane, MapId{}); continue; } r -= I_O;
            if (r < I_1) { transpose_item(args.in[22], D, FF, W13T, scr, r, lane, MapW13{0}); continue; } r -= I_1;
            transpose_item(args.in[23], D, FF, W13T, scr, r, lane, MapW13{128});
        }
        {
            LAS float* sl = (LAS float*)(lds + RING_OFF);
            LAS f32x2v* red2 = (LAS f32x2v*)(lds + RING_OFF + 20480);
            __syncthreads();
            for (int i = tid; i < 5 * 1024; i += NWAVES * 64) { const float cv = i < 1024 ? args.in[2][i] : args.in[3][i - 1024]; sl[i] = cv * sigm(cv); }
            __syncthreads();
            for (int p0r = 0; p0r < 1 + ((P0_PROBE >> 1) & 1); ++p0r)
            for (int task = vcu; task < 48 * 16; task += G) {
                const int cb = task % 48, ks = task / 48, n = 128 * cb + 2 * lane, k0 = 64 * ks + 8 * wave;
                const float* W = args.in[4] + (size_t)k0 * NMOD + n;
                f32x2v w[8];
#pragma unroll
                for (int i = 0; i < 8; ++i) w[i] = *(const f32x2v*)(W + (size_t)i * NMOD);
                f32x2v a0 = {0.f, 0.f}, a1 = a0, a2 = a0, a3 = a0, a4 = a0;
#pragma unroll
                for (int i = 0; i < 8; ++i) { const int k = k0 + i; a0 += w[i] * sl[k]; a1 += w[i] * sl[1024 + k]; a2 += w[i] * sl[2048 + k]; a3 += w[i] * sl[3072 + k]; a4 += w[i] * sl[4096 + k]; }
                __syncthreads();
                red2[(wave * 5 + 0) * 64 + lane] = a0; red2[(wave * 5 + 1) * 64 + lane] = a1; red2[(wave * 5 + 2) * 64 + lane] = a2; red2[(wave * 5 + 3) * 64 + lane] = a3; red2[(wave * 5 + 4) * 64 + lane] = a4;
                __syncthreads();
                if (wave < 5) { f32x2v t = red2[(0 * 5 + wave) * 64 + lane];
#pragma unroll
                    for (int v = 1; v < 8; ++v) t += red2[(v * 5 + wave) * 64 + lane];
                    *(f32x2v*)(modp + (size_t)(ks * 5 + wave) * NMOD + n) = t; }
            }
            __syncthreads();
        }
        for (int p0r = 0; p0r < 1 + ((P0_PROBE >> 2) & 1); ++p0r)
        for (int idx = gtid; idx < 16384 * 32; idx += NT) { const int pos = idx >> 5, i = idx & 31;
            const float inv = fexp2(-(float)i * 0.41524101186092033f); const float ang = (float)pos * inv; float s, c; sincos_rev((double)ang * INV_2PI, s, c); cosT[idx] = c; sinT[idx] = s; }
        for (int idx = gtid; idx < 4096; idx += NT) {
            const float dt = fexp2(args.in[10][idx >> 6] * LOG2E), lr = args.in[8][idx], li = args.in[9][idx];
            const float ldre = lr * dt; const double th = (double)li * (double)dt * INV_2PI;
            float s, c; sincos_rev(th, s, c); const float mag = fexp2(ldre * LOG2E), are = mag * c, aim = mag * s;
            const float nr = are - 1.f, den = lr * lr + li * li;
            t_ldre[idx] = ldre; t_theta[idx] = th; t_zre[idx] = (nr * lr + aim * li) / den; t_zim[idx] = (aim * lr - nr * li) / den;
            float sT, cT; sincos_rev((double)TCH * th, sT, cT); const float mT = fexp2((float)TCH * ldre * LOG2E); t_atre[idx] = mT * cT; t_atim[idx] = mT * sT;
        }
    }
    SEAM(0);

    if (IN(1)) for (int rep_ = 0; rep_ < REPS(1); ++rep_) {
        for (int e = gtid; e < 5 * NMOD; e += NT) { const int b = e / NMOD, n = e % NMOD; float v = args.in[5][n];
#pragma unroll
            for (int ks = 0; ks < 16; ++ks) v += modp[(size_t)(ks * 5 + b) * NMOD + n];
            modf[e] = v; }
#pragma unroll 1
        for (int step = 0; step < 2; ++step) {
        if ((step == 0) == ((bx & 1) == 0)) {
        LAS float* Gm = (LAS float*)(lds + RING_OFF + 65536); LAS float* Sh = Gm + 1024;
        for (int rb = vcu; rb < M / 128; rb += G) {
            const int row0 = rb * 128, b = batch_of(row0);
            __syncthreads();
            for (int k = tid; k < 1024; k += NWAVES * 64) { float sc = args.in[5][1024 + k], sh = args.in[5][k];
#pragma unroll
                for (int ks = 0; ks < 16; ++ks) { sc += modp[(size_t)(ks * 5 + b) * NMOD + 1024 + k]; sh += modp[(size_t)(ks * 5 + b) * NMOD + k]; }
                Gm[k] = args.in[6][k] * (1.f + sc); Sh[k] = sh; }
            __syncthreads();
            for (int i = 0; i < 16; i += 8) { const int row = row0 + wave * 16 + i; const float* xb = xrow_ptr(args, row); bf16* ob = H1 + (size_t)row * D;
                const float* xr[8] = {xb, xb + D, xb + 2 * D, xb + 3 * D, xb + 4 * D, xb + 5 * D, xb + 6 * D, xb + 7 * D};
                bf16* orw[8] = {ob, ob + D, ob + 2 * D, ob + 3 * D, ob + 4 * D, ob + 5 * D, ob + 6 * D, ob + 7 * D}; norm_rows_lds<8>(xr, orw, Gm, Sh, lane); }
        }
        } else {
        for (int task = vcu; task < 256; task += G) {
            const int g = task >> 3, lb = task & 7;
            LAS float* Bre = (LAS float*)(lds + RING_OFF);
            LAS float* Bim = Bre + 2048;
            LAS float* CZr = Bim + 2048;
            LAS float* CZi = CZr + 2080;
            LAS float* PWr = CZi + 2080;
            LAS float* PWi = PWr + 520;
            LAS float* X0 = PWi + 520;
            __syncthreads();
            for (int i = tid; i < 2048; i += NWAVES * 64) {
                const int dir = i >> 10, rem = i & 1023, gd = dir * 32 + g;
                Bre[i] = args.in[11][(size_t)gd * 1024 + rem]; Bim[i] = args.in[12][(size_t)gd * 1024 + rem];
                const int c = rem >> 6, n = rem & 63, bi = gd * 64 + n;
                const float cr = args.in[13][(size_t)gd * 1024 + rem], ci = args.in[14][(size_t)gd * 1024 + rem], zr = t_zre[bi], zi = t_zim[bi];
                CZr[(dir * 16 + c) * 65 + n] = cr * zr - ci * zi; CZi[(dir * 16 + c) * 65 + n] = cr * zi + ci * zr;
            }
            { const int i = tid; const int dir = i >> 8, l = (i >> 6) & 3, n = i & 63; float pre, pim; cpow_tab(t_ldre, t_theta, (dir * 32 + g) * 64 + n, 4 * lb + l, pre, pim);
                PWr[(dir * 4 + l) * 65 + n] = pre; PWi[(dir * 4 + l) * 65 + n] = pim; }
            __syncthreads();
            const int dir = tid >> 8, l = (tid >> 6) & 3, c = (tid >> 2) & 15, cq = tid & 3, tau = 4 * lb + l;
            f32x4 acc = {0.f, 0.f, 0.f, 0.f};
            const LAS float* czr = CZr + (dir * 16 + c) * 65; const LAS float* czi = CZi + (dir * 16 + c) * 65;
            const LAS float* pwr = PWr + (dir * 4 + l) * 65; const LAS float* pwi = PWi + (dir * 4 + l) * 65;
#pragma unroll 8
            for (int n = 0; n < 64; ++n) {
                const float a = czr[n], b = czi[n], pr = pwr[n], pi = pwi[n], wr_ = a * pr - b * pi, wi_ = a * pi + b * pr;
                const f32x4 r0 = *(const LAS f32x4*)(Bre + dir * 1024 + n * 16 + 4 * cq), m0 = *(const LAS f32x4*)(Bim + dir * 1024 + n * 16 + 4 * cq);
                acc += r0 * wr_ - m0 * wi_;
            }
            if (tau == 0 && dir == 1) *(LAS f32x4*)(X0 + c * 16 + 4 * cq) = acc;
            __syncthreads();
            if (tau == 0 && dir == 0) { const float dsk = args.in[15][16 * g + c]; const f32x4 xo = *(const LAS f32x4*)(X0 + c * 16 + 4 * cq);
#pragma unroll
                for (int j = 0; j < 4; ++j) acc[j] += xo[j] + ((4 * cq + j == c) ? dsk : 0.f); }
            if (!(tau == 0 && dir == 1)) {
                const int ti = dir == 0 ? (TCH - 1) + tau : (TCH - 1) - tau;
                v2u o; o.x = pk2(acc[0], acc[1]); o.y = pk2(acc[2], acc[3]);
                *(v2u*)(Klag + ((size_t)((g * (2 * TCH - 1) + ti) * 16 + c) * 16 + 4 * cq)) = o;
            }
        }
        for (int e = gtid; e < 32 * 2 * 64 * TCH; e += NT) {
            const int s = e & 31, n = (e >> 5) & 63, dir = (e >> 11) & 1, g = e >> 12, bi = (dir * 32 + g) * 64 + n;
            float pre, pim; cpow_tab(t_ldre, t_theta, bi, dir == 0 ? (TCH - 1) - s : s, pre, pim);
            const float zr = t_zre[bi], zi = t_zim[bi], wr_ = pre * zr - pim * zi, wi_ = pre * zi + pim * zr;
            const f32x4* br = (const f32x4*)(args.in[11] + (size_t)bi * 16); const f32x4* bm = (const f32x4*)(args.in[12] + (size_t)bi * 16);
            float re[16], im[16];
#pragma unroll
            for (int j4 = 0; j4 < 4; ++j4) { const f32x4 b1 = br[j4], b2 = bm[j4];
#pragma unroll
                for (int e2 = 0; e2 < 4; ++e2) { re[4 * j4 + e2] = wr_ * b1[e2] - wi_ * b2[e2]; im[4 * j4 + e2] = wr_ * b2[e2] + wi_ * b1[e2]; } }
            bf16* d0 = Ptab + ((size_t)(g * 256 + dir * 128 + 2 * n) * (16 * TCH) + s * 16);
            v4u o; o.x = pk2(re[0], re[1]); o.y = pk2(re[2], re[3]); o.z = pk2(re[4], re[5]); o.w = pk2(re[6], re[7]); *(v4u*)d0 = o;
            o.x = pk2(re[8], re[9]); o.y = pk2(re[10], re[11]); o.z = pk2(re[12], re[13]); o.w = pk2(re[14], re[15]); *(v4u*)(d0 + 8) = o;
            o.x = pk2(im[0], im[1]); o.y = pk2(im[2], im[3]); o.z = pk2(im[4], im[5]); o.w = pk2(im[6], im[7]); *(v4u*)(d0 + 16 * TCH) = o;
            o.x = pk2(im[8], im[9]); o.y = pk2(im[10], im[11]); o.z = pk2(im[12], im[13]); o.w = pk2(im[14], im[15]); *(v4u*)(d0 + 16 * TCH + 8) = o;
        }
        }
        }
    }
    SEAM(1);

    if (IN(2)) for (int rep_ = 0; rep_ < REPS(2); ++rep_) {
        pg8::Gemm g{H1, WinT, M, NPROJ, D, D, D}; DupOrder<(DUP_MASK >> 2) & 1> S; S.S.init(M, NPROJ, G, bx);
        EpiQKV E{Qb, Kb, Vb, Ub, cosT, sinT};
        pg8::gemm_phase<EpiQKV, DupOrder<(DUP_MASK >> 2) & 1>, true, true>(lds + RING_OFF, g, S, E);
    }
    SEAM(2);

    if (IN(3)) {
        { pg8::Gemm g{Ub, Ptab, NG * NCG, NG * 256, 16 * TCH, UP, 16 * TCH}; SchedState S{bx}; EpiState E{Sbuf};
          pg8::gemm_phase<EpiState, SchedState, true, true>(lds + RING_OFF, g, S, E); }
        for (int rep_ = 0; rep_ < REPS(3); ++rep_) att::phase(lds + RING_OFF, Qb, Kb, Vb, Ob, Lse, bx, G, wave, lane);
    }
    SEAM(3);

    if (IN(4)) for (int rep_ = 0; rep_ < REPS(4); ++rep_) {
        if (bx < 128) {
            int seq, g, dir, nc, chunk0, sgi;
            if (bx < 64) { seq = 0; g = bx >> 1; dir = bx & 1; nc = 512; chunk0 = 0; sgi = wave; }
            else { const int q = (bx - 64) * 4 + (wave >> 1); seq = 1 + (q >> 6); g = (q >> 1) & 31; dir = q & 1; nc = 128; chunk0 = 512 + 128 * (seq - 1); sgi = wave & 1; }
            const int i_lo = 64 * sgi;
            const int bi = (dir * 32 + g) * 64 + lane; const float ar = t_atre[bi], ai = t_atim[bi];
            float hr = 0.f, hi_ = 0.f;
            LAS float* T = (LAS float*)(lds + RING_OFF);
#pragma unroll 1
            for (int i0 = i_lo; i0 < i_lo + 64; i0 += 32) {
                f32x2v sv[32];
#pragma unroll
                for (int j = 0; j < 32; ++j) { const int c = dir == 0 ? i0 + j : nc - 1 - (i0 + j); sv[j] = *(const f32x2v*)(Sbuf + ((size_t)(g * NCG + chunk0 + c) * 256 + dir * 128 + 2 * lane)); }
#pragma unroll
                for (int j = 0; j < 32; ++j) { const float nr = ar * hr - ai * hi_ + sv[j].x, ni = ar * hi_ + ai * hr + sv[j].y; hr = nr; hi_ = ni; }
            }
            __syncthreads();
            T[(wave * 64 + lane) * 2] = hr; T[(wave * 64 + lane) * 2 + 1] = hi_;
            __syncthreads();
            float pr = ar, pi = ai;
#pragma unroll
            for (int k = 0; k < 6; ++k) { const float nr = pr * pr - pi * pi, ni = 2.f * pr * pi; pr = nr; pi = ni; }
            hr = 0.f; hi_ = 0.f;
            for (int v = wave - sgi; v < wave; ++v) { const float tr = T[(v * 64 + lane) * 2], ti2 = T[(v * 64 + lane) * 2 + 1]; const float nr = pr * hr - pi * hi_ + tr, ni = pr * hi_ + pi * hr + ti2; hr = nr; hi_ = ni; }
#pragma unroll 1
            for (int i0 = i_lo; i0 < i_lo + 64; i0 += 32) {
                f32x2v sv[32];
#pragma unroll
                for (int j = 0; j < 32; ++j) { const int c = dir == 0 ? i0 + j : nc - 1 - (i0 + j); sv[j] = *(const f32x2v*)(Sbuf + ((size_t)(g * NCG + chunk0 + c) * 256 + dir * 128 + 2 * lane)); }
#pragma unroll
                for (int j = 0; j < 32; ++j) { const int c = dir == 0 ? i0 + j : nc - 1 - (i0 + j);
                    *(unsigned*)(Ub + ((size_t)(g * NCG + chunk0 + c) * UP + 16 * TCH + dir * 128 + 2 * lane)) = pk2(hr, hi_);
                    const float nr = ar * hr - ai * hi_ + sv[j].x, ni = ar * hi_ + ai * hr + sv[j].y; hr = nr; hi_ = ni; }
            }
        }
        for (int e = gtid; e < 32 * TCH * 16 * TCH; e += NT) {
            const int s = e & 31, c = (e >> 5) & 15, t = (e >> 9) & 31, g = e >> 14;
            const v4u* src = (const v4u*)(Klag + ((size_t)((g * (2 * TCH - 1) + (t - s + TCH - 1)) * 16 + c) * 16));
            v4u* dst = (v4u*)(Toep + ((size_t)(g * 16 * TCH + t * 16 + c) * UP + s * 16));
            const v4u a = src[0], b = src[1]; dst[0] = a; dst[1] = b;
        }
        for (int e = gtid; e < 32 * TCH * 2 * 64; e += NT) {
            const int n = e & 63, dir = (e >> 6) & 1, t = (e >> 7) & 31, g = e >> 12, bi = (dir * 32 + g) * 64 + n;
            float pre, pim; cpow_tab(t_ldre, t_theta, bi, dir == 0 ? t + 1 : TCH - t, pre, pim);
#pragma unroll 4
            for (int c = 0; c < 16; ++c) {
                const float cr = args.in[13][(size_t)((dir * 32 + g) * 16 + c) * 64 + n], ci = args.in[14][(size_t)((dir * 32 + g) * 16 + c) * 64 + n];
                *(unsigned*)(Toep + ((size_t)(g * 16 * TCH + t * 16 + c) * UP + 16 * TCH + dir * 128 + 2 * n)) = pk2(cr * pre - ci * pim, -(cr * pim + ci * pre));
            }
        }
    }
    SEAM(4);

    if (IN(5)) for (int rep_ = 0; rep_ < REPS(5); ++rep_) {
        pg8::Gemm g{Ub, Toep, NG * NCG, NG * 16 * TCH, UP, UP, UP}; SchedSsmOut S{vcu}; EpiSsmOut E{Gb};
        pg8::gemm_phase<EpiSsmOut, SchedSsmOut, true, true>(lds + RING_OFF, g, S, E);
    }
    SEAM(5);

    if (IN(6)) for (int rep_ = 0; rep_ < REPS(6); ++rep_) {
        pg8::Gemm g{Gb, WgluT, M, 512, 512, 512, 512}; DupOrder<(DUP_MASK >> 6) & 1> S; S.S.init(M, 512, G, bx);
        EpiGluNorm E{lds};
        pg8::gemm_phase<EpiGluNorm, DupOrder<(DUP_MASK >> 6) & 1>, true, true>(lds + RING_OFF, g, S, E);
#ifndef P6_PROBE
#define P6_PROBE 0
#endif
        for (int p6r = 0; p6r < 1 + (P6_PROBE & 1); ++p6r)
        for (int t0 = 2 * gw; t0 < M; t0 += 2 * NGW) {
            const int hh = lane >> 3;
            float l0[2], l1[2], l2[2]; v4u a[2], bb[2], c[2];
#pragma unroll
            for (int k = 0; k < 2; ++k) { const size_t t = t0 + k;
                l0[k] = Lse[t * 8 + hh]; l1[k] = Lse[((size_t)M + t) * 8 + hh]; l2[k] = Lse[((size_t)2 * M + t) * 8 + hh];
                a[k] = *(const v4u*)(Ob + t * 512 + 8 * lane); bb[k] = *(const v4u*)(Ob + ((size_t)M + t) * 512 + 8 * lane); c[k] = *(const v4u*)(Ob + ((size_t)2 * M + t) * 512 + 8 * lane); }
            const f32x4 g0 = *(const f32x4*)(args.in[18] + 8 * lane), g1 = *(const f32x4*)(args.in[18] + 8 * lane + 4);
#pragma unroll
            for (int k = 0; k < 2; ++k) {
                const float lm = fmaxf(l0[k], fmaxf(l1[k], l2[k]));
                float w0 = fexp2((l0[k] - lm) * LOG2E), w1 = fexp2((l1[k] - lm) * LOG2E), w2 = fexp2((l2[k] - lm) * LOG2E);
                const float wi = frcp(w0 + w1 + w2); w0 *= wi; w1 *= wi; w2 *= wi;
                float v[8];
                v[0] = w0 * bflo(a[k].x) + w1 * bflo(bb[k].x) + w2 * bflo(c[k].x); v[1] = w0 * bfhi(a[k].x) + w1 * bfhi(bb[k].x) + w2 * bfhi(c[k].x);
                v[2] = w0 * bflo(a[k].y) + w1 * bflo(bb[k].y) + w2 * bflo(c[k].y); v[3] = w0 * bfhi(a[k].y) + w1 * bfhi(bb[k].y) + w2 * bfhi(c[k].y);
                v[4] = w0 * bflo(a[k].z) + w1 * bflo(bb[k].z) + w2 * bflo(c[k].z); v[5] = w0 * bfhi(a[k].z) + w1 * bfhi(bb[k].z) + w2 * bfhi(c[k].z);
                v[6] = w0 * bflo(a[k].w) + w1 * bflo(bb[k].w) + w2 * bflo(c[k].w); v[7] = w0 * bfhi(a[k].w) + w1 * bfhi(bb[k].w) + w2 * bfhi(c[k].w);
                float sq = 0.f;
#pragma unroll
                for (int j = 0; j < 8; ++j) sq += v[j] * v[j];
                const float rs = __builtin_amdgcn_rsqf(wave_sum(sq) * (1.f / 512.f) + EPS);
                v4u o; o.x = pk2(v[0] * rs * g0[0], v[1] * rs * g0[1]); o.y = pk2(v[2] * rs * g0[2], v[3] * rs * g0[3]); o.z = pk2(v[4] * rs * g1[0], v[5] * rs * g1[1]); o.w = pk2(v[6] * rs * g1[2], v[7] * rs * g1[3]);
                *(v4u*)(MixA + (size_t)(t0 + k) * D + 8 * lane) = o;
            }
        }
    }
    SEAM(6);


    if (IN(8)) {
        pg8::Gemm g{MixA, WoT, M, D, D, D, D, H2, W13T}; EpiWoUp E{lds};
        if (G == 256) {
#pragma unroll 1
            for (int part = 0; part < 2; ++part) { SchedWoUp S{bx, (const unsigned*)(ctl + CW_READY), part == 0 ? 0 : 1, part == 0 ? 1 : 12};
                pg8::gemm_phase<EpiWoUp, SchedWoUp, true, true>(lds + RING_OFF, g, S, E); }
        }
    }
    SEAM(8);

    if (IN(11)) for (int rep_ = 0; rep_ < REPS(11); ++rep_) {
        for (int it = gw; it < 44 * 32; it += NGW) transpose_item(args.in[24], FF, D, W2T, scr, it, lane, MapId{});
    }
    SEAM(11);
#ifdef EXTRA_BARS
    for (int xb_ = 0; xb_ < EXTRA_BARS; ++xb_) xcd_barrier(bar);
#endif

    if (IN(12)) {
        pg8::Gemm g{Act, W2T, M, D, FF, FF, FF}; DupOrder<((DUP_MASK >> 12) & 1) + 2 * ((DUP_MASK >> 13) & 1)> S; S.S.init(M, D, G, bx);
        EpiDownFinal E{lds};
        pg8::gemm_phase<EpiDownFinal, DupOrder<((DUP_MASK >> 12) & 1) + 2 * ((DUP_MASK >> 13) & 1)>, true, true>(lds + RING_OFF, g, S, E);
    }
    if (TIME_PHASE == 12 && bx == 0) { __syncthreads(); if (tid == 0) { const unsigned long long t1 = __builtin_amdgcn_s_memrealtime(); const unsigned long long dt = t1 - tp0; while (__builtin_amdgcn_s_memrealtime() - t1 < 9ull * dt) __builtin_amdgcn_s_sleep(8); } }
#undef IN
#undef SEAM
}

extern "C" void kernel_launch(void* const* d_in, const int* in_sizes, int n_in, void* d_out, int out_size, void* d_ws, size_t ws_size, hipStream_t stream) {
    static int grid = 0;
    if (grid == 0) {
        if (n_in != 26 || in_sizes[0] != MP * D || out_size != M * D || ws_size < WS_END) { fprintf(stderr, "kernel_launch: unexpected shapes (n_in %d, in0 %d, out %d, ws %zu); nothing launched\n", n_in, n_in > 0 ? in_sizes[0] : -1, out_size, ws_size); grid = -1; return; }
        int dev = 0, cus = 0, per_cu = 0;
        if (hipGetDevice(&dev) != hipSuccess || hipDeviceGetAttribute(&cus, hipDeviceAttributeMultiprocessorCount, dev) != hipSuccess) { grid = -1; return; }
        if (hipFuncSetAttribute((const void*)mk_fwd, hipFuncAttributeMaxDynamicSharedMemorySize, LDS_BYTES) != hipSuccess) { fprintf(stderr, "kernel_launch: hipFuncSetAttribute failed\n"); grid = -1; return; }
        if (hipOccupancyMaxActiveBlocksPerMultiprocessor(&per_cu, (const void*)mk_fwd, NWAVES * 64, LDS_BYTES) != hipSuccess || per_cu < 1) fprintf(stderr, "kernel_launch: occupancy query says %d\n", per_cu);
        (void)hipGetLastError();
        grid = cus;
    }
    if (grid < 0) return;
    if (hipMemsetAsync((char*)d_ws + WS_CTL, 0, CTL_ZERO_BYTES, stream) != hipSuccess) return;
    Args a{};
    for (int i = 0; i < 26; ++i) a.in[i] = (const float*)d_in[i];
    a.out = (float*)d_out; a.ws = (unsigned char*)d_ws;
    if (MK_N_LAUNCHES == 1) { a.ph_lo = 0; a.ph_hi = N_PHASES; hipLaunchKernelGGL(mk_fwd, dim3(grid), dim3(NWAVES * 64), LDS_BYTES, stream, a); }
    else for (int p = 0; p < N_PHASES; ++p) { a.ph_lo = p; a.ph_hi = p + 1; hipLaunchKernelGGL(mk_fwd, dim3(grid), dim3(NWAVES * 64), LDS_BYTES, stream, a); }
}
```

```cpp
#include <hip/hip_runtime.h>
#include <cstdio>
#include <cstdint>
#include <cmath>
namespace pg8 {
#define PG8_LAS __attribute__((address_space(3)))
typedef unsigned short bf16_t;
typedef short bf16x8 __attribute__((ext_vector_type(8)));
typedef float f32x4 __attribute__((ext_vector_type(4)));
typedef unsigned u32x4 __attribute__((ext_vector_type(4)));
constexpr int BM = 256, BK = 64, HALF = 128, HTB = HALF * BK * 2  , STAGE_BYTES = 8 * HTB, NXCD = 8, WGM = 8;

__host__ __device__ __forceinline__ int lds_byte(int r, int c) { const int st = (r >> 4) * 2 + (c >> 5), rr = r & 15, cc = c & 31, ob = rr * 64 + cc * 2; return st * 1024 + (ob ^ (((ob >> 9) & 1) << 5)); }
__host__ __device__ __forceinline__ void stage_rc(int b, int& R, int& C) { const int st = b / 1024, sb = b % 1024, swz = sb ^ (((sb >> 9) & 1) << 5); R = (st >> 1) * 16 + swz / 64; C = (st & 1) * 32 + (swz % 64) / 2; }
__host__ __device__ __forceinline__ int perm32(int rho) { const int n = rho >> 4, i = rho & 15; return 8 * (i >> 2) + 4 * n + (i & 3); }

struct Unit { int pm, pn; int ty = 0; };
struct Gemm { const bf16_t* A; const bf16_t* Bt; int M, N, K, lda, ldb; const bf16_t* A2 = nullptr; const bf16_t* Bt2 = nullptr; };

struct StaticOrder {
    int nM, nN, nwg, G, c;
    __host__ __device__ void init(int M, int N, int G_, int c_) { nM = M / BM; nN = N / BM; nwg = nM * nN; G = G_; c = c_; }
    __host__ __device__ bool next(int i, Unit& u) const {
        const long L = (long)i * G + c; if (L >= nwg) return false;
        int wgid = (int)L; { const int q = nwg / NXCD, r = nwg % NXCD, xcd = wgid % NXCD, off = wgid / NXCD; wgid = (xcd < r ? xcd * (q + 1) : r * (q + 1) + (xcd - r) * q) + off; }
        const int nig = WGM * nN, gid = wgid / nig, fm = gid * WGM, gsz = (nM - fm) < WGM ? (nM - fm) : WGM;
        u.pm = fm + ((wgid % nig) % gsz); u.pn = (wgid % nig) / gsz; return true;
    }
    __device__ __forceinline__ void a_ready(const Unit&) const {}
    __device__ __forceinline__ void done(const Unit&) const {}
};

__device__ __forceinline__ unsigned cvt_pk_bf16(float lo, float hi) { unsigned r; asm volatile("v_cvt_pk_bf16_f32 %0, %1, %2" : "=v"(r) : "v"(lo), "v"(hi)); return r; }
template <class E, class = void> struct PrefetchOf { static constexpr bool v = false; };
template <class E> struct PrefetchOf<E, decltype((void)E::PREFETCH)> { static constexpr bool v = E::PREFETCH; };
template <class Epi, class Sched, bool ALIGN_EPI = false, bool SP2 = false>
__device__ __forceinline__ void gemm_phase(PG8_LAS unsigned char* lds, const Gemm g, const Sched& S, const Epi& E) {
    const int tid = threadIdx.x, wid = __builtin_amdgcn_readfirstlane(tid >> 6), lane = tid & 63, wr = wid >> 2, wc = wid & 3, fr = lane & 15, fq = lane >> 4;
    const int K = g.K, nt = K / BK;
    unsigned voffA[2], voffB[2];
#pragma unroll
    for (int i = 0; i < 2; ++i) { int R, C; stage_rc(tid * 16 + i * 8192, R, C); const int Rb = Epi::PERM ? ((R & ~31) + perm32(R & 31)) : R;
        voffA[i] = (unsigned)(R * g.lda + C) * 2u; voffB[i] = (unsigned)(Rb * g.ldb + C) * 2u; }
    const size_t kstep = (size_t)(BK * 2);
    const size_t hstepA = (size_t)HALF * g.lda * 2, hstepB = (size_t)HALF * g.ldb * 2;
    const size_t tstepA = 2 * hstepA, tstepB = 2 * hstepB;
    const unsigned ldsw = (unsigned)wid * 1024u;
    const int aoff = lds_byte(wr * 64 + fr, fq * 8), boff = lds_byte(wc * 32 + fr, fq * 8);
#define PG8_SA(b, h) (((b) * 2 + (h)) * HTB)
#define PG8_SB(b, h) ((4 + (b) * 2 + (h)) * HTB)
#define PG8_STAGE(bufoff, gbase, voff) do { _Pragma("unroll") for (int _i = 0; _i < 2; ++_i) \
        __builtin_amdgcn_global_load_lds((const unsigned*)((const char*)(gbase) + (voff)[_i]), (PG8_LAS unsigned*)(lds + (bufoff) + ldsw + _i * 8192), 16, 0, 0); } while (0)
#define PG8_STAGEX(bufoff, gbase) do { _Pragma("unroll") for (int _i = 0; _i < 2; ++_i) \
        __builtin_amdgcn_global_load_lds((const unsigned*)((const char*)(gbase) + (size_t)_i * 65536 + vX), (PG8_LAS unsigned*)(lds + (bufoff) + ldsw + _i * 8192), 16, 0, 0); } while (0)
#define PG8_LDA(dst, b, h) do { _Pragma("unroll") for (int m = 0; m < 4; ++m) _Pragma("unroll") for (int k = 0; k < 2; ++k) dst[m][k] = *(const PG8_LAS bf16x8*)(lds + PG8_SA(b, h) + aoff + m * 2048 + k * 1024); } while (0)
#define PG8_LDB(dst, b, h) do { _Pragma("unroll") for (int n = 0; n < 2; ++n) _Pragma("unroll") for (int k = 0; k < 2; ++k) dst[n][k] = *(const PG8_LAS bf16x8*)(lds + PG8_SB(b, h) + boff + n * 2048 + k * 1024); } while (0)
#define PG8_MMA(ai, bj, At, Bt) do { __builtin_amdgcn_s_setprio(1); _Pragma("unroll") for (int m = 0; m < 4; ++m) _Pragma("unroll") for (int n = 0; n < 2; ++n) _Pragma("unroll") for (int k = 0; k < 2; ++k) \
        acc[ai][bj][m][n] = __builtin_amdgcn_mfma_f32_16x16x32_bf16(Bt[n][k], At[m][k], acc[ai][bj][m][n], 0, 0, 0); __builtin_amdgcn_s_setprio(0); } while (0)
#define PG8_WAIT_V(n) asm volatile("s_waitcnt vmcnt(" #n ")" ::: "memory")
#define PG8_WAIT_L(n) asm volatile("s_waitcnt lgkmcnt(" #n ")" ::: "memory")
#define PG8_BAR __builtin_amdgcn_s_barrier()
#define PG8_SCHED __builtin_amdgcn_sched_barrier(0)
    Unit cur, nxt; int ui = 0;
    if (!S.next(0, cur)) return;
    f32x4 acc[2][2][4][2];
#pragma unroll
    for (int a = 0; a < 2; ++a)
#pragma unroll
        for (int b = 0; b < 2; ++b)
#pragma unroll
            for (int m = 0; m < 4; ++m)
#pragma unroll
                for (int n = 0; n < 2; ++n) acc[a][b][m][n] = (f32x4){0.f, 0.f, 0.f, 0.f};
    bf16x8 At[4][2], B0[2][2], B1[2][2];
    const char* cA = (const char*)(cur.ty ? g.A2 : g.A) + (size_t)cur.pm * tstepA; const char* cB = (const char*)(cur.ty ? g.Bt2 : g.Bt) + (size_t)cur.pn * tstepB;
    S.a_ready(cur);
    if constexpr (SP2) {
        PG8_STAGE(PG8_SB(0, 0), cB, voffB); PG8_STAGE(PG8_SB(0, 1), cB + hstepB, voffB); PG8_STAGE(PG8_SA(0, 0), cA, voffA); PG8_STAGE(PG8_SA(0, 1), cA + hstepA, voffA);
        if (wr == 1) PG8_BAR;
        PG8_WAIT_V(2); PG8_BAR;
        PG8_STAGE(PG8_SB(1, 0), cB + kstep, voffB); PG8_STAGE(PG8_SA(1, 0), cA + kstep, voffA); PG8_STAGE(PG8_SB(1, 1), cB + hstepB + kstep, voffB);
        PG8_WAIT_V(6); PG8_BAR;
    } else {
        PG8_STAGE(PG8_SB(0, 0), cB, voffB); PG8_STAGE(PG8_SA(0, 0), cA, voffA); PG8_STAGE(PG8_SB(0, 1), cB + hstepB, voffB); PG8_STAGE(PG8_SA(0, 1), cA + hstepA, voffA);
        if (wr == 1) PG8_BAR;
        PG8_WAIT_V(4); PG8_BAR;
        PG8_STAGE(PG8_SB(1, 0), cB + kstep, voffB); PG8_STAGE(PG8_SA(1, 0), cA + kstep, voffA); PG8_STAGE(PG8_SB(1, 1), cB + hstepB + kstep, voffB);
        PG8_WAIT_V(6); PG8_BAR;
    }
    for (;;) {
        const bool has_next = S.next(ui + 1, nxt);
        const char* nA = has_next ? (const char*)(nxt.ty ? g.A2 : g.A) + (size_t)nxt.pm * tstepA : cA; const char* nB = has_next ? (const char*)(nxt.ty ? g.Bt2 : g.Bt) + (size_t)nxt.pn * tstepB : cB;
        for (int t = 0; t < nt; t += 2) {
            const bool last = (t == nt - 2);
            const char* a1 = cA + (size_t)(t + 1) * kstep;
            const char* a2 = last ? nA : cA + (size_t)(t + 2) * kstep; const char* b2 = last ? nB : cB + (size_t)(t + 2) * kstep;
            const char* a3 = a2 + kstep; const char* b3 = b2 + kstep;
            size_t hsA = hstepA, hsB = hstepB;
            const bool pfx = PrefetchOf<Epi>::v && last && !has_next;
            if constexpr (PrefetchOf<Epi>::v) { if (pfx) { const char* xb = E.prefetch_base(cur); b2 = xb; a2 = xb + 2 * 131072; b3 = xb + 4 * 131072; a3 = xb + 6 * 131072; hsA = hsB = 131072; } }
            if (last && has_next) S.a_ready(nxt);
            if constexpr (SP2) {
            PG8_LDB(B0, 0, 0); PG8_LDB(B1, 0, 1); PG8_SCHED; PG8_LDA(At, 0, 0); PG8_STAGE(PG8_SA(1, 1), a1 + hstepA, voffA);
            if constexpr (PrefetchOf<Epi>::v) {
                int l_ = lane; asm volatile("" : "+v"(l_));
                const unsigned rho_ = 2u * (unsigned)wid + ((unsigned)l_ >> 5), vX = rho_ * 4096u + ((((unsigned)l_ & 31u) ^ ((rho_ & 7u) << 2)) << 4);
                voffA[0] = pfx ? vX : voffA[0]; voffB[0] = pfx ? vX : voffB[0]; voffA[1] = pfx ? vX + 65536u : voffA[1]; voffB[1] = pfx ? vX + 65536u : voffB[1];
            }
            PG8_WAIT_V(8); PG8_WAIT_L(0); PG8_BAR; PG8_MMA(0, 0, At, B0); PG8_MMA(0, 1, At, B1); PG8_BAR; PG8_SCHED;
            PG8_LDA(At, 0, 1); PG8_STAGE(PG8_SB(0, 0), b2, voffB); PG8_STAGE(PG8_SB(0, 1), b2 + hsB, voffB); PG8_STAGE(PG8_SA(0, 0), a2, voffA);
            PG8_WAIT_V(8); PG8_WAIT_L(0); PG8_BAR; PG8_MMA(1, 0, At, B0); PG8_MMA(1, 1, At, B1); PG8_BAR; PG8_SCHED;
            PG8_LDB(B0, 1, 0); PG8_LDB(B1, 1, 1); PG8_SCHED; PG8_LDA(At, 1, 0); PG8_STAGE(PG8_SA(0, 1), a2 + hsA, voffA);
            PG8_WAIT_V(8); PG8_WAIT_L(0); PG8_BAR; PG8_MMA(0, 0, At, B0); PG8_MMA(0, 1, At, B1); PG8_BAR; PG8_SCHED;
            PG8_LDA(At, 1, 1); PG8_STAGE(PG8_SB(1, 0), b3, voffB); PG8_STAGE(PG8_SB(1, 1), b3 + hsB, voffB); PG8_STAGE(PG8_SA(1, 0), a3, voffA);
            PG8_WAIT_V(8); PG8_WAIT_L(0); PG8_BAR; PG8_MMA(1, 0, At, B0); PG8_MMA(1, 1, At, B1); PG8_BAR; PG8_SCHED;
            } else {
            PG8_LDB(B0, 0, 0); PG8_SCHED; PG8_LDA(At, 0, 0); PG8_STAGE(PG8_SA(1, 1), a1 + hstepA, voffA);
            PG8_WAIT_L(8); PG8_BAR; PG8_WAIT_L(0); PG8_MMA(0, 0, At, B0); PG8_BAR; PG8_SCHED;
            PG8_LDB(B1, 0, 1); PG8_STAGE(PG8_SB(0, 0), b2, voffB);
            PG8_BAR; PG8_WAIT_L(0); PG8_MMA(0, 1, At, B1); PG8_BAR;
            PG8_LDA(At, 0, 1); PG8_STAGE(PG8_SA(0, 0), a2, voffA);
            PG8_BAR; PG8_WAIT_L(0); PG8_MMA(1, 0, At, B0); PG8_BAR; PG8_SCHED;
            PG8_STAGE(PG8_SB(0, 1), b2 + hstepB, voffB);
            PG8_WAIT_V(6); PG8_BAR; PG8_MMA(1, 1, At, B1); PG8_BAR;
            PG8_LDB(B0, 1, 0); PG8_SCHED; PG8_LDA(At, 1, 0); PG8_STAGE(PG8_SA(0, 1), a2 + hstepA, voffA);
            PG8_WAIT_L(8); PG8_BAR; PG8_WAIT_L(0); PG8_MMA(0, 0, At, B0); PG8_BAR; PG8_SCHED;
            PG8_LDB(B1, 1, 1); PG8_STAGE(PG8_SB(1, 0), b3, voffB);
            PG8_BAR; PG8_WAIT_L(0); PG8_MMA(0, 1, At, B1); PG8_BAR;
            PG8_LDA(At, 1, 1); PG8_STAGE(PG8_SA(1, 0), a3, voffA);
            PG8_BAR; PG8_WAIT_L(0); PG8_MMA(1, 0, At, B0); PG8_BAR; PG8_SCHED;
            PG8_STAGE(PG8_SB(1, 1), b3 + hstepB, voffB);
            PG8_WAIT_V(6); PG8_BAR; PG8_MMA(1, 1, At, B1); PG8_BAR;
            }
        }
        if constexpr (ALIGN_EPI) { if (wr == 0) PG8_BAR; }
        if constexpr (PrefetchOf<Epi>::v) E.pf = has_next ? 0 : 1;
        if constexpr (!Epi::AFTER_DRAIN) { E(acc, cur, wr, wc, fr, fq); S.done(cur); }
        if (!has_next) break;
#pragma unroll
        for (int a = 0; a < 2; ++a)
#pragma unroll
            for (int b = 0; b < 2; ++b)
#pragma unroll
                for (int m = 0; m < 4; ++m)
#pragma unroll
                    for (int n = 0; n < 2; ++n) acc[a][b][m][n] = (f32x4){0.f, 0.f, 0.f, 0.f};
        cur = nxt; cA = nA; cB = nB; ++ui;
        if constexpr (ALIGN_EPI) { if (wr == 1) PG8_BAR; }
    }
    PG8_WAIT_V(0);
    if constexpr (!ALIGN_EPI) { if (wr == 0) PG8_BAR; }
    PG8_BAR;
    if constexpr (Epi::AFTER_DRAIN) { E.fused(acc, cur, wr, wc, fr, fq, lds, wid, lane); S.done(cur); }
#undef PG8_SA
#undef PG8_SB
#undef PG8_STAGE
#undef PG8_STAGEX
#undef PG8_LDA
#undef PG8_LDB
#undef PG8_MMA
#undef PG8_WAIT_V
#undef PG8_WAIT_L
#undef PG8_BAR
#undef PG8_SCHED
}
}
#define GAS __attribute__((address_space(1)))
#define LAS __attribute__((address_space(3)))
typedef unsigned short bf16;
typedef unsigned v4u __attribute__((ext_vector_type(4)));
typedef float f32x4 __attribute__((ext_vector_type(4)));
typedef short bf16x8 __attribute__((ext_vector_type(8)));
typedef GAS unsigned gu32;
typedef GAS unsigned long long gu64;
#define RLX_AGENT __ATOMIC_RELAXED, __HIP_MEMORY_SCOPE_AGENT
#define LDS_WAIT() asm volatile("s_waitcnt lgkmcnt(0)" ::: "memory")
#define VM_WAIT() asm volatile("s_waitcnt vmcnt(0)" ::: "memory")
__device__ __forceinline__ unsigned long long rt() { return __builtin_amdgcn_s_memrealtime(); }
__device__ __forceinline__ unsigned f2bf(float f) { unsigned u = __builtin_bit_cast(unsigned, f); return (u + 0x7fffu + ((u >> 16) & 1u)) >> 16; }
__device__ __forceinline__ unsigned pk2(float lo, float hi) { return f2bf(lo) | (f2bf(hi) << 16); }

#define XB_TMO      128
#define XB_XCNT(j)  (256  + 64 * (j))
#define XB_XSUB(j)  (1280 + 64 * (j))
#define XB_XGEN(j)  (2304 + 64 * (j))
#define XB_TOP      3328
#define XB_TOPGEN   3392
#define XCD_BAR_WORDS 3456
#define XB_SPIN_CAP (1u << 18)

__device__ __forceinline__ unsigned xb_ld(unsigned* p)              { return __hip_atomic_load(p, __ATOMIC_RELAXED, __HIP_MEMORY_SCOPE_AGENT); }
__device__ __forceinline__ unsigned xb_add(unsigned* p, unsigned v) { return __hip_atomic_fetch_add(p, v, __ATOMIC_RELAXED, __HIP_MEMORY_SCOPE_AGENT); }
__device__ __forceinline__ unsigned xb_xcc_id() { return (unsigned)__builtin_amdgcn_s_getreg((3 << 11) | 20) & 0xFu; }
#define XB_SPIN(cond, bar) do { unsigned _sp = 0; while (cond) { __builtin_amdgcn_s_sleep(1); \
    if ((++_sp & 255u) == 0u) { if (xb_ld(&(bar)[XB_TMO])) break; if (_sp > XB_SPIN_CAP) { atomicAdd(&(bar)[XB_TMO], 1u); break; } } } } while (0)

struct XcdBarrier {
    unsigned* bar; unsigned x;
    volatile LAS unsigned* st;
};

__device__ __forceinline__ XcdBarrier xcd_barrier_post(unsigned* bar, volatile LAS unsigned* st) {
    XcdBarrier b; b.bar = bar; b.x = xb_xcc_id(); b.st = st;
    if (threadIdx.x == 0) (void)xb_add(&bar[XB_XCNT(b.x)], 1u);
    return b;
}
__device__ __forceinline__ void xcd_barrier_complete(unsigned* bar, unsigned x, unsigned& nloc, unsigned& nx) {
    const unsigned G = gridDim.x * gridDim.y * gridDim.z;
    unsigned sum, cnt, mine, sp = 0u;
    for (;;) {
        sum = 0u; cnt = 0u; mine = 0u;
#pragma unroll
        for (unsigned j = 0; j < 16; ++j) { const unsigned c = xb_ld(&bar[XB_XCNT(j)]); sum += c; cnt += (c > 0u) ? 1u : 0u; mine = (j == x) ? c : mine; }
        if (sum == G) break;
        __builtin_amdgcn_s_sleep(1);
        if ((++sp & 255u) == 0u) { if (xb_ld(&bar[XB_TMO])) break; if (sp > XB_SPIN_CAP) { atomicAdd(&bar[XB_TMO], 1u); break; } }
    }
    nloc = mine > 0u ? mine : 1u; nx = cnt > 0u ? cnt : 1u;
}

__device__ __forceinline__ void xcd_barrier(const XcdBarrier& b) {
    asm volatile("s_waitcnt vmcnt(0)" ::: "memory");
    __syncthreads();
    if (threadIdx.x == 0) {
        unsigned* bar = b.bar;
        __builtin_amdgcn_s_waitcnt(0);
        unsigned nloc = b.st[0], nx = b.st[1];
        if (nloc == 0u) { xcd_barrier_complete(bar, b.x, nloc, nx); b.st[0] = nloc; b.st[1] = nx; }
        const unsigned old = xb_add(&bar[XB_XSUB(b.x)], 1u);
        const unsigned gen = old / nloc;
        if (old + 1u == (gen + 1u) * nloc) {
            __builtin_amdgcn_fence(__ATOMIC_RELEASE, "agent");
            asm volatile("s_waitcnt vmcnt(0)" ::: "memory");
            const unsigned og = xb_add(&bar[XB_TOP], 1u);
            const unsigned tg = og / nx;
            if (og + 1u == (tg + 1u) * nx) xb_add(&bar[XB_TOPGEN], 1u);
            else XB_SPIN(xb_ld(&bar[XB_TOPGEN]) == tg, bar);
            __builtin_amdgcn_fence(__ATOMIC_ACQUIRE, "agent");
            xb_add(&bar[XB_XGEN(b.x)], 1u);
            asm volatile("s_waitcnt vmcnt(0)" ::: "memory");
        } else {
            XB_SPIN(xb_ld(&bar[XB_XGEN(b.x)]) == gen, bar);
            __builtin_amdgcn_fence(__ATOMIC_ACQUIRE, "agent");
            asm volatile("s_waitcnt vmcnt(0)" ::: "memory");
        }
    }
    __syncthreads();
}

constexpr int NWAVES = 8;
#ifndef MK_N_LAUNCHES
#define MK_N_LAUNCHES 1
#endif
constexpr int N_PHASES = 14;
constexpr int D = 1024, M = 32768, MP = 16384, SS = 4096;
constexpr int NG = 32, TCH = 32, NCG = 1024  , FF = 2816, NPROJ = 2048, NMOD = 6144, UP = 768  ;
constexpr float EPS = 1e-6f;
constexpr float LOG2E = 1.4426950408889634f, LN2F = 0.6931471805599453f;
constexpr float QSCALE = 0.125f * LOG2E;
constexpr double INV_2PI = 0.15915494309189533577;

constexpr size_t MiB = 1u << 20;
constexpr size_t WS_CTL = 0, CTL_ZERO_BYTES = 262144;
constexpr size_t WS_MODF = 262144;
constexpr size_t WS_XBUF = 524288;
constexpr size_t WS_LDRE = 393216, WS_ZRE = 409600, WS_ZIM = 425984, WS_ATRE = 442368, WS_ATIM = 458752, WS_THETA = 475136;
constexpr size_t WS_W13 = 1 * MiB;
constexpr size_t WS_PTAB = 12 * MiB, WS_SBUF = 20 * MiB, WS_WIN = 52 * MiB, WS_ROPE = 56 * MiB, WS_MODP = 60 * MiB, WS_WGLU = 254 * MiB, WS_WO = 252 * MiB, WS_KLAG = 63 * MiB;
constexpr size_t WS_SSMRAW = 12 * MiB, WS_H2 = 12 * MiB, WS_W2 = 1 * MiB;
constexpr size_t WS_U = 76 * MiB, WS_Q = 124 * MiB, WS_K = 156 * MiB, WS_V = 188 * MiB, WS_TOEP = 124 * MiB, WS_G = 196 * MiB, WS_MIXA = 12 * MiB  , WS_ACT = 76 * MiB, WS_END = 255 * MiB;
constexpr size_t DO_H1 = 0, DO_OB = 0, DO_LSE = 96 * MiB, DO_TOEP = 100 * MiB;
constexpr int CW_ATTQ = 2048;
constexpr int CW_BAR = 4096, CW_SEAM = 16384, SEAM_BANK = 8192;
constexpr int PARAM_OFF = 131520;
constexpr int CW_W13 = CW_SEAM + 4 * SEAM_BANK + 4160, CW_WQ2 = CW_SEAM + 4 * SEAM_BANK + 4224;
constexpr int CW_TQ = CW_SEAM + 4 * SEAM_BANK + 4096;
constexpr int CW_SST = CW_SEAM + 4 * SEAM_BANK;
constexpr int CW_READY = CW_SEAM + 3 * SEAM_BANK;
constexpr int XLDS_OFF = 131584;

constexpr int RING_OFF = 0, RING_BYTES = 131072;
constexpr int LDSCTL_OFF = RING_BYTES, MISC_OFF = LDSCTL_OFF + 320;
constexpr int LDS_BYTES = 147456;

typedef short v4i16_t __attribute__((ext_vector_type(4)));
typedef unsigned v2u __attribute__((ext_vector_type(2)));
typedef float f32x2v __attribute__((ext_vector_type(2)));

struct Args { const float* in[26]; float* out; unsigned char* ws; int ph_lo, ph_hi; };

template <int CTRL> __device__ __forceinline__ float dpp_f(float v) { return __int_as_float(__builtin_amdgcn_mov_dpp(__float_as_int(v), CTRL, 0xF, 0xF, true)); }
__device__ __forceinline__ float wave_sum(float v) {
    v += dpp_f<0xB1>(v); v += dpp_f<0x4E>(v); v += dpp_f<0x141>(v); v += dpp_f<0x140>(v);
    { auto r_ = __builtin_amdgcn_permlane16_swap(__float_as_uint(v), __float_as_uint(v), false, false); v = __uint_as_float(r_[0]) + __uint_as_float(r_[1]); }
    { auto q_ = __builtin_amdgcn_permlane32_swap(__float_as_uint(v), __float_as_uint(v), false, false); v = __uint_as_float(q_[0]) + __uint_as_float(q_[1]); }
    return v;
}
__device__ __forceinline__ float fexp2(float x) { return __builtin_amdgcn_exp2f(x); }
__device__ __forceinline__ float frcp(float x) { return __builtin_amdgcn_rcpf(x); }
__device__ __forceinline__ float sigm(float x) { return frcp(1.f + fexp2(-x * LOG2E)); }
__device__ __forceinline__ float gelu_tanh(float x) { const float u = 1.5957691216057308f * (x + 0.044715f * x * x * x); return x * sigm(u); }
__device__ __forceinline__ void sincos_rev(double revs, float& s, float& c) { const double fr = revs - __builtin_rint(revs); const float f = (float)fr; s = __builtin_amdgcn_sinf(f); c = __builtin_amdgcn_cosf(f); }
__device__ __forceinline__ float bf2f(unsigned short h) { return __builtin_bit_cast(float, (unsigned)h << 16); }
__device__ __forceinline__ void st16_wt(void* p, const pg8::u32x4& v) { asm volatile("global_store_dwordx4 %0, %1, off sc1\n\ts_nop 1" :: "v"(p), "v"(v) : "memory"); }
__device__ __forceinline__ float bflo(unsigned w) { return __builtin_bit_cast(float, w << 16); }
__device__ __forceinline__ float bfhi(unsigned w) { return __builtin_bit_cast(float, w & 0xffff0000u); }
__device__ __forceinline__ int batch_of(int row) { return row < MP ? 0 : 1 + ((row - MP) >> 12); }
__device__ __forceinline__ const float* xrow_ptr(const Args& a, int row) { return row < MP ? a.in[0] + (size_t)row * D : a.in[1] + (size_t)(row - MP) * D; }

struct SchedState {
    int c; unsigned* sst;
    __device__ bool next(int i, pg8::Unit& u) const { if (i > 0 || c >= 128) return false; u.pm = c; u.pn = c >> 2; return true; }
    __device__ __forceinline__ void a_ready(const pg8::Unit&) const {}
    __device__ __forceinline__ void done(const pg8::Unit& u) const {
        asm volatile("s_waitcnt vmcnt(0)" ::: "memory");
        if ((threadIdx.x & 63) == 0) __hip_atomic_fetch_add(sst + 64 * u.pn, 1u, __ATOMIC_RELAXED, __HIP_MEMORY_SCOPE_AGENT);
    }
};
struct SchedSsmOut {
    int c;
    __device__ bool next(int i, pg8::Unit& u) const { if (i > 0 || c >= 256) return false; const int g = c >> 3; u.pm = 4 * g + ((c >> 1) & 3); u.pn = 2 * g + (c & 1); return true; }
    __device__ __forceinline__ void a_ready(const pg8::Unit&) const {}
    __device__ __forceinline__ void done(const pg8::Unit&) const {}
};

#ifndef DUP_MASK
#define DUP_MASK 0
#endif
template <int DUP> struct DupOrder {
    pg8::StaticOrder S;
    __device__ bool next(int i, pg8::Unit& u) const { if (DUP == 2) { pg8::Unit t; int n = 0; while (S.next(n, t)) ++n; return i < 2 * n ? S.next(i % n, u) : false; } return S.next(DUP ? (i >> 1) : i, u); }
    __device__ __forceinline__ void a_ready(const pg8::Unit&) const {}
    __device__ __forceinline__ void done(const pg8::Unit&) const {}
};
struct OneUnit {
    pg8::StaticOrder S; int first, count;
    __device__ bool next(int i, pg8::Unit& u) const { return i < count ? S.next(first + i, u) : false; }
    __device__ __forceinline__ void a_ready(const pg8::Unit&) const {}
    __device__ __forceinline__ void done(const pg8::Unit&) const {}
};
struct SchedWoUp {
    int c; const unsigned* ready; int base, count;
    mutable int seen = -1;
    __device__ bool next(int i0, pg8::Unit& u) const {
        if (i0 >= count) return false;
        const int i = base + i0;
        const int x = c & 7, j = c >> 3, t = 1 + (x % 5), P0 = 16 * x;
        if (i == 0) { u.ty = 0; u.pm = P0 + (j & 7); u.pn = j >> 3; return true; }
        if (i == t) { u.ty = 0; u.pm = P0 + 8 + (j & 7); u.pn = j >> 3; return true; }
        u.ty = 1;
        if (i == 12) { if (j < 16) { u.pm = P0 + (j & 7); u.pn = 20 + (j >> 3); } else { u.pm = P0 + 8 + (j & 7); u.pn = 20 + ((j - 16) >> 3); } return true; }
        const int k = i - 1 - (i > t ? 1 : 0), half = k / 5, b = k % 5;
        u.pm = P0 + 8 * half + (j & 7); u.pn = 4 * b + (j >> 3); return true;
    }
    __device__ __forceinline__ void a_ready(const pg8::Unit& u) const {
        if (u.ty != 1 || u.pm == seen) return;
        seen = u.pm;
        if (threadIdx.x < 64) {
            unsigned sp = 0;
            while ((unsigned)__builtin_amdgcn_readfirstlane(__hip_atomic_load(ready + 64 * u.pm, __ATOMIC_RELAXED, __HIP_MEMORY_SCOPE_AGENT)) < 32u) { __builtin_amdgcn_s_sleep(2); if (++sp > (1u << 22)) break; }
            __builtin_amdgcn_fence(__ATOMIC_ACQUIRE, "agent");
            asm volatile("s_waitcnt vmcnt(0)" ::: "memory");
        }
        asm volatile("" ::: "memory"); __builtin_amdgcn_s_barrier(); asm volatile("" ::: "memory");
    }
    __device__ __forceinline__ void done(const pg8::Unit& u) const {
        if (u.ty == 1 && u.pn >= 16 && u.pn < 20 && (u.pm & 8) && threadIdx.x == 0) __hip_atomic_fetch_add((unsigned*)ready + (CW_W13 - CW_READY), 1u, __ATOMIC_RELAXED, __HIP_MEMORY_SCOPE_AGENT);
    }
};
using pg8::f32x4; using pg8::u32x4; using pg8::cvt_pk_bf16;
#define EPI_ROWS(u, ai, m) ((u).pm * 256 + (ai) * 128 + wr * 64 + (m) * 16 + fr)
__device__ __forceinline__ u32x4 pack8(const f32x4& a, const f32x4& b) { u32x4 w; w.x = cvt_pk_bf16(a[0], a[1]); w.y = cvt_pk_bf16(a[2], a[3]); w.z = cvt_pk_bf16(b[0], b[1]); w.w = cvt_pk_bf16(b[2], b[3]); return w; }

struct EpiQKV {
    static constexpr bool PERM = true, AFTER_DRAIN = false;
    bf16 *Q, *K, *V, *U; const float *cosT, *sinT;
    __device__ __forceinline__ void operator()(const f32x4 (&acc)[2][2][4][2], const pg8::Unit& u, int wr, int wc, int fr, int fq) const {
        const int kind = u.pn >> 1, ph = u.pn & 1;
        if (kind < 2) {
            bf16* dst0 = kind == 0 ? Q : K; const float sc = kind == 0 ? QSCALE : 1.f;
            const int i0 = 16 * (wc & 1) + 4 * fq;
#pragma unroll
            for (int ai = 0; ai < 2; ++ai)
#pragma unroll
                for (int m = 0; m < 4; ++m) {
                    const int row = EPI_ROWS(u, ai, m); const int pos = row < MP ? row : ((row - MP) & (SS - 1));
                    const f32x4 cs = *(const f32x4*)(cosT + pos * 32 + i0), sn = *(const f32x4*)(sinT + pos * 32 + i0);
#pragma unroll
                    for (int bj = 0; bj < 2; ++bj) {
                        const int head = ph * 4 + bj * 2 + (wc >> 1);
                        const f32x4 x1 = acc[ai][bj][m][0], x2 = acc[ai][bj][m][1];
                        const f32x4 o1 = (x1 * cs - x2 * sn) * sc, o2 = (x2 * cs + x1 * sn) * sc;
                        const auto rx = __builtin_amdgcn_permlane16_swap(cvt_pk_bf16(o1[0], o1[1]), cvt_pk_bf16(o2[0], o2[1]), false, false);
                        const auto ry = __builtin_amdgcn_permlane16_swap(cvt_pk_bf16(o1[2], o1[3]), cvt_pk_bf16(o2[2], o2[3]), false, false);
                        bf16* d = dst0 + (size_t)row * 512 + head * 64 + ((fq & 1) ? 32 + i0 - 4 : i0);
                        *(u32x4*)d = (u32x4){rx[0], ry[0], rx[1], ry[1]};
                    }
                }
        } else {
#pragma unroll
            for (int ai = 0; ai < 2; ++ai)
#pragma unroll
                for (int m = 0; m < 4; ++m) {
                    const int row = EPI_ROWS(u, ai, m);
#pragma unroll
                    for (int bj = 0; bj < 2; ++bj) {
                        const int col = ph * 256 + bj * 128 + wc * 32 + 8 * fq;
                        const u32x4 w = pack8(acc[ai][bj][m][0], acc[ai][bj][m][1]);
                        if (kind == 2) *(u32x4*)(V + (size_t)row * 512 + col) = w;
                        else { const int g = col >> 4, c = col & 15; *(u32x4*)(U + ((size_t)(g * NCG + (row >> 5)) * UP + (row & 31) * 16 + c)) = w; }
                    }
                }
        }
    }
};
struct EpiState {
    static constexpr bool PERM = true, AFTER_DRAIN = false;
    bf16* S;
    __device__ __forceinline__ void operator()(const f32x4 (&acc)[2][2][4][2], const pg8::Unit& u, int wr, int wc, int fr, int fq) const {
        const int g = u.pn, mt = u.pm & 3;
#pragma unroll
        for (int ai = 0; ai < 2; ++ai)
#pragma unroll
            for (int m = 0; m < 4; ++m) {
                const int chunk = mt * 256 + ai * 128 + wr * 64 + m * 16 + fr;
#pragma unroll
                for (int bj = 0; bj < 2; ++bj) st16_wt(S + ((size_t)(g * NCG + chunk) * 256 + bj * 128 + wc * 32 + 8 * fq), pack8(acc[ai][bj][m][0], acc[ai][bj][m][1]));
            }
    }
};
struct EpiSsmOut {
    static constexpr bool PERM = true, AFTER_DRAIN = false;
    bf16* G;
    __device__ __forceinline__ void operator()(const f32x4 (&acc)[2][2][4][2], const pg8::Unit& u, int wr, int wc, int fr, int fq) const {
        const int g = u.pn >> 1, nt = u.pn & 1, mt = u.pm & 3;
#pragma unroll
        for (int ai = 0; ai < 2; ++ai)
#pragma unroll
            for (int m = 0; m < 4; ++m) {
                const int chunk = mt * 256 + ai * 128 + wr * 64 + m * 16 + fr;
#pragma unroll
                for (int bj = 0; bj < 2; ++bj) {
                    const int ncol = nt * 256 + bj * 128 + wc * 32 + 8 * fq, t = ncol >> 4, c0 = ncol & 15;
                    f32x4 a = acc[ai][bj][m][0], b = acc[ai][bj][m][1];
#pragma unroll
                    for (int e = 0; e < 4; ++e) { a[e] = gelu_tanh(a[e]); b[e] = gelu_tanh(b[e]); }
                    *(u32x4*)(G + (size_t)(chunk * TCH + t) * 512 + g * 16 + c0) = pack8(a, b);
                }
            }
    }
};
struct EpiGlu {
    static constexpr bool PERM = true, AFTER_DRAIN = false;
    const bf16* G; const float* bglu; bf16* O;
    __device__ __forceinline__ void operator()(const f32x4 (&acc)[2][2][4][2], const pg8::Unit& u, int wr, int wc, int fr, int fq) const {
#pragma unroll
        for (int bj = 0; bj < 2; ++bj) {
            const int col = u.pn * 256 + bj * 128 + wc * 32 + 8 * fq;
            const f32x4 b0 = *(const f32x4*)(bglu + col), b1 = *(const f32x4*)(bglu + col + 4);
#pragma unroll
            for (int ai = 0; ai < 2; ++ai)
#pragma unroll
                for (int m = 0; m < 4; ++m) {
                    const int row = EPI_ROWS(u, ai, m);
                    const u32x4 gv = *(const u32x4*)(G + (size_t)row * 512 + col);
                    const f32x4 z0 = acc[ai][bj][m][0] + b0, z1 = acc[ai][bj][m][1] + b1;
                    f32x4 o0, o1;
                    o0[0] = bflo(gv.x) * sigm(z0[0]); o0[1] = bfhi(gv.x) * sigm(z0[1]); o0[2] = bflo(gv.y) * sigm(z0[2]); o0[3] = bfhi(gv.y) * sigm(z0[3]);
                    o1[0] = bflo(gv.z) * sigm(z1[0]); o1[1] = bfhi(gv.z) * sigm(z1[1]); o1[2] = bflo(gv.w) * sigm(z1[2]); o1[3] = bfhi(gv.w) * sigm(z1[3]);
                    *(u32x4*)(O + (size_t)row * 512 + col) = pack8(o0, o1);
                }
        }
    }
};
struct EpiResid {
    static constexpr bool PERM = true, AFTER_DRAIN = false;
    const float* xp; const float* xs; float* out; const float* gate;
    int inplace;
    __device__ __forceinline__ void operator()(const f32x4 (&acc)[2][2][4][2], const pg8::Unit& u, int wr, int wc, int fr, int fq) const {
#pragma unroll
        for (int ai = 0; ai < 2; ++ai)
#pragma unroll
            for (int m = 0; m < 4; ++m) {
                const int row = EPI_ROWS(u, ai, m); const int b = batch_of(row);
                const float* base = inplace ? out + (size_t)row * D : (row < MP ? xp + (size_t)row * D : xs + (size_t)(row - MP) * D);
#pragma unroll
                for (int bj = 0; bj < 2; ++bj) {
                    const int col = u.pn * 256 + bj * 128 + wc * 32 + 8 * fq;
                    const f32x4 g0 = *(const f32x4*)(gate + b * NMOD + col), g1 = *(const f32x4*)(gate + b * NMOD + col + 4);
                    const f32x4 x0 = *(const f32x4*)(base + col), x1 = *(const f32x4*)(base + col + 4);
                    *(f32x4*)(out + (size_t)row * D + col) = x0 + g0 * acc[ai][bj][m][0];
                    *(f32x4*)(out + (size_t)row * D + col + 4) = x1 + g1 * acc[ai][bj][m][1];
                }
            }
    }
};
struct PB { const float* xp; const float* xs; float* out; unsigned char* ws; const float* p17; const float* p19; const float* p21; const float* p25; };
__device__ __forceinline__ PB load_pb(LAS unsigned char* lds) { asm volatile("" ::: "memory"); const LAS unsigned long long* p = (const LAS unsigned long long*)(lds + PARAM_OFF); PB r;
    r.xp = (const float*)p[0]; r.xs = (const float*)p[1]; r.out = (float*)p[2]; r.ws = (unsigned char*)p[3]; r.p17 = (const float*)p[4]; r.p19 = (const float*)p[5]; r.p21 = (const float*)p[6]; r.p25 = (const float*)p[7]; return r; }
template <int NTN, int BANK>
__device__ __forceinline__ void row_ssq_exchange(const f32x4 (&v)[2][2][4][2], const pg8::Unit& u, int wr, int wc, int fr, int fq, LAS unsigned char* ldsx, unsigned char* ws) {
    unsigned* xbuf = (unsigned*)(ws + WS_XBUF); unsigned* cnt = (unsigned*)(ws + WS_CTL) + CW_SEAM + BANK * SEAM_BANK + 64 * u.pm;
    int lane = threadIdx.x & 63; asm volatile("" : "+v"(lane)); const int wid = __builtin_amdgcn_readfirstlane(threadIdx.x >> 6);
    LAS float* P = (LAS float*)ldsx; LAS float* S = (LAS float*)(ldsx + 4096);
#pragma unroll
    for (int ai = 0; ai < 2; ++ai)
#pragma unroll
        for (int m = 0; m < 4; ++m) {
            float q = 0.f;
#pragma unroll
            for (int bj = 0; bj < 2; ++bj)
#pragma unroll
                for (int n = 0; n < 2; ++n) { const f32x4 x = v[ai][bj][m][n]; q += (x[0] * x[0] + x[1] * x[1]) + (x[2] * x[2] + x[3] * x[3]); }
            { auto r_ = __builtin_amdgcn_permlane16_swap(__float_as_uint(q), __float_as_uint(q), false, false); q = __uint_as_float(r_[0]) + __uint_as_float(r_[1]);
              auto q_ = __builtin_amdgcn_permlane32_swap(__float_as_uint(q), __float_as_uint(q), false, false); q = __uint_as_float(q_[0]) + __uint_as_float(q_[1]); }
            if (fq == 0) P[(ai * 128 + wr * 64 + m * 16 + fr) * 4 + wc] = q;
        }
    asm volatile("s_waitcnt lgkmcnt(0)" ::: "memory"); __builtin_amdgcn_s_barrier(); asm volatile("" ::: "memory");
    const int row = wid * 32 + (lane & 31);
    if (lane < 32) { const float t = (P[row * 4 + 0] + P[row * 4 + 1]) + (P[row * 4 + 2] + P[row * 4 + 3]);
        __hip_atomic_store(xbuf + ((size_t)(u.pm * 256 + row) * 4 + (u.pn & 3)), __float_as_uint(t), __ATOMIC_RELAXED, __HIP_MEMORY_SCOPE_AGENT); }
    asm volatile("s_waitcnt vmcnt(0)" ::: "memory");
    if (lane == 0) __hip_atomic_fetch_add(cnt, 1u, __ATOMIC_RELAXED, __HIP_MEMORY_SCOPE_AGENT);
    if (wid == 0) {
        unsigned sp = 0;
        while ((unsigned)__builtin_amdgcn_readfirstlane(__hip_atomic_load(cnt, __ATOMIC_RELAXED, __HIP_MEMORY_SCOPE_AGENT)) < 8u * NTN) { __builtin_amdgcn_s_sleep(1); if (++sp > (1u << 22)) break; }
    }
    asm volatile("s_waitcnt vmcnt(0) lgkmcnt(0)" ::: "memory"); __builtin_amdgcn_s_barrier(); asm volatile("" ::: "memory");
    if (lane < 32) { float t = 0.f;
#pragma unroll
        for (int k = 0; k < NTN; ++k) t += __uint_as_float(__hip_atomic_load(xbuf + ((size_t)(u.pm * 256 + row) * 4 + k), __ATOMIC_RELAXED, __HIP_MEMORY_SCOPE_AGENT));
        S[row] = __builtin_amdgcn_rsqf(t * (1.f / (256.f * NTN)) + EPS); }
    asm volatile("s_waitcnt lgkmcnt(0)" ::: "memory"); __builtin_amdgcn_s_barrier(); asm volatile("" ::: "memory");
}
struct EpiGluNorm {
    static constexpr bool PERM = true, AFTER_DRAIN = false;
    LAS unsigned char* lds;
    __device__ __forceinline__ void operator()(f32x4 (&acc)[2][2][4][2], const pg8::Unit& u, int wr, int wc, int fr, int fq) const {
        asm volatile("" : "+v"(fr), "+v"(fq));
        const PB pb = load_pb(lds); const bf16* G = (const bf16*)(pb.ws + WS_G); bf16* O = (bf16*)(pb.ws + WS_MIXA);
#pragma unroll
        for (int bj = 0; bj < 2; ++bj) {
            const int col = u.pn * 256 + bj * 128 + wc * 32 + 8 * fq;
            const f32x4 b0 = *(const f32x4*)(pb.p17 + col), b1 = *(const f32x4*)(pb.p17 + col + 4);
#pragma unroll
            for (int ai = 0; ai < 2; ++ai)
#pragma unroll
                for (int m = 0; m < 4; ++m) {
                    const int row = EPI_ROWS(u, ai, m);
                    const u32x4 gv = *(const u32x4*)(G + (size_t)row * 512 + col);
                    const f32x4 z0 = acc[ai][bj][m][0] + b0, z1 = acc[ai][bj][m][1] + b1;
                    f32x4 o0, o1;
                    o0[0] = bflo(gv.x) * sigm(z0[0]); o0[1] = bfhi(gv.x) * sigm(z0[1]); o0[2] = bflo(gv.y) * sigm(z0[2]); o0[3] = bfhi(gv.y) * sigm(z0[3]);
                    o1[0] = bflo(gv.z) * sigm(z1[0]); o1[1] = bfhi(gv.z) * sigm(z1[1]); o1[2] = bflo(gv.w) * sigm(z1[2]); o1[3] = bfhi(gv.w) * sigm(z1[3]);
                    acc[ai][bj][m][0] = o0; acc[ai][bj][m][1] = o1;
                    asm volatile("" : "+v"(acc[ai][bj][m][0]), "+v"(acc[ai][bj][m][1]));
                    if (m == 3) asm volatile("" ::: "memory");
                }
        }
        f32x4 gg[2][2];
#pragma unroll
        for (int bj = 0; bj < 2; ++bj) { const int col = u.pn * 256 + bj * 128 + wc * 32 + 8 * fq; gg[bj][0] = *(const f32x4*)(pb.p19 + col); gg[bj][1] = *(const f32x4*)(pb.p19 + col + 4); }
        row_ssq_exchange<2, 0>(acc, u, wr, wc, fr, fq, lds + XLDS_OFF, pb.ws);
        const LAS float* S = (const LAS float*)(lds + XLDS_OFF + 4096);
#pragma unroll
        for (int bj = 0; bj < 2; ++bj) {
            const int col = u.pn * 256 + bj * 128 + wc * 32 + 8 * fq;
            const f32x4 g0 = gg[bj][0], g1 = gg[bj][1];
#pragma unroll
            for (int ai = 0; ai < 2; ++ai)
#pragma unroll
                for (int m = 0; m < 4; ++m) {
                    const int rl = ai * 128 + wr * 64 + m * 16 + fr; const float rs = S[rl];
                    *(u32x4*)(O + (size_t)(u.pm * 256 + rl) * D + 512 + col) = pack8(acc[ai][bj][m][0] * rs * g0, acc[ai][bj][m][1] * rs * g1);
                }
        }
    }
};
struct EpiWoH2 {
    static constexpr bool PERM = true, AFTER_DRAIN = false;
    LAS unsigned char* lds;
    __device__ __forceinline__ void operator()(f32x4 (&acc)[2][2][4][2], const pg8::Unit& u, int wr, int wc, int fr, int fq) const {
        asm volatile("" : "+v"(fr), "+v"(fq));
        const PB pb = load_pb(lds);
        unsigned char* wsu = (unsigned char*)(((unsigned long long)(unsigned)__builtin_amdgcn_readfirstlane((int)((unsigned long long)pb.ws >> 32)) << 32) | (unsigned)__builtin_amdgcn_readfirstlane((int)(unsigned long long)pb.ws));
        const __amdgpu_buffer_rsrc_t h2r = __builtin_amdgcn_make_buffer_rsrc((void*)(wsu + WS_H2), (short)0, (int)((size_t)M * D * 2), 0x00020000);
        const int b = batch_of(u.pm * 256); const float* mb = (const float*)(pb.ws + WS_MODF) + b * NMOD;
#pragma unroll
        for (int bj = 0; bj < 2; ++bj) {
            const int col = u.pn * 256 + bj * 128 + wc * 32 + 8 * fq;
            const f32x4 g0 = *(const f32x4*)(mb + 2048 + col), g1 = *(const f32x4*)(mb + 2048 + col + 4);
#pragma unroll
            for (int ai = 0; ai < 2; ++ai)
#pragma unroll
                for (int m = 0; m < 4; ++m) {
                    const int row = EPI_ROWS(u, ai, m);
                    const float* base = (row < MP ? pb.xp + (size_t)row * D : pb.xs + (size_t)(row - MP) * D) + col;
                    const f32x4 x0 = *(const f32x4*)base, x1 = *(const f32x4*)(base + 4);
                    const f32x4 r0 = x0 + g0 * acc[ai][bj][m][0], r1 = x1 + g1 * acc[ai][bj][m][1];
                    acc[ai][bj][m][0] = r0; acc[ai][bj][m][1] = r1;
                    *(u32x4*)((unsigned char*)pb.out + (size_t)row * (D * 4) + 2048 + col * 2) = pack8(r0, r1);
                    if (ai == 1 && m == 3) asm volatile("" ::: "memory");
                }
        }
        f32x4 hg[2][4];
#pragma unroll
        for (int bj = 0; bj < 2; ++bj) { const int col = u.pn * 256 + bj * 128 + wc * 32 + 8 * fq;
            hg[bj][0] = *(const f32x4*)(pb.p21 + col) * (*(const f32x4*)(mb + 4096 + col) + 1.f); hg[bj][1] = *(const f32x4*)(pb.p21 + col + 4) * (*(const f32x4*)(mb + 4096 + col + 4) + 1.f);
            hg[bj][2] = *(const f32x4*)(mb + 3072 + col); hg[bj][3] = *(const f32x4*)(mb + 3072 + col + 4); }
        row_ssq_exchange<4, 1>(acc, u, wr, wc, fr, fq, lds + XLDS_OFF, pb.ws);
        const LAS float* S = (const LAS float*)(lds + XLDS_OFF + 4096);
#pragma unroll
        for (int bj = 0; bj < 2; ++bj) {
            const int col = u.pn * 256 + bj * 128 + wc * 32 + 8 * fq;
            const f32x4 gm0 = hg[bj][0], gm1 = hg[bj][1];
            const f32x4 sh0 = hg[bj][2], sh1 = hg[bj][3];
#pragma unroll
            for (int ai = 0; ai < 2; ++ai)
#pragma unroll
                for (int m = 0; m < 4; ++m) {
                    const int rl = ai * 128 + wr * 64 + m * 16 + fr; const float rs = S[rl];
                    __builtin_amdgcn_raw_buffer_store_b128(pack8(acc[ai][bj][m][0] * rs * gm0 + sh0, acc[ai][bj][m][1] * rs * gm1 + sh1), h2r, (int)(((size_t)(u.pm * 256 + rl) * D + col) * 2), 0, 16);
                }
        }
        asm volatile("s_waitcnt vmcnt(0)" ::: "memory");
        if ((threadIdx.x & 63) == 0) __hip_atomic_fetch_add((unsigned*)(pb.ws + WS_CTL) + CW_READY + 64 * u.pm, 1u, __ATOMIC_RELAXED, __HIP_MEMORY_SCOPE_AGENT);
    }
};
struct EpiDownFinal {
    static constexpr bool PERM = true, AFTER_DRAIN = false, PREFETCH = true;
    LAS unsigned char* lds;
    mutable int pf = 0;
    __device__ __forceinline__ const char* prefetch_base(const pg8::Unit& u) const {
        const LAS unsigned long long* p = (const LAS unsigned long long*)(lds + PARAM_OFF); const unsigned long long o = p[2];
        const unsigned long long ou = ((unsigned long long)(unsigned)__builtin_amdgcn_readfirstlane((int)(o >> 32)) << 32) | (unsigned)__builtin_amdgcn_readfirstlane((int)o);
        return (const char*)ou + (size_t)u.pm * (256 * 4096) + 2048 + u.pn * 512;
    }
    static __device__ __forceinline__ constexpr int slot_of(int k) { return k < 2 ? 4 + k : k < 4 ? k - 2 : k < 6 ? k + 2 : 2; }
    __device__ __forceinline__ void operator()(f32x4 (&acc)[2][2][4][2], const pg8::Unit& u, int wr, int wc, int fr, int fq) const {
        asm volatile("" : "+v"(fr), "+v"(fq));
        const PB pb = load_pb(lds);
        const int b = batch_of(u.pm * 256); const float* mb = (const float*)(pb.ws + WS_MODF) + b * NMOD;
        const bool keep = false;
        const bool pfd = pf != 0;
        f32x4 gq[2][2]; u32x4 xg[2][2];
#pragma unroll
        for (int bj = 0; bj < 2; ++bj) { const int col = u.pn * 256 + bj * 128 + wc * 32 + 8 * fq;
            gq[bj][0] = *(const f32x4*)(mb + 5120 + col); gq[bj][1] = *(const f32x4*)(mb + 5120 + col + 4);
#pragma unroll
            for (int mm = 0; mm < 2; ++mm) xg[bj][mm] = (u32x4){0u, 0u, 0u, 0u};
            if (pfd && wr == 1) {
#pragma unroll
                for (int mm = 0; mm < 2; ++mm) xg[bj][mm] = *(const u32x4*)((const unsigned char*)pb.out + (size_t)EPI_ROWS(u, 1, 2 + mm) * (D * 4) + 2048 + col * 2); } }
        if (pfd) { asm volatile("s_waitcnt vmcnt(0)" ::: "memory"); __builtin_amdgcn_s_barrier(); asm volatile("" ::: "memory"); }
#pragma unroll
        for (int bj = 0; bj < 2; ++bj) {
            const int col = u.pn * 256 + bj * 128 + wc * 32 + 8 * fq;
            const f32x4 g0 = gq[bj][0], g1 = gq[bj][1];
            const LAS unsigned char* lp = lds + fr * 512 + (((16 * bj + 4 * wc + fq) ^ ((fr & 7) << 2)) << 4);
#pragma unroll
            for (int ai = 0; ai < 2; ++ai)
#pragma unroll
                for (int m = 0; m < 4; ++m) {
                    u32x4 xw;
                    const int kq = 4 * ai + (m >> 1);
                    if (pfd && !(kq == 5 && wr == 1)) {
                        const int so = (wr ? slot_of(kq + 2 > 6 ? 6 : kq + 2) : slot_of(kq)) * 16384 + (m & 1) * 8192;
                        xw = *(const LAS u32x4*)(lp + so);
                    } else if (pfd) xw = xg[bj][m & 1];
                    else xw = *(const u32x4*)((const unsigned char*)pb.out + (size_t)EPI_ROWS(u, ai, m) * (D * 4) + 2048 + col * 2);
                    const f32x4 x0 = {bflo(xw.x), bfhi(xw.x), bflo(xw.y), bfhi(xw.y)}, x1 = {bflo(xw.z), bfhi(xw.z), bflo(xw.w), bfhi(xw.w)};
                    acc[ai][bj][m][0] = x0 + g0 * acc[ai][bj][m][0]; acc[ai][bj][m][1] = x1 + g1 * acc[ai][bj][m][1];
                    asm volatile("" : "+v"(acc[ai][bj][m][0]), "+v"(acc[ai][bj][m][1]));
                    if (ai == 1 && m == 3) asm volatile("" ::: "memory");
                }
        }
        f32x4 fg[2][2];
#pragma unroll
        for (int bj = 0; bj < 2; ++bj) { const int col = u.pn * 256 + bj * 128 + wc * 32 + 8 * fq; fg[bj][0] = *(const f32x4*)(pb.p25 + col); fg[bj][1] = *(const f32x4*)(pb.p25 + col + 4); }
        row_ssq_exchange<4, 2>(acc, u, wr, wc, fr, fq, lds + XLDS_OFF, pb.ws);
        const LAS float* S = (const LAS float*)(lds + XLDS_OFF + 4096);
        asm volatile("" : "+v"(fr), "+v"(fq));
        if (!keep) {
#pragma unroll
        for (int bj = 0; bj < 2; ++bj) {
            const int col = u.pn * 256 + bj * 128 + wc * 32 + 8 * fq;
            const f32x4 f0 = fg[bj][0], f1 = fg[bj][1];
#pragma unroll
            for (int ai = 0; ai < 2; ++ai)
#pragma unroll
                for (int m = 0; m < 4; ++m) {
                    const int rl = ai * 128 + wr * 64 + m * 16 + fr; const float rs = S[rl];
                    float* o = pb.out + (size_t)(u.pm * 256 + rl) * D + col;
                    *(f32x4*)o = acc[ai][bj][m][0] * rs * f0; *(f32x4*)(o + 4) = acc[ai][bj][m][1] * rs * f1;
                }
        }
        }
    }
};

struct EpiWoUp {
    static constexpr bool PERM = true, AFTER_DRAIN = false;
    LAS unsigned char* lds;
    __device__ __forceinline__ void operator()(f32x4 (&acc)[2][2][4][2], const pg8::Unit& u, int wr, int wc, int fr, int fq) const {
        if (u.ty == 0) { EpiWoH2 E{lds}; E(acc, u, wr, wc, fr, fq); return; }
        asm volatile("" : "+v"(fr), "+v"(fq));
        const PB pb = load_pb(lds); bf16* O = (bf16*)(pb.ws + WS_ACT);
        const int j0 = u.pn * 128 + wc * 32 + 8 * fq;
#pragma unroll
        for (int ai = 0; ai < 2; ++ai)
#pragma unroll
            for (int m = 0; m < 4; ++m) {
                const int row = EPI_ROWS(u, ai, m);
                f32x4 o0, o1;
#pragma unroll
                for (int e = 0; e < 4; ++e) { const float a0 = acc[ai][0][m][0][e], a1 = acc[ai][0][m][1][e]; o0[e] = a0 * sigm(a0) * acc[ai][1][m][0][e]; o1[e] = a1 * sigm(a1) * acc[ai][1][m][1][e]; }
                *(u32x4*)(O + (size_t)row * FF + j0) = pack8(o0, o1);
            }
    }
};

template <class Map>
__device__ __forceinline__ void transpose_item(const float* W, int K, int N, bf16* WT, LAS float* scr, int item, int lane, Map map) {
    const int nblk = N / 32, kb = item / nblk, nb = item % nblk, k0 = 64 * kb, n0 = 32 * nb;
    { const int rr = lane >> 3, c4 = (lane & 7) * 4; f32x4 t[8];
#pragma unroll
      for (int j = 0; j < 8; ++j) t[j] = *(const f32x4*)(W + (size_t)(k0 + rr + 8 * j) * N + n0 + c4);
#pragma unroll
      for (int j = 0; j < 8; ++j) { LAS float* d = scr + (rr + 8 * j) * 33 + c4; d[0] = t[j][0]; d[1] = t[j][1]; d[2] = t[j][2]; d[3] = t[j][3]; } }
    LDS_WAIT(); asm volatile("" ::: "memory");
    const int c = lane & 7;
#pragma unroll
    for (int j = 0; j < 4; ++j) { const int n = (lane >> 3) + 8 * j; const LAS float* s = scr + (8 * c) * 33 + n;
        v4u o; o.x = pk2(s[0 * 33], s[1 * 33]); o.y = pk2(s[2 * 33], s[3 * 33]); o.z = pk2(s[4 * 33], s[5 * 33]); o.w = pk2(s[6 * 33], s[7 * 33]);
        *(GAS v4u*)(WT + (size_t)map(n0 + n) * K + k0 + 8 * c) = o; }
    LDS_WAIT(); asm volatile("" ::: "memory");
}
struct MapId { __device__ __forceinline__ int operator()(int n) const { return n; } };
struct MapWin { __device__ __forceinline__ int operator()(int n) const { if (n >= 1024) return n; const int d = n & 63; return (n & ~63) + ((d >> 2) & 7) * 8 + (d >> 5) * 4 + (d & 3); } };
struct MapW13 { int off; __device__ __forceinline__ int operator()(int j) const { return 256 * (j >> 7) + off + (j & 127); } };

template <int R>
__device__ __forceinline__ void norm_rows_lds(const float* const (&xrow)[R], bf16* const (&orow)[R], const LAS float* Gm, const LAS float* Sh, int lane) {
    f32x4 v[R][4];
#pragma unroll
    for (int r = 0; r < R; ++r)
#pragma unroll
        for (int j = 0; j < 4; ++j) v[r][j] = ((const GAS f32x4*)xrow[r] + lane)[64 * j];
#pragma unroll
    for (int r = 0; r < R; ++r) {
        float s = 0.f;
#pragma unroll
        for (int j = 0; j < 4; ++j) s += (v[r][j].x * v[r][j].x + v[r][j].y * v[r][j].y) + (v[r][j].z * v[r][j].z + v[r][j].w * v[r][j].w);
        const float rstd = __builtin_amdgcn_rsqf(wave_sum(s) * (1.f / D) + EPS);
        GAS v2u* o8 = (GAS v2u*)orow[r] + lane;
#pragma unroll
        for (int j = 0; j < 4; ++j) { const f32x4 gm = *(const LAS f32x4*)(Gm + 256 * j + 4 * lane), sh = *(const LAS f32x4*)(Sh + 256 * j + 4 * lane);
            const f32x4 h = v[r][j] * rstd * gm + sh; v2u w; w.x = pk2(h.x, h.y); w.y = pk2(h.z, h.w); o8[64 * j] = w; }
    }
}

__device__ __forceinline__ void cpow_tab(const float* ldre, const double* theta, int bi, int e, float& pre, float& pim) {
    const float mag = fexp2((float)e * ldre[bi] * LOG2E); float s, c; sincos_rev((double)e * theta[bi], s, c); pre = mag * c; pim = mag * s;
}

__device__ __forceinline__ float xmax16_32(float m) {
    auto r = __builtin_amdgcn_permlane16_swap(__float_as_uint(m), __float_as_uint(m), false, false); m = fmaxf(__uint_as_float(r[0]), __uint_as_float(r[1]));
    auto q = __builtin_amdgcn_permlane32_swap(__float_as_uint(m), __float_as_uint(m), false, false); return fmaxf(__uint_as_float(q[0]), __uint_as_float(q[1])); }
__device__ __forceinline__ float xsum16_32(float m) {
    auto r = __builtin_amdgcn_permlane16_swap(__float_as_uint(m), __float_as_uint(m), false, false); m = __uint_as_float(r[0]) + __uint_as_float(r[1]);
    auto q = __builtin_amdgcn_permlane32_swap(__float_as_uint(m), __float_as_uint(m), false, false); return __uint_as_float(q[0]) + __uint_as_float(q[1]); }
namespace att {
constexpr int NITEMS = 3 * 8 * 256, VOFF = 32768, BUFB = 65536;
struct Item { int br, h, seq_base, ldil, r, kblk, nidx, cont; };
__device__ __forceinline__ Item decode(int hs, int pos) {
    Item I; const int bh = hs >> 6, L = (hs & 63) * 4 + pos; I.br = bh >> 3; I.h = bh & 7; I.ldil = 2 * I.br;
    int S, li;
    if (L < 128) { I.seq_base = 0; S = MP; li = L; } else { const int si = (L - 128) >> 5; I.seq_base = MP + SS * si; S = SS; li = (L - 128) & 31; }
    const int lnb = (S == MP ? 7 : 5) - I.ldil;
    I.r = li >> lnb; I.kblk = li & ((1 << lnb) - 1); I.nidx = S >> I.ldil; I.cont = (pos > 0 && I.kblk > 0) ? 1 : 0; return I;
}
__device__ __forceinline__ void glds16(const void* gsrc, unsigned lds_dst) { unsigned keep;
    asm volatile("s_mov_b32 %0, m0\n\ts_mov_b32 m0, %2\n\ts_nop 0\n\tglobal_load_lds_dwordx4 %1, off\n\ts_mov_b32 m0, %0" : "=&s"(keep) : "v"(gsrc), "s"(lds_dst) : "memory"); }
template <bool HALF>
__device__ __forceinline__ void stage(LAS unsigned char* buf, const bf16* K, const bf16* V, const Item& I, int wave, int lane) {
    const unsigned lbase = (unsigned)__builtin_amdgcn_readfirstlane((int)(unsigned)(uintptr_t)buf);
    const int rsub = lane >> 3, c16 = lane & 7, kbase = 128 * I.kblk - 64;
    if (kbase >= 0 && kbase + 256 <= I.nidx) {
        const size_t tok0 = (size_t)I.seq_base + I.r + ((size_t)(kbase + 8 * wave + rsub) << I.ldil);
        const bf16* k0 = K + tok0 * 512 + I.h * 64 + ((c16 ^ rsub) << 3);
        const bf16* v0 = V + tok0 * 512 + I.h * 64 + ((c16 ^ (((rsub >> 1) & 3) << 1)) << 3);
        const size_t st = (size_t)65536 << I.ldil;
        const char* k1 = (const char*)k0 + st; const char* k2 = k1 + st; const char* k3 = k2 + st;
        const char* v1 = (const char*)v0 + st; const char* v2 = v1 + st; const char* v3 = v2 + st;
        unsigned keep;
        if (HALF)
            asm volatile("s_mov_b32 %0, m0\n\ts_mov_b32 m0, %5\n\ts_nop 0\n\tglobal_load_lds_dwordx4 %1, off\n\t"
                         "s_add_u32 m0, m0, 0x8000\n\ts_nop 0\n\tglobal_load_lds_dwordx4 %3, off\n\t"
                         "s_sub_u32 m0, m0, 0x6000\n\ts_nop 0\n\tglobal_load_lds_dwordx4 %2, off\n\t"
                         "s_add_u32 m0, m0, 0x8000\n\ts_nop 0\n\tglobal_load_lds_dwordx4 %4, off\n\t"
                         "s_mov_b32 m0, %0"
                         : "=&s"(keep) : "v"(k2), "v"(k3), "v"(v2), "v"(v3), "s"(lbase + wave * 1024 + 16384) : "memory", "scc");
        else
            asm volatile("s_mov_b32 %0, m0\n\ts_mov_b32 m0, %9\n\ts_nop 0\n\tglobal_load_lds_dwordx4 %1, off\n\t"
                         "s_add_u32 m0, m0, 0x8000\n\ts_nop 0\n\tglobal_load_lds_dwordx4 %5, off\n\t"
                         "s_sub_u32 m0, m0, 0x6000\n\ts_nop 0\n\tglobal_load_lds_dwordx4 %2, off\n\t"
                         "s_add_u32 m0, m0, 0x8000\n\ts_nop 0\n\tglobal_load_lds_dwordx4 %6, off\n\t"
                         "s_sub_u32 m0, m0, 0x6000\n\ts_nop 0\n\tglobal_load_lds_dwordx4 %3, off\n\t"
                         "s_add_u32 m0, m0, 0x8000\n\ts_nop 0\n\tglobal_load_lds_dwordx4 %7, off\n\t"
                         "s_sub_u32 m0, m0, 0x6000\n\ts_nop 0\n\tglobal_load_lds_dwordx4 %4, off\n\t"
                         "s_add_u32 m0, m0, 0x8000\n\ts_nop 0\n\tglobal_load_lds_dwordx4 %8, off\n\t"
                         "s_mov_b32 m0, %0"
                         : "=&s"(keep) : "v"(k0), "v"(k1), "v"(k2), "v"(k3), "v"(v0), "v"(v1), "v"(v2), "v"(v3), "s"(lbase + wave * 1024) : "memory", "scc");
        return;
    }
#pragma unroll
    for (int i = (HALF ? 2 : 0); i < 4; ++i) {
        const int p = wave + 8 * i, row = 8 * p + rsub; int kidx = kbase + row; kidx = kidx < 0 ? 0 : (kidx >= I.nidx ? I.nidx - 1 : kidx);
        const size_t tok = (size_t)I.seq_base + I.r + ((size_t)kidx << I.ldil);
        glds16(K + tok * 512 + I.h * 64 + ((c16 ^ (row & 7)) << 3), lbase + p * 1024);
        glds16(V + tok * 512 + I.h * 64 + ((c16 ^ (((row >> 1) & 3) << 1)) << 3), lbase + VOFF + p * 1024);
    }
}
__device__ __forceinline__ void slide(LAS unsigned char* dst, const LAS unsigned char* src, int wave, int lane) {
#pragma unroll
    for (int i = 0; i < 2; ++i) { const int o = (wave + 8 * i) * 1024 + lane * 16;
        const u32x4 a = *(const LAS u32x4*)(src + 16384 + o), b = *(const LAS u32x4*)(src + VOFF + 16384 + o);
        *(LAS u32x4*)(dst + o) = a; *(LAS u32x4*)(dst + VOFF + o) = b; }
}
__device__ __forceinline__ size_t q_token(const Item& I, int wave, int lane) { return (size_t)I.seq_base + I.r + ((size_t)(128 * I.kblk + 16 * wave + (lane & 15)) << I.ldil); }
struct Out { u32x4 s[2]; float lse; bf16* od; float* lp; };
__device__ __forceinline__ void store_out(const Out& o, int lane) {
    *(u32x4*)o.od = o.s[0]; *(u32x4*)(o.od + 16) = o.s[1];
    if ((lane >> 4) == 0) *o.lp = o.lse;
}
__device__ __forceinline__ void compute(LAS unsigned char* buf, const Item& I, const bf16x8 (&qf)[2], size_t qtok, bf16* Ob, float* Lse, int wave, int lane, Out& out) {
    const int qi = lane & 15, g4 = lane >> 4, kbase = 128 * I.kblk - 64;
    const LAS unsigned char* kp0 = buf + (16 * wave + qi) * 128 + ((g4 ^ (qi & 7)) << 4);
    const LAS unsigned char* kp1 = buf + (16 * wave + qi) * 128 + (((4 + g4) ^ (qi & 7)) << 4);
    bf16x8 kf0[9], kf1[9];
#pragma unroll
    for (int kt = 0; kt < 9; ++kt) { kf0[kt] = *(const LAS bf16x8*)(kp0 + kt * 2048); kf1[kt] = *(const LAS bf16x8*)(kp1 + kt * 2048); }
    __builtin_amdgcn_sched_barrier(0);
    f32x4 sc[9];
#pragma unroll
    for (int kt = 0; kt < 9; ++kt) sc[kt] = __builtin_amdgcn_mfma_f32_16x16x32_bf16(kf0[kt], qf[0], (f32x4){0.f, 0.f, 0.f, 0.f}, 0, 0, 0);
#pragma unroll
    for (int kt = 0; kt < 9; ++kt) sc[kt] = __builtin_amdgcn_mfma_f32_16x16x32_bf16(kf1[kt], qf[1], sc[kt], 0, 0, 0);
    __builtin_amdgcn_sched_barrier(0);
    const int il = lane & 15, q_ = il >> 2, p_ = il & 3, rr = 4 * g4 + q_, sw = (rr >> 1) & 3;
    const LAS unsigned char* vb = buf + VOFF + (16 * wave + rr) * 128 + p_ * 8;
    v4i16_t vlo[5][4], vhi[5][4];
#pragma unroll
    for (int ks = 0; ks < 5; ++ks) {
        const int hioff = (ks == 4 && wave == 7) ? 0 : 2048;
        if (ks > 0) asm volatile("s_waitcnt lgkmcnt(7)" ::: "memory");
#pragma unroll
        for (int dt = 0; dt < 4; ++dt) {
            vlo[ks][dt] = __builtin_amdgcn_ds_read_tr16_b64_v4i16((LAS v4i16_t*)(vb + ks * 4096 + ((dt ^ sw) << 5)));
            vhi[ks][dt] = __builtin_amdgcn_ds_read_tr16_b64_v4i16((LAS v4i16_t*)(vb + ks * 4096 + hioff + ((dt ^ sw) << 5)));
        }
    }
    __builtin_amdgcn_sched_barrier(0);
#pragma unroll
    for (int e = 0; e < 4; ++e) { const int jj = 4 * g4 + e; if (jj < qi) sc[0][e] = -INFINITY; if (jj > qi) sc[8][e] = -INFINITY; }
    if (kbase < 0 || kbase + 256 > I.nidx) {
#pragma unroll
        for (int kt = 0; kt < 9; ++kt)
#pragma unroll
            for (int e = 0; e < 4; ++e) { const int kidx = kbase + 16 * (wave + kt) + 4 * g4 + e; if ((unsigned)kidx >= (unsigned)I.nidx) sc[kt][e] = -INFINITY; }
    }
    f32x4 mx4 = sc[0];
#pragma unroll
    for (int kt = 1; kt < 9; ++kt)
#pragma unroll
        for (int e = 0; e < 4; ++e) mx4[e] = fmaxf(mx4[e], sc[kt][e]);
    float mx = fmaxf(fmaxf(mx4[0], mx4[1]), fmaxf(mx4[2], mx4[3]));
    mx = xmax16_32(mx);
    bf16x8 pf[5]; float lsv = 0.f;
#pragma unroll
    for (int ks = 0; ks < 5; ++ks) {
        f32x4 pa, pb;
#pragma unroll
        for (int e = 0; e < 4; ++e) { pa[e] = fexp2(sc[2 * ks][e] - mx); pb[e] = (ks < 4) ? fexp2(sc[2 * ks + 1][e] - mx) : 0.f; }
#pragma unroll
        for (int e = 0; e < 4; ++e) lsv += pa[e] + pb[e];
        pf[ks] = __builtin_bit_cast(bf16x8, pack8(pa, pb));
    }
    __builtin_amdgcn_sched_barrier(0);
    f32x4 o[4];
#pragma unroll
    for (int dt = 0; dt < 4; ++dt) o[dt] = (f32x4){0.f, 0.f, 0.f, 0.f};
#pragma unroll
    for (int ks = 0; ks < 5; ++ks) {
#pragma unroll
        for (int dt = 0; dt < 4; ++dt) {
            const bf16x8 vf = (bf16x8){vlo[ks][dt][0], vlo[ks][dt][1], vlo[ks][dt][2], vlo[ks][dt][3], vhi[ks][dt][0], vhi[ks][dt][1], vhi[ks][dt][2], vhi[ks][dt][3]};
            o[dt] = __builtin_amdgcn_mfma_f32_16x16x32_bf16(vf, pf[ks], o[dt], 0, 0, 0);
        }
    }
    const float ls = xsum16_32(lsv);
    const float inv = frcp(ls);
    out.od = Ob + ((size_t)I.br * M + qtok) * 512 + I.h * 64 + ((g4 & 1) ? 32 + 4 * (g4 - 1) : 4 * g4); out.lp = Lse + ((size_t)I.br * M + qtok) * 8 + I.h;
    unsigned wx[4], wy[4];
#pragma unroll
    for (int dt = 0; dt < 4; ++dt) { wx[dt] = cvt_pk_bf16(o[dt][0] * inv, o[dt][1] * inv); wy[dt] = cvt_pk_bf16(o[dt][2] * inv, o[dt][3] * inv); }
#pragma unroll
    for (int p = 0; p < 2; ++p) {
        const auto rx = __builtin_amdgcn_permlane16_swap(wx[p], wx[p + 2], false, false); const auto ry = __builtin_amdgcn_permlane16_swap(wy[p], wy[p + 2], false, false);
        out.s[p] = (u32x4){rx[0], ry[0], rx[1], ry[1]};
    }
    out.lse = (mx + __builtin_amdgcn_logf(ls)) * LN2F;
}
__device__ __forceinline__ int run_of(int bx, int G, int k) {
    if (G != 256) { const int hs = bx + k * G; return hs < 1536 ? hs : 1536; }
    if (bx < 128) return k < 5 ? bx + 128 * k : 1536;
    return k < 7 ? 640 + (bx - 128) + 128 * k : 1536;
}
__device__ __forceinline__ void phase(LAS unsigned char* ring, const bf16* Q, const bf16* K, const bf16* V, bf16* Ob, float* Lse, int bx, int G, int wave, int lane) {
    int i = 0, hsc = run_of(bx, G, 0), hsn = hsc;
    bf16x8 qc[2], qn[2]; size_t tokc = 0, tokn = 0;
    qc[0] = qc[1] = qn[0] = qn[1] = (bf16x8){0, 0, 0, 0, 0, 0, 0, 0};
    if (hsc < 1536) { const Item I = decode(hsc, 0); stage<false>(ring, K, V, I, wave, lane); tokc = q_token(I, wave, lane);
        qc[0] = *(const bf16x8*)(Q + tokc * 512 + I.h * 64 + 8 * (lane >> 4)); qc[1] = *(const bf16x8*)(Q + tokc * 512 + I.h * 64 + 32 + 8 * (lane >> 4)); }
    asm volatile("s_waitcnt vmcnt(0)" : "+v"(qc[0]), "+v"(qc[1]) :: "memory"); __builtin_amdgcn_s_barrier(); asm volatile("" ::: "memory");
    int b = 0; Out po; bool have = false;
    po.od = nullptr; po.lp = nullptr; po.lse = 0.f; po.s[0] = po.s[1] = (u32x4){0u, 0u, 0u, 0u};
    while (hsc < 1536) {
        const int in = i + 1; hsn = run_of(bx, G, in >> 2);
        if (hsn < 1536) { const Item In = decode(hsn, in & 3);
            if (In.cont) stage<true>(ring + (b ^ 1) * BUFB, K, V, In, wave, lane);
            else stage<false>(ring + (b ^ 1) * BUFB, K, V, In, wave, lane);
            tokn = q_token(In, wave, lane);
            qn[0] = *(const bf16x8*)(Q + tokn * 512 + In.h * 64 + 8 * (lane >> 4)); qn[1] = *(const bf16x8*)(Q + tokn * 512 + In.h * 64 + 32 + 8 * (lane >> 4));
            if (In.cont) slide(ring + (b ^ 1) * BUFB, ring + b * BUFB, wave, lane); }
        if (have) store_out(po, lane);
        { const Item I = decode(hsc, i & 3); compute(ring + b * BUFB, I, qc, tokc, Ob, Lse, wave, lane, po); have = true; }
        asm volatile("s_waitcnt vmcnt(0) lgkmcnt(0)" : "+v"(qn[0]), "+v"(qn[1]) :: "memory"); __builtin_amdgcn_s_barrier(); asm volatile("" ::: "memory");
        i = in; hsc = hsn; qc[0] = qn[0]; qc[1] = qn[1]; tokc = tokn; b ^= 1;
    }
    if (have) store_out(po, lane);
    __syncthreads();
}
}

__global__ void __launch_bounds__(NWAVES * 64, 2) mk_fwd(Args args) {
    extern __shared__ __attribute__((aligned(16))) unsigned char lds_raw[];
    LAS unsigned char* lds = (LAS unsigned char*)lds_raw;
    volatile LAS unsigned* MISC = (volatile LAS unsigned*)(lds + MISC_OFF);
    const int tid = threadIdx.x, lane = tid & 63, wave = __builtin_amdgcn_readfirstlane(tid >> 6);
    const int G = gridDim.x, bx = blockIdx.x;
    const int vcu = (G % 8 == 0) ? (bx % 8) * (G / 8) + bx / 8 : bx;
    const int gw = vcu * NWAVES + wave, NGW = G * NWAVES;
    const int gtid = gw * 64 + lane, NT = NGW * 64;
    unsigned char* ws = args.ws;
    gu32* ctl = (gu32*)(ws + WS_CTL);
    for (int u = tid; u < (LDS_BYTES - LDSCTL_OFF) / 4; u += NWAVES * 64) ((LAS unsigned*)(lds + LDSCTL_OFF))[u] = 0u;
    __syncthreads();
    if (tid == 0) { LAS unsigned long long* p = (LAS unsigned long long*)(lds + PARAM_OFF); p[0] = (unsigned long long)args.in[0]; p[1] = (unsigned long long)args.in[1]; p[2] = (unsigned long long)args.out; p[3] = (unsigned long long)args.ws;
        p[4] = (unsigned long long)args.in[17]; p[5] = (unsigned long long)args.in[19]; p[6] = (unsigned long long)args.in[21]; p[7] = (unsigned long long)args.in[25]; }
    __syncthreads();
    XcdBarrier bar; bar.bar = (unsigned*)(ctl + CW_BAR); bar.x = 0; bar.st = nullptr;
    if (MK_N_LAUNCHES == 1) bar = xcd_barrier_post((unsigned*)(ctl + CW_BAR), MISC + 8);
    const int lo = args.ph_lo, hi = args.ph_hi;
#ifndef REP_MASK
#define REP_MASK 0
#endif
#define IN(k) (lo <= (k) && (k) < hi)
#define REPS(k) (1 + ((REP_MASK >> (k)) & 1))
#ifndef TIME_PHASE
#define TIME_PHASE -1
#endif
    unsigned long long tp0 = (TIME_PHASE >= 0) ? __builtin_amdgcn_s_memrealtime() : 0ull;
#define SEAM(k) do { if (IN(k) && IN((k) + 1)) { \
        xcd_barrier(bar); \
        if (TIME_PHASE >= 0 && bx == 0 && tid == 0) { unsigned long long t1 = __builtin_amdgcn_s_memrealtime(); \
            if ((k) == TIME_PHASE) { const unsigned long long dt = t1 - tp0; while (__builtin_amdgcn_s_memrealtime() - t1 < 9ull * dt) __builtin_amdgcn_s_sleep(8); t1 = __builtin_amdgcn_s_memrealtime(); } \
            tp0 = t1; } } } while (0)

    float* modf = (float*)(ws + WS_MODF); float* modp = (float*)(ws + WS_MODP);
    float* t_ldre = (float*)(ws + WS_LDRE); float* t_zre = (float*)(ws + WS_ZRE); float* t_zim = (float*)(ws + WS_ZIM); float* t_atre = (float*)(ws + WS_ATRE); float* t_atim = (float*)(ws + WS_ATIM); double* t_theta = (double*)(ws + WS_THETA);
    bf16* W13T = (bf16*)(ws + WS_W13); bf16* WinT = (bf16*)(ws + WS_WIN); bf16* WgluT = (bf16*)(ws + WS_WGLU); bf16* WoT = (bf16*)(ws + WS_WO); bf16* W2T = (bf16*)(ws + WS_W2);
    bf16* Ptab = (bf16*)(ws + WS_PTAB); bf16* Sbuf = (bf16*)(ws + WS_SBUF); bf16* Klag = (bf16*)(ws + WS_KLAG); bf16* Toep = (bf16*)((unsigned char*)args.out + DO_TOEP);
    float* cosT = (float*)(ws + WS_ROPE); float* sinT = cosT + 16384 * 32;
    bf16* Ub = (bf16*)(ws + WS_U); bf16* Qb = (bf16*)(ws + WS_Q); bf16* Kb = (bf16*)(ws + WS_K); bf16* Vb = (bf16*)(ws + WS_V);
    bf16* Gb = (bf16*)(ws + WS_G); bf16* SsmRaw = (bf16*)(ws + WS_SSMRAW); bf16* MixA = (bf16*)(ws + WS_MIXA); bf16* H2 = (bf16*)(ws + WS_H2); bf16* Act = (bf16*)(ws + WS_ACT);
    bf16* H1 = (bf16*)((unsigned char*)args.out + DO_H1); bf16* Ob = (bf16*)((unsigned char*)args.out + DO_OB); float* Lse = (float*)((unsigned char*)args.out + DO_LSE);
    LAS float* scr = (LAS float*)(lds + RING_OFF + wave * 16384);

    auto later_weight_item = [&](int r) {
        constexpr int J_GLU = 8 * 16, J_O = 16 * 32, J_1 = 16 * 88;
        if (r < J_GLU) { transpose_item(args.in[16], 512, 512, WgluT, scr, r, lane, MapId{}); return; } r -= J_GLU;
        if (r < J_O) { transpose_item(args.in[20], D, D, WoT, scr, r, lane, MapId{}); return; } r -= J_O;
        if (r < J_1) { transpose_item(args.in[22], D, FF, W13T, scr, r, lane, MapW13{0}); return; } r -= J_1;
        transpose_item(args.in[23], D, FF, W13T, scr, r, lane, MapW13{128});
    };
    if (IN(0)) for (int rep_ = 0; rep_ < REPS(0); ++rep_) {
        constexpr int I_IN = 16 * 64, I_GLU = 8 * 16, I_O = 16 * 32, I_1 = 16 * 88;
        constexpr int NITEMS = I_IN + I_GLU + I_O + 2 * I_1;
#ifndef P0_PROBE
#define P0_PROBE 0
#endif
        for (int p0r = 0; p0r < 1 + (P0_PROBE & 1); ++p0r)
        for (int it = gw; it < (G == 256 ? I_IN : NITEMS); it += NGW) {
            int r = it;
            if (r < I_IN) { transpose_item(args.in[7], D, NPROJ, WinT, scr, r, lane, MapWin{}); continue; } r -= I_IN;
            later_weight_item(r);
        }
        {
            LAS float* sl = (LAS float*)(lds + RING_OFF);
            LAS f32x2v* red2 = (LAS f32x2v*)(lds + RING_OFF + 20480);
            __syncthreads();
            for (int i = tid; i < 5 * 1024; i += NWAVES * 64) { const float cv = i < 1024 ? args.in[2][i] : args.in[3][i - 1024]; sl[i] = cv * sigm(cv); }
            __syncthreads();
            for (int p0r = 0; p0r < 1 + ((P0_PROBE >> 1) & 1); ++p0r)
            for (int task = vcu; task < 48 * 16; task += G) {
                const int cb = task % 48, ks = task / 48, n = 128 * cb + 2 * lane, k0 = 64 * ks + 8 * wave;
                const float* W = args.in[4] + (size_t)k0 * NMOD + n;
                f32x2v w[8];
#pragma unroll
                for (int i = 0; i < 8; ++i) w[i] = *(const f32x2v*)(W + (size_t)i * NMOD);
                f32x2v a0 = {0.f, 0.f}, a1 = a0, a2 = a0, a3 = a0, a4 = a0;
#pragma unroll
                for (int i = 0; i < 8; ++i) { const int k = k0 + i; a0 += w[i] * sl[k]; a1 += w[i] * sl[1024 + k]; a2 += w[i] * sl[2048 + k]; a3 += w[i] * sl[3072 + k]; a4 += w[i] * sl[4096 + k]; }
                __syncthreads();
                red2[(wave * 5 + 0) * 64 + lane] = a0; red2[(wave * 5 + 1) * 64 + lane] = a1; red2[(wave * 5 + 2) * 64 + lane] = a2; red2[(wave * 5 + 3) * 64 + lane] = a3; red2[(wave * 5 + 4) * 64 + lane] = a4;
                __syncthreads();
                if (wave < 5) { f32x2v t = red2[(0 * 5 + wave) * 64 + lane];
#pragma unroll
                    for (int v = 1; v < 8; ++v) t += red2[(v * 5 + wave) * 64 + lane];
                    *(f32x2v*)(modp + (size_t)(ks * 5 + wave) * NMOD + n) = t; }
            }
            __syncthreads();
        }
        for (int p0r = 0; p0r < 1 + ((P0_PROBE >> 2) & 1); ++p0r)
        for (int idx = gtid; idx < 16384 * 32; idx += NT) { const int pos = idx >> 5, i = idx & 31;
            const float inv = fexp2(-(float)i * 0.41524101186092033f); const float ang = (float)pos * inv; float s, c; sincos_rev((double)ang * INV_2PI, s, c); cosT[idx] = c; sinT[idx] = s; }
        for (int idx = gtid; idx < 4096; idx += NT) {
            const float dt = fexp2(args.in[10][idx >> 6] * LOG2E), lr = args.in[8][idx], li = args.in[9][idx];
            const float ldre = lr * dt; const double th = (double)li * (double)dt * INV_2PI;
            float s, c; sincos_rev(th, s, c); const float mag = fexp2(ldre * LOG2E), are = mag * c, aim = mag * s;
            const float nr = are - 1.f, den = lr * lr + li * li;
            t_ldre[idx] = ldre; t_theta[idx] = th; t_zre[idx] = (nr * lr + aim * li) / den; t_zim[idx] = (aim * lr - nr * li) / den;
            float sT, cT; sincos_rev((double)TCH * th, sT, cT); const float mT = fexp2((float)TCH * ldre * LOG2E); t_atre[idx] = mT * cT; t_atim[idx] = mT * sT;
        }
    }
    SEAM(0);

    if (IN(1)) for (int rep_ = 0; rep_ < REPS(1); ++rep_) {
        for (int e = gtid; e < 5 * NMOD; e += NT) { const int b = e / NMOD, n = e % NMOD; float v = args.in[5][n];
#pragma unroll
            for (int ks = 0; ks < 16; ++ks) v += modp[(size_t)(ks * 5 + b) * NMOD + n];
            modf[e] = v; }
#pragma unroll 1
        for (int step = 0; step < 2; ++step) {
        if ((step == 0) == ((bx & 1) == 0)) {
        LAS float* Gm = (LAS float*)(lds + RING_OFF + 65536); LAS float* Sh = Gm + 1024;
        for (int rb = vcu; rb < M / 128; rb += G) {
            const int row0 = rb * 128, b = batch_of(row0);
            __syncthreads();
            for (int k = tid; k < 1024; k += NWAVES * 64) { float sc = args.in[5][1024 + k], sh = args.in[5][k];
#pragma unroll
                for (int ks = 0; ks < 16; ++ks) { sc += modp[(size_t)(ks * 5 + b) * NMOD + 1024 + k]; sh += modp[(size_t)(ks * 5 + b) * NMOD + k]; }
                Gm[k] = args.in[6][k] * (1.f + sc); Sh[k] = sh; }
            __syncthreads();
            for (int i = 0; i < 16; i += 8) { const int row = row0 + wave * 16 + i; const float* xb = xrow_ptr(args, row); bf16* ob = H1 + (size_t)row * D;
                const float* xr[8] = {xb, xb + D, xb + 2 * D, xb + 3 * D, xb + 4 * D, xb + 5 * D, xb + 6 * D, xb + 7 * D};
                bf16* orw[8] = {ob, ob + D, ob + 2 * D, ob + 3 * D, ob + 4 * D, ob + 5 * D, ob + 6 * D, ob + 7 * D}; norm_rows_lds<8>(xr, orw, Gm, Sh, lane); }
        }
        } else {
        for (int task = vcu; task < 256; task += G) {
            const int g = task >> 3, lb = task & 7;
            LAS float* Bre = (LAS float*)(lds + RING_OFF);
            LAS float* Bim = Bre + 2048;
            LAS float* CZr = Bim + 2048;
            LAS float* CZi = CZr + 2080;
            LAS float* PWr = CZi + 2080;
            LAS float* PWi = PWr + 520;
            LAS float* X0 = PWi + 520;
            __syncthreads();
            for (int i = tid; i < 2048; i += NWAVES * 64) {
                const int dir = i >> 10, rem = i & 1023, gd = dir * 32 + g;
                Bre[i] = args.in[11][(size_t)gd * 1024 + rem]; Bim[i] = args.in[12][(size_t)gd * 1024 + rem];
                const int c = rem >> 6, n = rem & 63, bi = gd * 64 + n;
                const float cr = args.in[13][(size_t)gd * 1024 + rem], ci = args.in[14][(size_t)gd * 1024 + rem], zr = t_zre[bi], zi = t_zim[bi];
                CZr[(dir * 16 + c) * 65 + n] = cr * zr - ci * zi; CZi[(dir * 16 + c) * 65 + n] = cr * zi + ci * zr;
            }
            { const int i = tid; const int dir = i >> 8, l = (i >> 6) & 3, n = i & 63; float pre, pim; cpow_tab(t_ldre, t_theta, (dir * 32 + g) * 64 + n, 4 * lb + l, pre, pim);
                PWr[(dir * 4 + l) * 65 + n] = pre; PWi[(dir * 4 + l) * 65 + n] = pim; }
            __syncthreads();
            const int dir = tid >> 8, l = (tid >> 6) & 3, c = (tid >> 2) & 15, cq = tid & 3, tau = 4 * lb + l;
            f32x4 acc = {0.f, 0.f, 0.f, 0.f};
            const LAS float* czr = CZr + (dir * 16 + c) * 65; const LAS float* czi = CZi + (dir * 16 + c) * 65;
            const LAS float* pwr = PWr + (dir * 4 + l) * 65; const LAS float* pwi = PWi + (dir * 4 + l) * 65;
#pragma unroll 8
            for (int n = 0; n < 64; ++n) {
                const float a = czr[n], b = czi[n], pr = pwr[n], pi = pwi[n], wr_ = a * pr - b * pi, wi_ = a * pi + b * pr;
                const f32x4 r0 = *(const LAS f32x4*)(Bre + dir * 1024 + n * 16 + 4 * cq), m0 = *(const LAS f32x4*)(Bim + dir * 1024 + n * 16 + 4 * cq);
                acc += r0 * wr_ - m0 * wi_;
            }
            if (tau == 0 && dir == 1) *(LAS f32x4*)(X0 + c * 16 + 4 * cq) = acc;
            __syncthreads();
            if (tau == 0 && dir == 0) { const float dsk = args.in[15][16 * g + c]; const f32x4 xo = *(const LAS f32x4*)(X0 + c * 16 + 4 * cq);
#pragma unroll
                for (int j = 0; j < 4; ++j) acc[j] += xo[j] + ((4 * cq + j == c) ? dsk : 0.f); }
            if (!(tau == 0 && dir == 1)) {
                const int ti = dir == 0 ? (TCH - 1) + tau : (TCH - 1) - tau;
                v2u o; o.x = pk2(acc[0], acc[1]); o.y = pk2(acc[2], acc[3]);
                *(v2u*)(Klag + ((size_t)((g * (2 * TCH - 1) + ti) * 16 + c) * 16 + 4 * cq)) = o;
            }
        }
        for (int e = gtid; e < 32 * 2 * 64 * TCH; e += NT) {
            const int s = e & 31, n = (e >> 5) & 63, dir = (e >> 11) & 1, g = e >> 12, bi = (dir * 32 + g) * 64 + n;
            float pre, pim; cpow_tab(t_ldre, t_theta, bi, dir == 0 ? (TCH - 1) - s : s, pre, pim);
            const float zr = t_zre[bi], zi = t_zim[bi], wr_ = pre * zr - pim * zi, wi_ = pre * zi + pim * zr;
            const f32x4* br = (const f32x4*)(args.in[11] + (size_t)bi * 16); const f32x4* bm = (const f32x4*)(args.in[12] + (size_t)bi * 16);
            float re[16], im[16];
#pragma unroll
            for (int j4 = 0; j4 < 4; ++j4) { const f32x4 b1 = br[j4], b2 = bm[j4];
#pragma unroll
                for (int e2 = 0; e2 < 4; ++e2) { re[4 * j4 + e2] = wr_ * b1[e2] - wi_ * b2[e2]; im[4 * j4 + e2] = wr_ * b2[e2] + wi_ * b1[e2]; } }
            bf16* d0 = Ptab + ((size_t)(g * 256 + dir * 128 + 2 * n) * (16 * TCH) + s * 16);
            v4u o; o.x = pk2(re[0], re[1]); o.y = pk2(re[2], re[3]); o.z = pk2(re[4], re[5]); o.w = pk2(re[6], re[7]); *(v4u*)d0 = o;
            o.x = pk2(re[8], re[9]); o.y = pk2(re[10], re[11]); o.z = pk2(re[12], re[13]); o.w = pk2(re[14], re[15]); *(v4u*)(d0 + 8) = o;
            o.x = pk2(im[0], im[1]); o.y = pk2(im[2], im[3]); o.z = pk2(im[4], im[5]); o.w = pk2(im[6], im[7]); *(v4u*)(d0 + 16 * TCH) = o;
            o.x = pk2(im[8], im[9]); o.y = pk2(im[10], im[11]); o.z = pk2(im[12], im[13]); o.w = pk2(im[14], im[15]); *(v4u*)(d0 + 16 * TCH + 8) = o;
        }
        }
        }
    }
    SEAM(1);

    if (IN(2)) for (int rep_ = 0; rep_ < REPS(2); ++rep_) {
        pg8::Gemm g{H1, WinT, M, NPROJ, D, D, D}; DupOrder<(DUP_MASK >> 2) & 1> S; S.S.init(M, NPROJ, G, bx);
        EpiQKV E{Qb, Kb, Vb, Ub, cosT, sinT};
        pg8::gemm_phase<EpiQKV, DupOrder<(DUP_MASK >> 2) & 1>, true, true>(lds + RING_OFF, g, S, E);
    }
    SEAM(2);

    auto scan_chains = [&]() {
        if (bx < 128) {
            int seq, g, dir, nc, chunk0, sgi;
            if (bx < 64) { seq = 0; g = bx >> 1; dir = bx & 1; nc = 512; chunk0 = 0; sgi = wave; }
            else { const int q = (bx - 64) * 4 + (wave >> 1); seq = 1 + (q >> 6); g = (q >> 1) & 31; dir = q & 1; nc = 128; chunk0 = 512 + 128 * (seq - 1); sgi = wave & 1; }
            const int i_lo = 64 * sgi;
            {
                unsigned sp = 0;
                while ((unsigned)__builtin_amdgcn_readfirstlane(__hip_atomic_load((unsigned*)(ctl + CW_SST) + 64 * g, __ATOMIC_RELAXED, __HIP_MEMORY_SCOPE_AGENT)) < 32u) { __builtin_amdgcn_s_sleep(2); if (++sp > (1u << 22)) break; }
                __builtin_amdgcn_fence(__ATOMIC_ACQUIRE, "agent"); asm volatile("s_waitcnt vmcnt(0)" ::: "memory");
            }
            const int bi = (dir * 32 + g) * 64 + lane; const float ar = t_atre[bi], ai = t_atim[bi];
            float hr = 0.f, hi_ = 0.f;
            LAS float* T = (LAS float*)(lds + RING_OFF);
            unsigned sw[64];
            const bf16* sp0 = Sbuf + ((size_t)(g * NCG + chunk0 + (dir == 0 ? i_lo : nc - 1 - i_lo)) * 256 + dir * 128 + 2 * lane);
            if (dir == 0) {
#pragma unroll
                for (int j = 0; j < 64; ++j) sw[j] = *(const unsigned*)(sp0 + j * 256);
            } else {
#pragma unroll
                for (int j = 0; j < 64; ++j) sw[j] = *(const unsigned*)(sp0 - j * 256);
            }
#pragma unroll
            for (int j = 0; j < 64; ++j) { const float nr = ar * hr - ai * hi_ + bflo(sw[j]), ni = ar * hi_ + ai * hr + bfhi(sw[j]); hr = nr; hi_ = ni; }
            __syncthreads();
            T[(wave * 64 + lane) * 2] = hr; T[(wave * 64 + lane) * 2 + 1] = hi_;
            __syncthreads();
#pragma unroll
            for (int j = 0; j < 64; ++j) asm volatile("" : "+v"(sw[j]));
            float pr = ar, pi = ai;
#pragma unroll
            for (int k = 0; k < 6; ++k) { const float nr = pr * pr - pi * pi, ni = 2.f * pr * pi; pr = nr; pi = ni; }
            hr = 0.f; hi_ = 0.f;
            for (int v = wave - sgi; v < wave; ++v) { const float tr = T[(v * 64 + lane) * 2], ti2 = T[(v * 64 + lane) * 2 + 1]; const float nr = pr * hr - pi * hi_ + tr, ni = pr * hi_ + pi * hr + ti2; hr = nr; hi_ = ni; }
            bf16* up = Ub + ((size_t)(g * NCG + chunk0 + (dir == 0 ? i_lo : nc - 1 - i_lo)) * UP + 16 * TCH + dir * 128 + 2 * lane);
            const long ustep = dir == 0 ? UP : -UP;
#pragma unroll
            for (int j = 0; j < 64; ++j) {
                *(unsigned*)up = pk2(hr, hi_); up += ustep; asm volatile("" : "+v"(up));
                const float nr = ar * hr - ai * hi_ + bflo(sw[j]), ni = ar * hi_ + ai * hr + bfhi(sw[j]); hr = nr; hi_ = ni; }
        }
    };
    auto build_toep = [&](int tb0, int tbs) {
        for (int e0 = tb0; e0 < 32 * TCH * 16 * TCH; e0 += 4 * tbs) {
            v4u a[4], b[4];
#pragma unroll
            for (int k = 0; k < 4; ++k) { const int e = e0 + k * tbs; if (e < 32 * TCH * 16 * TCH) {
                const int s = e & 31, c = (e >> 5) & 15, t = (e >> 9) & 31, g = e >> 14;
                const v4u* src = (const v4u*)(Klag + ((size_t)((g * (2 * TCH - 1) + (t - s + TCH - 1)) * 16 + c) * 16)); a[k] = src[0]; b[k] = src[1]; } }
#pragma unroll
            for (int k = 0; k < 4; ++k) { const int e = e0 + k * tbs; if (e < 32 * TCH * 16 * TCH) {
                const int s = e & 31, c = (e >> 5) & 15, t = (e >> 9) & 31, g = e >> 14;
                v4u* dst = (v4u*)(Toep + ((size_t)(g * 16 * TCH + t * 16 + c) * UP + s * 16)); dst[0] = a[k]; dst[1] = b[k]; } }
        }
        for (int e = tb0; e < 32 * TCH * 2 * 64; e += tbs) {
            const int n = e & 63, dir = (e >> 6) & 1, t = (e >> 7) & 31, g = e >> 12, bi = (dir * 32 + g) * 64 + n;
            float pre, pim; cpow_tab(t_ldre, t_theta, bi, dir == 0 ? t + 1 : TCH - t, pre, pim);
#pragma unroll
            for (int c = 0; c < 16; ++c) {
                const float cr = args.in[13][(size_t)((dir * 32 + g) * 16 + c) * 64 + n], ci = args.in[14][(size_t)((dir * 32 + g) * 16 + c) * 64 + n];
                *(unsigned*)(Toep + ((size_t)(g * 16 * TCH + t * 16 + c) * UP + 16 * TCH + dir * 128 + 2 * n)) = pk2(cr * pre - ci * pim, -(cr * pim + ci * pre));
            }
        }
        };
    if (IN(3)) {
        { pg8::Gemm g{Ub, Ptab, NG * NCG, NG * 256, 16 * TCH, UP, 16 * TCH}; SchedState S{bx, (unsigned*)(ctl + CW_SST)}; EpiState E{Sbuf};
          pg8::gemm_phase<EpiState, SchedState, true, true>(lds + RING_OFF, g, S, E); }
        for (int rep_ = 0; rep_ < REPS(3); ++rep_) att::phase(lds + RING_OFF, Qb, Kb, Vb, Ob, Lse, bx, G, wave, lane);
        scan_chains();
        if (G == 256) {
            LAS unsigned* tq = (LAS unsigned*)(lds + MISC_OFF + 72);
            for (;;) {
                __syncthreads();
                if (tid == 0) *tq = __hip_atomic_fetch_add((unsigned*)(ctl + CW_TQ), 1u, __ATOMIC_RELAXED, __HIP_MEMORY_SCOPE_AGENT);
                __syncthreads();
                const unsigned sl = *tq;
                if (sl >= 256u + 216u) break;
                if (sl < 256u) build_toep((int)sl * (NWAVES * 64) + tid, 256 * NWAVES * 64);
                else { const int c0 = ((int)sl - 256) * 16; later_weight_item(c0 + wave); later_weight_item(c0 + 8 + wave); }
            }
        }
    }
    SEAM(3);

    if (IN(4)) for (int rep_ = 0; rep_ < REPS(4); ++rep_) {
        if (G != 256) build_toep(gtid, NT);
    }
    if (G != 256) SEAM(4);

    if (IN(5)) for (int rep_ = 0; rep_ < REPS(5); ++rep_) {
        pg8::Gemm g{Ub, Toep, NG * NCG, NG * 16 * TCH, UP, UP, UP}; SchedSsmOut S{vcu}; EpiSsmOut E{Gb};
        pg8::gemm_phase<EpiSsmOut, SchedSsmOut, true, true>(lds + RING_OFF, g, S, E);
    }
    SEAM(5);

    if (IN(6)) for (int rep_ = 0; rep_ < REPS(6); ++rep_) {
        pg8::Gemm g{Gb, WgluT, M, 512, 512, 512, 512}; DupOrder<(DUP_MASK >> 6) & 1> S; S.S.init(M, 512, G, bx);
        EpiGluNorm E{lds};
        auto merge_pass = [&]() {
#ifndef P6_PROBE
#define P6_PROBE 0
#endif
        for (int p6r = 0; p6r < 1 + (P6_PROBE & 1); ++p6r)
        for (int t0 = 2 * gw; t0 < M; t0 += 2 * NGW) {
            const int hh = lane >> 3;
            float l0[2], l1[2], l2[2]; v4u a[2], bb[2], c[2];
#pragma unroll
            for (int k = 0; k < 2; ++k) { const size_t t = t0 + k;
                l0[k] = Lse[t * 8 + hh]; l1[k] = Lse[((size_t)M + t) * 8 + hh]; l2[k] = Lse[((size_t)2 * M + t) * 8 + hh];
                a[k] = *(const v4u*)(Ob + t * 512 + 8 * lane); bb[k] = *(const v4u*)(Ob + ((size_t)M + t) * 512 + 8 * lane); c[k] = *(const v4u*)(Ob + ((size_t)2 * M + t) * 512 + 8 * lane); }
            const f32x4 g0 = *(const f32x4*)(args.in[18] + 8 * lane), g1 = *(const f32x4*)(args.in[18] + 8 * lane + 4);
#pragma unroll
            for (int k = 0; k < 2; ++k) {
                const float lm = fmaxf(l0[k], fmaxf(l1[k], l2[k]));
                float w0 = fexp2((l0[k] - lm) * LOG2E), w1 = fexp2((l1[k] - lm) * LOG2E), w2 = fexp2((l2[k] - lm) * LOG2E);
                const float wi = frcp(w0 + w1 + w2); w0 *= wi; w1 *= wi; w2 *= wi;
                float v[8];
                v[0] = w0 * bflo(a[k].x) + w1 * bflo(bb[k].x) + w2 * bflo(c[k].x); v[1] = w0 * bfhi(a[k].x) + w1 * bfhi(bb[k].x) + w2 * bfhi(c[k].x);
                v[2] = w0 * bflo(a[k].y) + w1 * bflo(bb[k].y) + w2 * bflo(c[k].y); v[3] = w0 * bfhi(a[k].y) + w1 * bfhi(bb[k].y) + w2 * bfhi(c[k].y);
                v[4] = w0 * bflo(a[k].z) + w1 * bflo(bb[k].z) + w2 * bflo(c[k].z); v[5] = w0 * bfhi(a[k].z) + w1 * bfhi(bb[k].z) + w2 * bfhi(c[k].z);
                v[6] = w0 * bflo(a[k].w) + w1 * bflo(bb[k].w) + w2 * bflo(c[k].w); v[7] = w0 * bfhi(a[k].w) + w1 * bfhi(bb[k].w) + w2 * bfhi(c[k].w);
                float sq = 0.f;
#pragma unroll
                for (int j = 0; j < 8; ++j) sq += v[j] * v[j];
                const float rs = __builtin_amdgcn_rsqf(wave_sum(sq) * (1.f / 512.f) + EPS);
                v4u o; o.x = pk2(v[0] * rs * g0[0], v[1] * rs * g0[1]); o.y = pk2(v[2] * rs * g0[2], v[3] * rs * g0[3]); o.z = pk2(v[4] * rs * g1[0], v[5] * rs * g1[1]); o.w = pk2(v[6] * rs * g1[2], v[7] * rs * g1[3]);
                *(v4u*)(MixA + (size_t)(t0 + k) * D + 8 * lane) = o;
            }
        }
            };
        if (bx & 1) merge_pass();
        pg8::gemm_phase<EpiGluNorm, DupOrder<(DUP_MASK >> 6) & 1>, true, true>(lds + RING_OFF, g, S, E);
        if (!(bx & 1)) merge_pass();
    }
    SEAM(6);


    if (IN(8)) {
        pg8::Gemm g{MixA, WoT, M, D, D, D, D, H2, W13T}; EpiWoUp E{lds};
        if (G == 256) {
#pragma unroll 1
            for (int part = 0; part < 2; ++part) { SchedWoUp S{bx, (const unsigned*)(ctl + CW_READY), part == 0 ? 0 : 1, part == 0 ? 1 : 12};
                pg8::gemm_phase<EpiWoUp, SchedWoUp, true, true>(lds + RING_OFF, g, S, E); }
            {   LAS unsigned* tq = (LAS unsigned*)(lds + MISC_OFF + 72);
                if (tid < 64) { unsigned sp = 0;
                    while ((unsigned)__builtin_amdgcn_readfirstlane(__hip_atomic_load((unsigned*)(ctl + CW_W13), __ATOMIC_RELAXED, __HIP_MEMORY_SCOPE_AGENT)) < 256u) { __builtin_amdgcn_s_sleep(4); if (++sp > (1u << 22)) break; } }
                for (;;) {
                    __syncthreads();
                    if (tid == 0) *tq = __hip_atomic_fetch_add((unsigned*)(ctl + CW_WQ2), 1u, __ATOMIC_RELAXED, __HIP_MEMORY_SCOPE_AGENT);
                    __syncthreads();
                    const unsigned sl = *tq;
                    if (sl >= 88u) break;
                    transpose_item(args.in[24], FF, D, W2T, scr, (int)sl * 16 + wave, lane, MapId{}); transpose_item(args.in[24], FF, D, W2T, scr, (int)sl * 16 + 8 + wave, lane, MapId{});
                }
            }
        }
    }
    SEAM(8);

#ifdef EXTRA_BARS
    for (int xb_ = 0; xb_ < EXTRA_BARS; ++xb_) xcd_barrier(bar);
#endif

    if (IN(12)) {
        pg8::Gemm g{Act, W2T, M, D, FF, FF, FF}; DupOrder<((DUP_MASK >> 12) & 1) + 2 * ((DUP_MASK >> 13) & 1)> S; S.S.init(M, D, G, bx);
        EpiDownFinal E{lds};
        { OneUnit O{S.S, 0, 1}; pg8::gemm_phase<EpiDownFinal, OneUnit, true, true>(lds + RING_OFF, g, O, E); }
        { OneUnit O{S.S, 1, 1 << 30}; pg8::gemm_phase<EpiDownFinal, OneUnit, true, true>(lds + RING_OFF, g, O, E); }
    }
    if (TIME_PHASE == 12 && bx == 0) { __syncthreads(); if (tid == 0) { const unsigned long long t1 = __builtin_amdgcn_s_memrealtime(); const unsigned long long dt = t1 - tp0; while (__builtin_amdgcn_s_memrealtime() - t1 < 9ull * dt) __builtin_amdgcn_s_sleep(8); } }
#undef IN
#undef SEAM
}

extern "C" void kernel_launch(void* const* d_in, const int* in_sizes, int n_in, void* d_out, int out_size, void* d_ws, size_t ws_size, hipStream_t stream) {
    static int grid = 0;
    if (grid == 0) {
        if (n_in != 26 || in_sizes[0] != MP * D || out_size != M * D || ws_size < WS_END) { fprintf(stderr, "kernel_launch: unexpected shapes (n_in %d, in0 %d, out %d, ws %zu); nothing launched\n", n_in, n_in > 0 ? in_sizes[0] : -1, out_size, ws_size); grid = -1; return; }
        int dev = 0, cus = 0, per_cu = 0;
        if (hipGetDevice(&dev) != hipSuccess || hipDeviceGetAttribute(&cus, hipDeviceAttributeMultiprocessorCount, dev) != hipSuccess) { grid = -1; return; }
        if (hipFuncSetAttribute((const void*)mk_fwd, hipFuncAttributeMaxDynamicSharedMemorySize, LDS_BYTES) != hipSuccess) { fprintf(stderr, "kernel_launch: hipFuncSetAttribute failed\n"); grid = -1; return; }
        if (hipOccupancyMaxActiveBlocksPerMultiprocessor(&per_cu, (const void*)mk_fwd, NWAVES * 64, LDS_BYTES) != hipSuccess || per_cu < 1) fprintf(stderr, "kernel_launch: occupancy query says %d\n", per_cu);
        (void)hipGetLastError();
        grid = cus;
    }
    if (grid < 0) return;
    if (hipMemsetAsync((char*)d_ws + WS_CTL, 0, CTL_ZERO_BYTES, stream) != hipSuccess) return;
    Args a{};
    for (int i = 0; i < 26; ++i) a.in[i] = (const float*)d_in[i];
    a.out = (float*)d_out; a.ws = (unsigned char*)d_ws;
    if (MK_N_LAUNCHES == 1) { a.ph_lo = 0; a.ph_hi = N_PHASES; hipLaunchKernelGGL(mk_fwd, dim3(grid), dim3(NWAVES * 64), LDS_BYTES, stream, a); }
    else for (int p = 0; p < N_PHASES; ++p) { a.ph_lo = p; a.ph_hi = p + 1; hipLaunchKernelGGL(mk_fwd, dim3(grid), dim3(NWAVES * 64), LDS_BYTES, stream, a); }
}
```
